# Optimizing an MI355X kernel written in HIP

```python
import jax, jax.numpy as jnp
from jax import lax
import numpy as np

D_MODEL = 1024
BATCH = 8
SEQ = 8192
DEPTH = 2
DEC_BATCH = 16
DEC_SEQ = 64
PAST_LEN = 4096

CHUNK = 64
N_MIXERS = 2
N_RET = (DEPTH + 1) // 2
N_SB = DEPTH // 2
RET_HEADS = 4
RET_DK = D_MODEL // RET_HEADS
RET_DV = 2 * RET_DK
RET_QK = RET_HEADS * RET_DK
RET_VW = RET_HEADS * RET_DV
ROPE_BASE = 10000.0
SB_HEADS = 16
SB_HD = D_MODEL // SB_HEADS
SB_QBLOCK = 128
PEER_HEADS = 8
PEER_QDIM = 256
N_KEYS = 128
N_EXPERTS = N_KEYS * N_KEYS
PEER_TOPK = 16
PEER_TOKEN_BLOCK = 256
LN_EPS = 1e-5
GN_EPS = 1e-6
ALPHA = (2 * DEPTH) ** 0.25
BETA_INIT = (8 * DEPTH) ** -0.25

kernel_name = 'retnet_stickbreak_peer_stream_step'


def layer_norm(x, g, b):
    xf = x.astype(jnp.float32)
    mu = jnp.mean(xf, axis=-1, keepdims=True)
    var = jnp.mean(jnp.square(xf - mu), axis=-1, keepdims=True)
    y = (xf - mu) * lax.rsqrt(var + LN_EPS) * g.astype(jnp.float32) + b.astype(jnp.float32)
    return y.astype(x.dtype)


def rotary(x, pos):
    half = x.shape[-1] // 2
    inv = ROPE_BASE ** (-jnp.arange(half, dtype=jnp.float32) / half)
    ang = pos.astype(jnp.float32)[:, None] * inv[None, :]
    cos, sin = jnp.cos(ang), jnp.sin(ang)
    xf = x.astype(jnp.float32)
    x1, x2 = xf[..., :half], xf[..., half:]
    return jnp.concatenate([x1 * cos - x2 * sin, x1 * sin + x2 * cos], axis=-1).astype(x.dtype)


def retention_log_decay():
    return jnp.log1p(-jnp.exp2(-5.0 - jnp.arange(RET_HEADS, dtype=jnp.float32)))


def retention_chunk(S, q, k, v, log_g):
    L = q.shape[2]
    pos = jnp.arange(L, dtype=jnp.float32)
    diff = pos[:, None] - pos[None, :]
    causal = diff >= 0
    dmask = jnp.where(causal, jnp.exp(log_g[:, None, None] * jnp.where(causal, diff, 0.0)), 0.0).astype(q.dtype)
    inner = jnp.einsum('bhnm,bhme->bhne', jnp.einsum('bhnd,bhmd->bhnm', q, k) * dmask, v)
    q_dec = jnp.exp(log_g[:, None] * (pos + 1.0)[None, :]).astype(q.dtype)
    cross = jnp.einsum('bhnd,bhde->bhne', q * q_dec[None, :, :, None], S)
    k_dec = jnp.exp(log_g[:, None] * (L - 1.0 - pos)[None, :]).astype(q.dtype)
    s_dec = jnp.exp(log_g * L).astype(S.dtype)
    S_new = S * s_dec[None, :, None, None] + jnp.einsum('bhmd,bhme->bhde', k * k_dec[None, :, :, None], v)
    return S_new.astype(S.dtype), inner + cross


def retention_mixer(x, S0, pos0, w_in, w_o):
    B, L, _ = x.shape
    q, k, v, g = jnp.split(x @ w_in, [RET_QK, 2 * RET_QK, 2 * RET_QK + RET_VW], axis=-1)
    pos = pos0 + jnp.arange(L)
    q = rotary(q.reshape(B, L, RET_HEADS, RET_DK).transpose(0, 2, 1, 3), pos)
    k = rotary(k.reshape(B, L, RET_HEADS, RET_DK).transpose(0, 2, 1, 3), pos) * (RET_DK ** -0.5)
    v = v.reshape(B, L, RET_HEADS, RET_DV).transpose(0, 2, 1, 3)
    log_g = retention_log_decay()
    if L <= CHUNK:
        S, o = retention_chunk(S0, q, k, v, log_g)
    else:
        nc = L // CHUNK
        def to_chunks(t):
            return jnp.moveaxis(t.reshape(B, RET_HEADS, nc, CHUNK, t.shape[-1]), 2, 0)
        S, o = lax.scan(lambda s, c: retention_chunk(s, c[0], c[1], c[2], log_g), S0,
                        (to_chunks(q), to_chunks(k), to_chunks(v)))
        o = jnp.moveaxis(o, 0, 2).reshape(B, RET_HEADS, L, RET_DV)
    of = o.astype(jnp.float32)
    mu = jnp.mean(of, axis=-1, keepdims=True)
    var = jnp.mean(jnp.square(of - mu), axis=-1, keepdims=True)
    y = ((of - mu) * lax.rsqrt(var + GN_EPS)).transpose(0, 2, 1, 3).reshape(B, L, RET_VW).astype(x.dtype)
    return (jax.nn.silu(g) * y) @ w_o, S


def stick_breaking_block(q, k, v, q_pos, k_pos):
    z = jnp.einsum('bhqd,bhkd->bhqk', q, k).astype(jnp.float32) * (SB_HD ** -0.5)
    mask = k_pos[None, :] < q_pos[:, None]
    log_remain = jnp.where(mask, jax.nn.log_sigmoid(-z), 0.0)
    log_pass = lax.cumsum(log_remain, axis=3, reverse=True) - log_remain
    w = jnp.where(mask, jnp.exp(jax.nn.log_sigmoid(z) + log_pass), 0.0)
    return jnp.einsum('bhqk,bhkd->bhqd', w.astype(v.dtype), v)


def stick_breaking_mixer(x, k_past, v_past, pos0, w_qkv, w_o):
    B, L, _ = x.shape
    q, k, v = jnp.split(x @ w_qkv, 3, axis=-1)
    q = q.reshape(B, L, SB_HEADS, SB_HD).transpose(0, 2, 1, 3)
    k = k.reshape(B, L, SB_HEADS, SB_HD).transpose(0, 2, 1, 3)
    v = v.reshape(B, L, SB_HEADS, SB_HD).transpose(0, 2, 1, 3)
    if k_past is None:
        k_all, v_all = k, v
    else:
        k_all = jnp.concatenate([k_past, k], axis=2)
        v_all = jnp.concatenate([v_past, v], axis=2)
    q_pos = pos0 + jnp.arange(L)
    k_pos = jnp.arange(k_all.shape[2])
    if L <= SB_QBLOCK:
        o = stick_breaking_block(q, k_all, v_all, q_pos, k_pos)
    else:
        nb = L // SB_QBLOCK
        qb = jnp.moveaxis(q.reshape(B, SB_HEADS, nb, SB_QBLOCK, SB_HD), 2, 0)
        pb = q_pos.reshape(nb, SB_QBLOCK)
        o = lax.map(lambda a: stick_breaking_block(a[0], k_all, v_all, a[1], k_pos), (qb, pb))
        o = jnp.moveaxis(o, 0, 2).reshape(B, SB_HEADS, L, SB_HD)
    out = o.transpose(0, 2, 1, 3).reshape(B, L, D_MODEL) @ w_o
    return out, k, v


def peer_tokens(xt, w_q, keys_a, keys_b, u, v):
    T = xt.shape[0]
    q = (xt @ w_q).reshape(T, PEER_HEADS, PEER_QDIM)
    qa, qb = jnp.split(q, 2, axis=-1)
    sa = jnp.einsum('thd,hkd->thk', qa, keys_a)
    sb = jnp.einsum('thd,hkd->thk', qb, keys_b)
    va, ia = lax.top_k(sa, PEER_TOPK)
    vb, ib = lax.top_k(sb, PEER_TOPK)
    cand_s = (va[..., :, None] + vb[..., None, :]).reshape(T, PEER_HEADS, PEER_TOPK * PEER_TOPK)
    cand_i = (ia[..., :, None] * N_KEYS + ib[..., None, :]).reshape(T, PEER_HEADS, PEER_TOPK * PEER_TOPK)
    s, j = lax.top_k(cand_s, PEER_TOPK)
    idx = jnp.take_along_axis(cand_i, j, axis=-1)
    gate = jax.nn.softmax(s.astype(jnp.float32), axis=-1).astype(xt.dtype)
    h = jax.nn.gelu(jnp.einsum('td,thkd->thk', xt, u[idx]), approximate=False)
    return jnp.einsum('thk,thkd->td', gate * h, v[idx])


def peer_ffn(x, w_q, keys_a, keys_b, u, v):
    B, L, D = x.shape
    T = B * L
    xt = x.reshape(T, D)
    if T <= PEER_TOKEN_BLOCK:
        out = peer_tokens(xt, w_q, keys_a, keys_b, u, v)
    else:
        nb = -(-T // PEER_TOKEN_BLOCK)
        pad = nb * PEER_TOKEN_BLOCK - T
        xb = jnp.pad(xt, ((0, pad), (0, 0))).reshape(nb, PEER_TOKEN_BLOCK, D)
        out = lax.map(lambda a: peer_tokens(a, w_q, keys_a, keys_b, u, v), xb)
        out = out.reshape(nb * PEER_TOKEN_BLOCK, D)[:T]
    return out.reshape(B, L, D)


def setup_inputs(seed: int = 0) -> dict:
    key = jax.random.key(seed)
    ks = jax.random.split(key, 16)
    f32 = jnp.float32

    def nrm(k, shape, scale):
        return jax.random.normal(k, shape, f32) * scale

    d_in = D_MODEL ** -0.5
    x_prompt = nrm(ks[0], (BATCH, SEQ, D_MODEL), 1.0)
    x_sample = nrm(ks[1], (DEC_BATCH, DEC_SEQ, D_MODEL), 1.0)
    state_ret = nrm(ks[2], (N_RET, DEC_BATCH, RET_HEADS, RET_DK, RET_DV), 0.5)
    cache_k = nrm(ks[3], (N_SB, DEC_BATCH, SB_HEADS, PAST_LEN, SB_HD), 1.0)
    cache_v = nrm(ks[4], (N_SB, DEC_BATCH, SB_HEADS, PAST_LEN, SB_HD), 1.0)
    ret_cols = jnp.concatenate([jnp.full((2 * RET_QK,), d_in, f32),
                                jnp.full((RET_VW,), d_in * BETA_INIT, f32),
                                jnp.full((RET_VW,), d_in, f32)])
    ret_w_in = nrm(ks[5], (N_RET, D_MODEL, 2 * RET_QK + 2 * RET_VW), 1.0) * ret_cols
    ret_w_o = nrm(ks[6], (N_RET, RET_VW, D_MODEL), RET_VW ** -0.5 * BETA_INIT)
    sb_cols = jnp.concatenate([jnp.full((2 * D_MODEL,), d_in, f32),
                               jnp.full((D_MODEL,), d_in * BETA_INIT, f32)])
    sb_w_qkv = nrm(ks[7], (N_SB, D_MODEL, 3 * D_MODEL), 1.0) * sb_cols
    sb_w_o = nrm(ks[8], (N_SB, D_MODEL, D_MODEL), d_in * BETA_INIT)
    peer_w_q = nrm(ks[9], (DEPTH, D_MODEL, PEER_HEADS * PEER_QDIM), d_in)
    peer_keys_a = nrm(ks[10], (DEPTH, PEER_HEADS, N_KEYS, PEER_QDIM // 2), (PEER_QDIM // 2) ** -0.5)
    peer_keys_b = nrm(ks[11], (DEPTH, PEER_HEADS, N_KEYS, PEER_QDIM // 2), (PEER_QDIM // 2) ** -0.5)
    peer_u = nrm(ks[12], (DEPTH, N_EXPERTS, D_MODEL), d_in)
    peer_v = nrm(ks[13], (DEPTH, N_EXPERTS, D_MODEL), BETA_INIT * PEER_HEADS ** -0.5)
    ln_g = 1.0 + nrm(ks[14], (DEPTH, 2, D_MODEL), 0.02)
    ln_b = nrm(ks[15], (DEPTH, 2, D_MODEL), 0.02)
    return {'x_prompt': x_prompt, 'x_sample': x_sample, 'state_ret': state_ret,
            'cache_k': cache_k, 'cache_v': cache_v,
            'ret_w_in': ret_w_in, 'ret_w_o': ret_w_o, 'sb_w_qkv': sb_w_qkv, 'sb_w_o': sb_w_o,
            'peer_w_q': peer_w_q, 'peer_keys_a': peer_keys_a, 'peer_keys_b': peer_keys_b,
            'peer_u': peer_u, 'peer_v': peer_v, 'ln_g': ln_g, 'ln_b': ln_b}


def reference(x_prompt, x_sample, state_ret, cache_k, cache_v, ret_w_in, ret_w_o, sb_w_qkv, sb_w_o,
              peer_w_q, peer_keys_a, peer_keys_b, peer_u, peer_v, ln_g, ln_b):
    xp, xs = x_prompt, x_sample
    ret_p, ret_s, kp, vp, ksm, vsm = [], [], [], [], [], []
    for i in range(DEPTH):
        j = i // N_MIXERS
        if i % N_MIXERS == 0:
            s0 = jnp.zeros((xp.shape[0], RET_HEADS, RET_DK, RET_DV), xp.dtype)
            mp, sp = retention_mixer(xp, s0, 0, ret_w_in[j], ret_w_o[j])
            ms, ss = retention_mixer(xs, state_ret[j], PAST_LEN, ret_w_in[j], ret_w_o[j])
            ret_p.append(sp)
            ret_s.append(ss)
        else:
            mp, k_new_p, v_new_p = stick_breaking_mixer(xp, None, None, 0, sb_w_qkv[j], sb_w_o[j])
            ms, k_new_s, v_new_s = stick_breaking_mixer(xs, cache_k[j], cache_v[j], PAST_LEN, sb_w_qkv[j], sb_w_o[j])
            kp.append(k_new_p)
            vp.append(v_new_p)
            ksm.append(k_new_s)
            vsm.append(v_new_s)
        xp = layer_norm(ALPHA * xp + mp, ln_g[i, 0], ln_b[i, 0])
        xs = layer_norm(ALPHA * xs + ms, ln_g[i, 0], ln_b[i, 0])
        xp = layer_norm(ALPHA * xp + peer_ffn(xp, peer_w_q[i], peer_keys_a[i], peer_keys_b[i], peer_u[i], peer_v[i]),
                        ln_g[i, 1], ln_b[i, 1])
        xs = layer_norm(ALPHA * xs + peer_ffn(xs, peer_w_q[i], peer_keys_a[i], peer_keys_b[i], peer_u[i], peer_v[i]),
                        ln_g[i, 1], ln_b[i, 1])
    return (xp, xs, jnp.stack(ret_p), jnp.stack(ret_s), jnp.stack(kp), jnp.stack(vp), jnp.stack(ksm), jnp.stack(vsm))
```

```cpp
#include <hip/hip_runtime.h>
#include <cstdio>
#include <cstdint>
#define GAS __attribute__((address_space(1)))
#define LAS __attribute__((address_space(3)))
namespace pg8 {
#define PG8_LAS __attribute__((address_space(3)))
typedef unsigned short bf16_t;
typedef short bf16x8 __attribute__((ext_vector_type(8)));
typedef float f32x4 __attribute__((ext_vector_type(4)));
typedef unsigned u32x4 __attribute__((ext_vector_type(4)));
constexpr int BM = 256, BK = 64, HALF = 128, HTB = HALF * BK * 2  , STAGE_BYTES = 8 * HTB, NXCD = 8, WGM = 8;

__host__ __device__ __forceinline__ int lds_byte(int r, int c) { const int st = (r >> 4) * 2 + (c >> 5), rr = r & 15, cc = c & 31, ob = rr * 64 + cc * 2; return st * 1024 + (ob ^ (((ob >> 9) & 1) << 5)); }
__host__ __device__ __forceinline__ void stage_rc(int b, int& R, int& C) { const int st = b / 1024, sb = b % 1024, swz = sb ^ (((sb >> 9) & 1) << 5); R = (st >> 1) * 16 + swz / 64; C = (st & 1) * 32 + (swz % 64) / 2; }
__host__ __device__ __forceinline__ int perm32(int rho) { const int n = rho >> 4, i = rho & 15; return 8 * (i >> 2) + 4 * n + (i & 3); }

struct Unit { int pm, pn; };
struct Gemm { const bf16_t* A; const bf16_t* Bt; int M, N, K, lda, ldb; };

struct StaticOrder {
    int nM, nN, nwg, G, c;
    __host__ __device__ void init(int M, int N, int G_, int c_) { nM = M / BM; nN = N / BM; nwg = nM * nN; G = G_; c = c_; }
    __host__ __device__ bool next(int i, Unit& u) const {
        const long L = (long)i * G + c; if (L >= nwg) return false;
        int wgid = (int)L; { const int q = nwg / NXCD, r = nwg % NXCD, xcd = wgid % NXCD, off = wgid / NXCD; wgid = (xcd < r ? xcd * (q + 1) : r * (q + 1) + (xcd - r) * q) + off; }
        const int nig = WGM * nN, gid = wgid / nig, fm = gid * WGM, gsz = (nM - fm) < WGM ? (nM - fm) : WGM;
        u.pm = fm + ((wgid % nig) % gsz); u.pn = (wgid % nig) / gsz; return true;
    }
    __device__ __forceinline__ void a_ready(const Unit&) const {}
    __device__ __forceinline__ void done(const Unit&) const {}
};

__device__ __forceinline__ unsigned cvt_pk_bf16(float lo, float hi) { unsigned r; asm volatile("v_cvt_pk_bf16_f32 %0, %1, %2" : "=v"(r) : "v"(lo), "v"(hi)); return r; }
typedef float f32x2 __attribute__((ext_vector_type(2)));
__device__ __forceinline__ f32x2 gelu_pk(f32x2 v) {
    const f32x2 av = __builtin_elementwise_abs(v), d = av * 0.2316418882f + 1.0f;
    f32x2 t; t.x = __builtin_amdgcn_rcpf(d.x); t.y = __builtin_amdgcn_rcpf(d.y);
    f32x2 q = t * 0.5307027145f + (-0.7265760135f); q = q * t + 0.7107068705f; q = q * t + (-0.142248368f); q = q * t + 0.127414796f; q = q * t;
    const f32x2 s = (v * v) * (-0.72134752044f);
    f32x2 e; e.x = __builtin_amdgcn_exp2f(s.x); e.y = __builtin_amdgcn_exp2f(s.y);
    const f32x2 m = v * (q * e), r = v - m;
    f32x2 o; o.x = v.x < 0.f ? m.x : r.x; o.y = v.y < 0.f ? m.y : r.y; return o;
}

template <int ACT  > struct EpiBf16 {
    static constexpr bool PERM = true, AFTER_DRAIN = false; static_assert(ACT == 0 || ACT == 1, "EpiBf16: ACT is 0 (none) or 1 (gelu_pk)");
    bf16_t* O; int ldc; const float* bias; int split_cols; size_t split_stride; float scale0;
    __device__ __forceinline__ void operator()(const f32x4 (&acc)[2][2][4][2], const Unit& u, int wr, int wc, int fr, int fq) const {
        const int row0 = u.pm * BM + wr * 64 + fr; int colt = u.pn * BM; bf16_t* base = O;
        float sc = 1.f; if (split_cols) { const int t = colt / split_cols; base += (size_t)t * split_stride; colt -= t * split_cols; if (t == 0) sc = scale0; }
        const int col0 = colt + wc * 32 + 8 * fq, bcol0 = u.pn * BM + wc * 32 + 8 * fq;
        f32x4 bv[2][2];
#pragma unroll
        for (int bj = 0; bj < 2; ++bj)
#pragma unroll
            for (int n = 0; n < 2; ++n) bv[bj][n] = bias ? *(const f32x4*)(bias + bcol0 + bj * HALF + 4 * n) : (f32x4){0.f, 0.f, 0.f, 0.f};
#pragma unroll
        for (int ai = 0; ai < 2; ++ai)
#pragma unroll
            for (int m = 0; m < 4; ++m) { bf16_t* rowp = base + (size_t)(row0 + ai * HALF + m * 16) * ldc + col0;
#pragma unroll
                for (int bj = 0; bj < 2; ++bj) { f32x4 v0 = acc[ai][bj][m][0] + bv[bj][0], v1 = acc[ai][bj][m][1] + bv[bj][1];
                    if (ACT == 1) { f32x2 a = gelu_pk((f32x2){v0[0], v0[1]}), b = gelu_pk((f32x2){v0[2], v0[3]}), c = gelu_pk((f32x2){v1[0], v1[1]}), d = gelu_pk((f32x2){v1[2], v1[3]});
                        v0 = (f32x4){a.x, a.y, b.x, b.y}; v1 = (f32x4){c.x, c.y, d.x, d.y}; }
                    v0 = v0 * sc; v1 = v1 * sc; u32x4 w; w.x = cvt_pk_bf16(v0[0], v0[1]); w.y = cvt_pk_bf16(v0[2], v0[3]); w.z = cvt_pk_bf16(v1[0], v1[1]); w.w = cvt_pk_bf16(v1[2], v1[3]);
                    *(u32x4*)(rowp + bj * HALF) = w; } }
    }
};

__device__ __forceinline__ int row_pos(int r) { return r < 65536 ? (r & 8191) : 4096 + (r & 63); }
struct EpiRot {
    static constexpr bool PERM = true, AFTER_DRAIN = false;
    bf16_t* QK; bf16_t* VG; const float* cosT; const float* sinT;
    __device__ __forceinline__ void operator()(const f32x4 (&acc)[2][2][4][2], const Unit& u, int wr, int wc, int fr, int fq) const {
        const int row0 = u.pm * BM + wr * 64 + fr;
        if (u.pn < 8) {
            const float l2g = __builtin_amdgcn_logf(1.0f - __builtin_amdgcn_exp2f(-5.0f - (float)(u.pn & 3))) * ((u.pn >= 4) ? -1.0f : 1.0f);
            const float sc0 = (u.pn >= 4) ? 0.0625f : 1.0f;
            const int i0 = wc * 32 + 8 * fq;
#pragma unroll
            for (int ai = 0; ai < 2; ++ai)
#pragma unroll
                for (int m = 0; m < 4; ++m) {
                    const int row = row0 + ai * HALF + m * 16; const int pos = row_pos(row);
                    const float sc = sc0 * __builtin_amdgcn_exp2f((float)(row & 63) * l2g);
                    const float* cp = cosT + (size_t)pos * 128 + i0; const float* sp = sinT + (size_t)pos * 128 + i0;
                    const f32x4 c0 = *(const f32x4*)cp, c1 = *(const f32x4*)(cp + 4), s0 = *(const f32x4*)sp, s1 = *(const f32x4*)(sp + 4);
                    const f32x4 a0 = acc[ai][0][m][0], a1 = acc[ai][0][m][1], b0 = acc[ai][1][m][0], b1 = acc[ai][1][m][1];
                    const f32x4 o00 = (a0 * c0 - b0 * s0) * sc, o01 = (a1 * c1 - b1 * s1) * sc;
                    const f32x4 o10 = (a0 * s0 + b0 * c0) * sc, o11 = (a1 * s1 + b1 * c1) * sc;
                    bf16_t* rowp = QK + (size_t)row * 2048 + u.pn * BM + wc * 32 + 8 * fq;
                    u32x4 w; w.x = cvt_pk_bf16(o00[0], o00[1]); w.y = cvt_pk_bf16(o00[2], o00[3]); w.z = cvt_pk_bf16(o01[0], o01[1]); w.w = cvt_pk_bf16(o01[2], o01[3]);
                    *(u32x4*)rowp = w;
                    w.x = cvt_pk_bf16(o10[0], o10[1]); w.y = cvt_pk_bf16(o10[2], o10[3]); w.z = cvt_pk_bf16(o11[0], o11[1]); w.w = cvt_pk_bf16(o11[2], o11[3]);
                    *(u32x4*)(rowp + HALF) = w;
                }
        } else {
#pragma unroll
            for (int ai = 0; ai < 2; ++ai)
#pragma unroll
                for (int m = 0; m < 4; ++m) {
                    const int row = row0 + ai * HALF + m * 16;
                    bf16_t* rowp = VG + (size_t)row * 4096 + (u.pn - 8) * BM + wc * 32 + 8 * fq;
#pragma unroll
                    for (int bj = 0; bj < 2; ++bj) { const f32x4 v0 = acc[ai][bj][m][0], v1 = acc[ai][bj][m][1];
                        u32x4 w; w.x = cvt_pk_bf16(v0[0], v0[1]); w.y = cvt_pk_bf16(v0[2], v0[3]); w.z = cvt_pk_bf16(v1[0], v1[1]); w.w = cvt_pk_bf16(v1[2], v1[3]);
                        *(u32x4*)(rowp + bj * HALF) = w; }
                }
        }
    }
};
struct EpiQKV1 {
    static constexpr bool PERM = true, AFTER_DRAIN = false;
    bf16_t* Q1; size_t bstride;
    float* krp; float* vrp; float* krs; float* vrs;
    __device__ __forceinline__ void operator()(const f32x4 (&acc)[2][2][4][2], const Unit& u, int wr, int wc, int fr, int fq) const {
        const int row0 = u.pm * BM + wr * 64 + fr;
        const int t = u.pn >> 2;
        const int colt = (u.pn & 3) * BM + wc * 32 + 8 * fq;
        const float sc = (t == 0) ? 0.125f : 1.0f;
        bf16_t* base = Q1 + (size_t)t * bstride;
#pragma unroll
        for (int ai = 0; ai < 2; ++ai)
#pragma unroll
            for (int m = 0; m < 4; ++m) {
                const int row = row0 + ai * HALF + m * 16;
                bf16_t* rowp = base + (size_t)row * 1024 + colt;
#pragma unroll
                for (int bj = 0; bj < 2; ++bj) { const f32x4 v0 = acc[ai][bj][m][0] * sc, v1 = acc[ai][bj][m][1] * sc;
                    u32x4 w; w.x = cvt_pk_bf16(v0[0], v0[1]); w.y = cvt_pk_bf16(v0[2], v0[3]); w.z = cvt_pk_bf16(v1[0], v1[1]); w.w = cvt_pk_bf16(v1[2], v1[3]);
                    *(u32x4*)(rowp + bj * HALF) = w;
                    }
            }
    }
};
template <class Epi, class Sched, bool ALIGN_EPI = false, bool SP2 = false>
__device__ __forceinline__ void gemm_phase(PG8_LAS unsigned char* lds, const Gemm g, const Sched& S, const Epi& E, const int wid_in) {
    const int lane = (int)__builtin_amdgcn_mbcnt_hi(~0u, __builtin_amdgcn_mbcnt_lo(~0u, 0u)), wid = wid_in, tid = wid * 64 + lane, wr = wid >> 2, wc = wid & 3, fr = lane & 15, fq = lane >> 4;
    const int K = g.K, nt = K / BK;
    unsigned voffA[2], voffB[2];
#pragma unroll
    for (int i = 0; i < 2; ++i) { int R, C; stage_rc(tid * 16 + i * 8192, R, C); const int Rb = Epi::PERM ? ((R & ~31) + perm32(R & 31)) : R;
        voffA[i] = (unsigned)(R * g.lda + C) * 2u; voffB[i] = (unsigned)(Rb * g.ldb + C) * 2u; }
    const size_t kstep = (size_t)(BK * 2);
    const size_t hstepA = (size_t)HALF * g.lda * 2, hstepB = (size_t)HALF * g.ldb * 2;
    const size_t tstepA = 2 * hstepA, tstepB = 2 * hstepB;
    const unsigned ldsw = (unsigned)wid * 1024u;
    const int aoff = lds_byte(wr * 64 + fr, fq * 8), boff = lds_byte(wc * 32 + fr, fq * 8);
#define PG8_SA(b, h) (((b) * 2 + (h)) * HTB)
#define PG8_SB(b, h) ((4 + (b) * 2 + (h)) * HTB)
#define PG8_STAGE(bufoff, gbase, voff) do { _Pragma("unroll") for (int _i = 0; _i < 2; ++_i) \
        __builtin_amdgcn_global_load_lds((const unsigned*)((const char*)(gbase) + (voff)[_i]), (PG8_LAS unsigned*)(lds + (bufoff) + ldsw + _i * 8192), 16, 0, 0); } while (0)
#define PG8_LDA(dst, b, h) do { _Pragma("unroll") for (int m = 0; m < 4; ++m) _Pragma("unroll") for (int k = 0; k < 2; ++k) dst[m][k] = *(const PG8_LAS bf16x8*)(lds + PG8_SA(b, h) + aoff + m * 2048 + k * 1024); } while (0)
#define PG8_LDB(dst, b, h) do { _Pragma("unroll") for (int n = 0; n < 2; ++n) _Pragma("unroll") for (int k = 0; k < 2; ++k) dst[n][k] = *(const PG8_LAS bf16x8*)(lds + PG8_SB(b, h) + boff + n * 2048 + k * 1024); } while (0)
#define PG8_MMA(ai, bj, At, Bt) do { __builtin_amdgcn_s_setprio(1); _Pragma("unroll") for (int m = 0; m < 4; ++m) _Pragma("unroll") for (int n = 0; n < 2; ++n) _Pragma("unroll") for (int k = 0; k < 2; ++k) \
        acc[ai][bj][m][n] = __builtin_amdgcn_mfma_f32_16x16x32_bf16(Bt[n][k], At[m][k], acc[ai][bj][m][n], 0, 0, 0); __builtin_amdgcn_s_setprio(0); } while (0)
#define PG8_WAIT_V(n) asm volatile("s_waitcnt vmcnt(" #n ")" ::: "memory")
#define PG8_WAIT_L(n) asm volatile("s_waitcnt lgkmcnt(" #n ")" ::: "memory")
#define PG8_BAR __builtin_amdgcn_s_barrier()
#define PG8_SCHED __builtin_amdgcn_sched_barrier(0)
    Unit cur, nxt; int ui = 0;
    if (!S.next(0, cur)) return;
    f32x4 acc[2][2][4][2];
#pragma unroll
    for (int a = 0; a < 2; ++a)
#pragma unroll
        for (int b = 0; b < 2; ++b)
#pragma unroll
            for (int m = 0; m < 4; ++m)
#pragma unroll
                for (int n = 0; n < 2; ++n) acc[a][b][m][n] = (f32x4){0.f, 0.f, 0.f, 0.f};
    bf16x8 At[4][2], B0[2][2], B1[2][2];
    const char* cA = (const char*)g.A + (size_t)cur.pm * tstepA; const char* cB = (const char*)g.Bt + (size_t)cur.pn * tstepB;
    S.a_ready(cur);
    if constexpr (SP2) {
        PG8_STAGE(PG8_SB(0, 0), cB, voffB); PG8_STAGE(PG8_SB(0, 1), cB + hstepB, voffB); PG8_STAGE(PG8_SA(0, 0), cA, voffA); PG8_STAGE(PG8_SA(0, 1), cA + hstepA, voffA);
        if (wr == 1) PG8_BAR;
        PG8_WAIT_V(2); PG8_BAR;
        PG8_STAGE(PG8_SB(1, 0), cB + kstep, voffB); PG8_STAGE(PG8_SA(1, 0), cA + kstep, voffA); PG8_STAGE(PG8_SB(1, 1), cB + hstepB + kstep, voffB);
        PG8_WAIT_V(6); PG8_BAR;
    } else {
        PG8_STAGE(PG8_SB(0, 0), cB, voffB); PG8_STAGE(PG8_SA(0, 0), cA, voffA); PG8_STAGE(PG8_SB(0, 1), cB + hstepB, voffB); PG8_STAGE(PG8_SA(0, 1), cA + hstepA, voffA);
        if (wr == 1) PG8_BAR;
        PG8_WAIT_V(4); PG8_BAR;
        PG8_STAGE(PG8_SB(1, 0), cB + kstep, voffB); PG8_STAGE(PG8_SA(1, 0), cA + kstep, voffA); PG8_STAGE(PG8_SB(1, 1), cB + hstepB + kstep, voffB);
        PG8_WAIT_V(6); PG8_BAR;
    }
    for (;;) {
        const bool has_next = S.next(ui + 1, nxt);
        const char* nA = has_next ? (const char*)g.A + (size_t)nxt.pm * tstepA : cA; const char* nB = has_next ? (const char*)g.Bt + (size_t)nxt.pn * tstepB : cB;
        for (int t = 0; t < nt; t += 2) {
            const bool last = (t == nt - 2);
            const char* a1 = cA + (size_t)(t + 1) * kstep;
            const char* a2 = last ? nA : cA + (size_t)(t + 2) * kstep; const char* b2 = last ? nB : cB + (size_t)(t + 2) * kstep;
            const char* a3 = a2 + kstep; const char* b3 = b2 + kstep;
            if (last && has_next) S.a_ready(nxt);
            if constexpr (SP2) {
            PG8_LDB(B0, 0, 0); PG8_LDB(B1, 0, 1); PG8_SCHED; PG8_LDA(At, 0, 0); PG8_STAGE(PG8_SA(1, 1), a1 + hstepA, voffA);
            PG8_WAIT_V(8); PG8_WAIT_L(0); PG8_BAR; PG8_MMA(0, 0, At, B0); PG8_MMA(0, 1, At, B1); PG8_BAR; PG8_SCHED;
            PG8_LDA(At, 0, 1); PG8_STAGE(PG8_SB(0, 0), b2, voffB); PG8_STAGE(PG8_SB(0, 1), b2 + hstepB, voffB); PG8_STAGE(PG8_SA(0, 0), a2, voffA);
            PG8_WAIT_V(8); PG8_WAIT_L(0); PG8_BAR; PG8_MMA(1, 0, At, B0); PG8_MMA(1, 1, At, B1); PG8_BAR; PG8_SCHED;
            PG8_LDB(B0, 1, 0); PG8_LDB(B1, 1, 1); PG8_SCHED; PG8_LDA(At, 1, 0); PG8_STAGE(PG8_SA(0, 1), a2 + hstepA, voffA);
            PG8_WAIT_V(8); PG8_WAIT_L(0); PG8_BAR; PG8_MMA(0, 0, At, B0); PG8_MMA(0, 1, At, B1); PG8_BAR; PG8_SCHED;
            PG8_LDA(At, 1, 1); PG8_STAGE(PG8_SB(1, 0), b3, voffB); PG8_STAGE(PG8_SB(1, 1), b3 + hstepB, voffB); PG8_STAGE(PG8_SA(1, 0), a3, voffA);
            PG8_WAIT_V(8); PG8_WAIT_L(0); PG8_BAR; PG8_MMA(1, 0, At, B0); PG8_MMA(1, 1, At, B1); PG8_BAR; PG8_SCHED;
            } else {
            PG8_LDB(B0, 0, 0); PG8_SCHED; PG8_LDA(At, 0, 0); PG8_STAGE(PG8_SA(1, 1), a1 + hstepA, voffA);
            PG8_WAIT_L(8); PG8_BAR; PG8_WAIT_L(0); PG8_MMA(0, 0, At, B0); PG8_BAR; PG8_SCHED;
            PG8_LDB(B1, 0, 1); PG8_STAGE(PG8_SB(0, 0), b2, voffB);
            PG8_BAR; PG8_WAIT_L(0); PG8_MMA(0, 1, At, B1); PG8_BAR;
            PG8_LDA(At, 0, 1); PG8_STAGE(PG8_SA(0, 0), a2, voffA);
            PG8_BAR; PG8_WAIT_L(0); PG8_MMA(1, 0, At, B0); PG8_BAR; PG8_SCHED;
            PG8_STAGE(PG8_SB(0, 1), b2 + hstepB, voffB);
            PG8_WAIT_V(6); PG8_BAR; PG8_MMA(1, 1, At, B1); PG8_BAR;
            PG8_LDB(B0, 1, 0); PG8_SCHED; PG8_LDA(At, 1, 0); PG8_STAGE(PG8_SA(0, 1), a2 + hstepA, voffA);
            PG8_WAIT_L(8); PG8_BAR; PG8_WAIT_L(0); PG8_MMA(0, 0, At, B0); PG8_BAR; PG8_SCHED;
            PG8_LDB(B1, 1, 1); PG8_STAGE(PG8_SB(1, 0), b3, voffB);
            PG8_BAR; PG8_WAIT_L(0); PG8_MMA(0, 1, At, B1); PG8_BAR;
            PG8_LDA(At, 1, 1); PG8_STAGE(PG8_SA(1, 0), a3, voffA);
            PG8_BAR; PG8_WAIT_L(0); PG8_MMA(1, 0, At, B0); PG8_BAR; PG8_SCHED;
            PG8_STAGE(PG8_SB(1, 1), b3 + hstepB, voffB);
            PG8_WAIT_V(6); PG8_BAR; PG8_MMA(1, 1, At, B1); PG8_BAR;
            }
        }
        if constexpr (ALIGN_EPI) { if (wr == 0) PG8_BAR; }
        if constexpr (!Epi::AFTER_DRAIN) { E(acc, cur, wr, wc, fr, fq); S.done(cur); }
        if (!has_next) break;
#pragma unroll
        for (int a = 0; a < 2; ++a)
#pragma unroll
            for (int b = 0; b < 2; ++b)
#pragma unroll
                for (int m = 0; m < 4; ++m)
#pragma unroll
                    for (int n = 0; n < 2; ++n) acc[a][b][m][n] = (f32x4){0.f, 0.f, 0.f, 0.f};
        cur = nxt; cA = nA; cB = nB; ++ui;
        if constexpr (ALIGN_EPI) { if (wr == 1) PG8_BAR; }
    }
    PG8_WAIT_V(0);
    if constexpr (!ALIGN_EPI) { if (wr == 0) PG8_BAR; }
    PG8_BAR;
    if constexpr (Epi::AFTER_DRAIN) { E.fused(acc, cur, wr, wc, fr, fq, lds, wid, lane); S.done(cur); }
#undef PG8_SA
#undef PG8_SB
#undef PG8_STAGE
#undef PG8_LDA
#undef PG8_LDB
#undef PG8_MMA
#undef PG8_WAIT_V
#undef PG8_WAIT_L
#undef PG8_BAR
#undef PG8_SCHED
}
}
#define XB_TMO      128
#define XB_XCNT(j)  (256  + 64 * (j))
#define XB_XSUB(j)  (1280 + 64 * (j))
#define XB_XGEN(j)  (2304 + 64 * (j))
#define XB_TOP      3328
#define XB_TOPGEN   3392
#define XCD_BAR_WORDS 3456
#define XB_SPIN_CAP (1u << 18)

__device__ __forceinline__ unsigned xb_ld(unsigned* p)              { return __hip_atomic_load(p, __ATOMIC_RELAXED, __HIP_MEMORY_SCOPE_AGENT); }
__device__ __forceinline__ unsigned xb_add(unsigned* p, unsigned v) { return __hip_atomic_fetch_add(p, v, __ATOMIC_RELAXED, __HIP_MEMORY_SCOPE_AGENT); }
__device__ __forceinline__ unsigned xb_xcc_id() { return (unsigned)__builtin_amdgcn_s_getreg((3 << 11) | 20) & 0xFu; }
#define XB_SPIN(cond, bar) do { unsigned _sp = 0; while (cond) { __builtin_amdgcn_s_sleep(1); \
    if ((++_sp & 255u) == 0u) { if (xb_ld(&(bar)[XB_TMO])) break; if (_sp > XB_SPIN_CAP) { atomicAdd(&(bar)[XB_TMO], 1u); break; } } } } while (0)

struct XcdBarrier {
    unsigned* bar; unsigned x;
    volatile LAS unsigned* st;
};

__device__ __forceinline__ XcdBarrier xcd_barrier_post(unsigned* bar, volatile LAS unsigned* st, const bool is_t0) {
    XcdBarrier b; b.bar = bar; b.x = xb_xcc_id(); b.st = st;
    if (is_t0) (void)xb_add(&bar[XB_XCNT(b.x)], 1u);
    return b;
}
__device__ __forceinline__ void xcd_barrier_complete(unsigned* bar, unsigned x, unsigned& nloc, unsigned& nx) {
    const unsigned G = gridDim.x * gridDim.y * gridDim.z;
    unsigned sum, cnt, mine, sp = 0u;
    for (;;) {
        sum = 0u; cnt = 0u; mine = 0u;
#pragma unroll
        for (unsigned j = 0; j < 16; ++j) { const unsigned c = xb_ld(&bar[XB_XCNT(j)]); sum += c; cnt += (c > 0u) ? 1u : 0u; mine = (j == x) ? c : mine; }
        if (sum == G) break;
        __builtin_amdgcn_s_sleep(1);
        if ((++sp & 255u) == 0u) { if (xb_ld(&bar[XB_TMO])) break; if (sp > XB_SPIN_CAP) { atomicAdd(&bar[XB_TMO], 1u); break; } }
    }
    nloc = mine > 0u ? mine : 1u; nx = cnt > 0u ? cnt : 1u;
}

__device__ __forceinline__ void xcd_barrier(const XcdBarrier& b, const bool is_t0) {
    asm volatile("s_waitcnt vmcnt(0)" ::: "memory");
    __syncthreads();
    if (is_t0) {
        unsigned* bar = b.bar;
        __builtin_amdgcn_s_waitcnt(0);
        unsigned nloc = b.st[0], nx = b.st[1];
        if (nloc == 0u) { xcd_barrier_complete(bar, b.x, nloc, nx); b.st[0] = nloc; b.st[1] = nx; }
        const unsigned old = xb_add(&bar[XB_XSUB(b.x)], 1u);
        const unsigned gen = old / nloc;
        if (old + 1u == (gen + 1u) * nloc) {
            __builtin_amdgcn_fence(__ATOMIC_RELEASE, "agent");
            asm volatile("s_waitcnt vmcnt(0)" ::: "memory");
            const unsigned og = xb_add(&bar[XB_TOP], 1u);
            const unsigned tg = og / nx;
            if (og + 1u == (tg + 1u) * nx) xb_add(&bar[XB_TOPGEN], 1u);
            else XB_SPIN(xb_ld(&bar[XB_TOPGEN]) == tg, bar);
            __builtin_amdgcn_fence(__ATOMIC_ACQUIRE, "agent");
            xb_add(&bar[XB_XGEN(b.x)], 1u);
            asm volatile("s_waitcnt vmcnt(0)" ::: "memory");
        } else {
            XB_SPIN(xb_ld(&bar[XB_XGEN(b.x)]) == gen, bar);
            __builtin_amdgcn_fence(__ATOMIC_ACQUIRE, "agent");
            asm volatile("s_waitcnt vmcnt(0)" ::: "memory");
        }
    }
    __syncthreads();
}

__device__ const float ROPE_INV[128] = {1.000000000e+00f, 9.305720329e-01f, 8.659643531e-01f, 8.058421612e-01f, 7.498942614e-01f, 6.978306174e-01f, 6.493816376e-01f, 6.042963862e-01f, 5.623413324e-01f, 5.232990980e-01f, 4.869675338e-01f, 4.531583786e-01f, 4.216965139e-01f, 3.924189806e-01f, 3.651741147e-01f, 3.398208320e-01f, 3.162277639e-01f, 2.942726910e-01f, 2.738419771e-01f, 2.548296750e-01f, 2.371373773e-01f, 2.206734121e-01f, 2.053525001e-01f, 1.910953075e-01f, 1.778279394e-01f, 1.654817164e-01f, 1.539926529e-01f, 1.433012486e-01f, 1.333521307e-01f, 1.240937784e-01f, 1.154782027e-01f, 1.074607819e-01f, 1.000000015e-01f, 9.305720776e-02f, 8.659642935e-02f, 8.058421314e-02f, 7.498941571e-02f, 6.978306174e-02f, 6.493816525e-02f, 6.042964011e-02f, 5.623413250e-02f, 5.232991278e-02f, 4.869675264e-02f, 4.531583562e-02f, 4.216965288e-02f, 3.924189508e-02f, 3.651741147e-02f, 3.398208320e-02f, 3.162277490e-02f, 2.942727134e-02f, 2.738419734e-02f, 2.548296750e-02f, 2.371373773e-02f, 2.206734009e-02f, 2.053525113e-02f, 1.910952851e-02f, 1.778279431e-02f, 1.654816978e-02f, 1.539926510e-02f, 1.433012541e-02f, 1.333521493e-02f, 1.240937784e-02f, 1.154782064e-02f, 1.074607857e-02f, 9.999999776e-03f, 9.305720218e-03f, 8.659643121e-03f, 8.058422245e-03f, 7.498941850e-03f, 6.978305988e-03f, 6.493816152e-03f, 6.042963825e-03f, 5.623413250e-03f, 5.232991185e-03f, 4.869675264e-03f, 4.531583283e-03f, 4.216964822e-03f, 3.924189601e-03f, 3.651741194e-03f, 3.398208413e-03f, 3.162277630e-03f, 2.942727180e-03f, 2.738419687e-03f, 2.548296936e-03f, 2.371373586e-03f, 2.206734149e-03f, 2.053524833e-03f, 1.910952968e-03f, 1.778279431e-03f, 1.654817141e-03f, 1.539926510e-03f, 1.433012541e-03f, 1.333521446e-03f, 1.240937738e-03f, 1.154781901e-03f, 1.074607833e-03f, 1.000000047e-03f, 9.305720450e-04f, 8.659643354e-04f, 8.058421663e-04f, 7.498942432e-04f, 6.978305755e-04f, 6.493816618e-04f, 6.042963942e-04f, 5.623413017e-04f, 5.232990952e-04f, 4.869675322e-04f, 4.531583691e-04f, 4.216965172e-04f, 3.924189659e-04f, 3.651741426e-04f, 3.398208355e-04f, 3.162277571e-04f, 2.942727006e-04f, 2.738419571e-04f, 2.548296761e-04f, 2.371373703e-04f, 2.206734061e-04f, 2.053525095e-04f, 1.910952997e-04f, 1.778279402e-04f, 1.654817170e-04f, 1.539926452e-04f, 1.433012512e-04f, 1.333521504e-04f, 1.240937709e-04f, 1.154782003e-04f, 1.074607862e-04f};
#define CE_(a, b) do { const int hi_ = (a) > (b) ? (a) : (b), lo_ = (a) > (b) ? (b) : (a); (a) = hi_; (b) = lo_; } while (0)
#define SORT16(X) do { CE_(X[0], X[1]); CE_(X[2], X[3]); CE_(X[4], X[5]); CE_(X[6], X[7]); CE_(X[8], X[9]); CE_(X[10], X[11]); CE_(X[12], X[13]); CE_(X[14], X[15]); CE_(X[0], X[2]); CE_(X[1], X[3]); CE_(X[4], X[6]); CE_(X[5], X[7]); CE_(X[8], X[10]); CE_(X[9], X[11]); CE_(X[12], X[14]); CE_(X[13], X[15]); CE_(X[1], X[2]); CE_(X[5], X[6]); CE_(X[9], X[10]); CE_(X[13], X[14]); CE_(X[0], X[4]); CE_(X[1], X[5]); CE_(X[2], X[6]); CE_(X[3], X[7]); CE_(X[8], X[12]); CE_(X[9], X[13]); CE_(X[10], X[14]); CE_(X[11], X[15]); CE_(X[2], X[4]); CE_(X[3], X[5]); CE_(X[10], X[12]); CE_(X[11], X[13]); CE_(X[1], X[2]); CE_(X[3], X[4]); CE_(X[5], X[6]); CE_(X[9], X[10]); CE_(X[11], X[12]); CE_(X[13], X[14]); CE_(X[0], X[8]); CE_(X[1], X[9]); CE_(X[2], X[10]); CE_(X[3], X[11]); CE_(X[4], X[12]); CE_(X[5], X[13]); CE_(X[6], X[14]); CE_(X[7], X[15]); CE_(X[4], X[8]); CE_(X[5], X[9]); CE_(X[6], X[10]); CE_(X[7], X[11]); CE_(X[2], X[4]); CE_(X[3], X[5]); CE_(X[6], X[8]); CE_(X[7], X[9]); CE_(X[10], X[12]); CE_(X[11], X[13]); CE_(X[1], X[2]); CE_(X[3], X[4]); CE_(X[5], X[6]); CE_(X[7], X[8]); CE_(X[9], X[10]); CE_(X[11], X[12]); CE_(X[13], X[14]); } while (0)
#define BITONIC16(X) do { CE_(X[0], X[8]); CE_(X[1], X[9]); CE_(X[2], X[10]); CE_(X[3], X[11]); CE_(X[4], X[12]); CE_(X[5], X[13]); CE_(X[6], X[14]); CE_(X[7], X[15]); CE_(X[0], X[4]); CE_(X[1], X[5]); CE_(X[2], X[6]); CE_(X[3], X[7]); CE_(X[8], X[12]); CE_(X[9], X[13]); CE_(X[10], X[14]); CE_(X[11], X[15]); CE_(X[0], X[2]); CE_(X[1], X[3]); CE_(X[4], X[6]); CE_(X[5], X[7]); CE_(X[8], X[10]); CE_(X[9], X[11]); CE_(X[12], X[14]); CE_(X[13], X[15]); CE_(X[0], X[1]); CE_(X[2], X[3]); CE_(X[4], X[5]); CE_(X[6], X[7]); CE_(X[8], X[9]); CE_(X[10], X[11]); CE_(X[12], X[13]); CE_(X[14], X[15]); } while (0)
#define MERGE_PRUNE(A, B) do { A[0] = (A[0] > B[15]) ? A[0] : B[15]; A[1] = (A[1] > B[14]) ? A[1] : B[14]; A[2] = (A[2] > B[13]) ? A[2] : B[13]; A[3] = (A[3] > B[12]) ? A[3] : B[12]; A[4] = (A[4] > B[11]) ? A[4] : B[11]; A[5] = (A[5] > B[10]) ? A[5] : B[10]; A[6] = (A[6] > B[9]) ? A[6] : B[9]; A[7] = (A[7] > B[8]) ? A[7] : B[8]; A[8] = (A[8] > B[7]) ? A[8] : B[7]; A[9] = (A[9] > B[6]) ? A[9] : B[6]; A[10] = (A[10] > B[5]) ? A[10] : B[5]; A[11] = (A[11] > B[4]) ? A[11] : B[4]; A[12] = (A[12] > B[3]) ? A[12] : B[3]; A[13] = (A[13] > B[2]) ? A[13] : B[2]; A[14] = (A[14] > B[1]) ? A[14] : B[1]; A[15] = (A[15] > B[0]) ? A[15] : B[0]; BITONIC16(A); } while (0)
#ifndef PG8_SP2
#define PG8_SP2 true
#endif
#ifndef PG8_ALIGN
#define PG8_ALIGN true
#endif
constexpr int NWAVES = 8, NTHR = 512;
constexpr int D = 1024, TP = 65536, TS = 1024, T = TP + TS;
constexpr int NPH = 18;
#ifndef MK_ONE_LAUNCH
#define MK_ONE_LAUNCH 1
#endif
constexpr float LN_EPS = 1e-5f, GN_EPS = 1e-6f, ALPHA = 1.41421356237309515f;
constexpr float LOG2E = 1.4426950408889634f, LN2 = 0.6931471805599453f;
constexpr float SB_EXIT = -110.0f;
constexpr size_t O_Y = 0, O_RSP = 68157440, O_RSS = 72351744, O_KRP = 80740352, O_VRP = 147849216, O_KRS = 214958080, O_VRS = 216006656, O_END = 217055232;
constexpr size_t MiB = 1u << 20;
constexpr size_t WS_CTL = 0, CTL_ZERO_BYTES = 1 * MiB;
constexpr size_t WS_WIN = 1 * MiB, WS_WRO = 13 * MiB, WS_WQKV = 17 * MiB, WS_WSO = 23 * MiB, WS_WPQ = 25 * MiB, WS_KEYS = 33 * MiB, WS_COS = 34 * MiB, WS_SIN = 38 * MiB;
constexpr size_t WS_PU = 42 * MiB, WS_PV = 74 * MiB, WS_RS = 106 * MiB  , WS_XB = 170 * MiB, WS_M1 = 300 * MiB, WS_VG = 430 * MiB, WS_IDX = 950 * MiB, WS_GATE = 983 * MiB, WS_END = 1016 * MiB;
constexpr int CW_BAR = 4096;
#ifndef QUANT_IN_RET
#define QUANT_IN_RET 0
#endif
constexpr int LN_TAIL_ROWS0 = 92, LN_TAIL_ROWS1 = 60;
constexpr int RING_BYTES = 155648;
constexpr int LDSCTL_OFF = RING_BYTES, MISC_OFF = LDSCTL_OFF + 320;
constexpr int LDS_BYTES = 163840;

typedef unsigned short bf16;
typedef unsigned v4u __attribute__((ext_vector_type(4)));
typedef unsigned v2u __attribute__((ext_vector_type(2)));
typedef float f32x4 __attribute__((ext_vector_type(4)));
typedef float f32x2 __attribute__((ext_vector_type(2)));
typedef float f32x16 __attribute__((ext_vector_type(16)));
typedef short bf16x8 __attribute__((ext_vector_type(8)));
typedef short s16x4 __attribute__((ext_vector_type(4)));
typedef GAS unsigned gu32;
#define RLX_AGENT __ATOMIC_RELAXED, __HIP_MEMORY_SCOPE_AGENT
#define LDS_WAIT() asm volatile("s_waitcnt lgkmcnt(0)" ::: "memory")
#define VM_WAIT() asm volatile("s_waitcnt vmcnt(0)" ::: "memory")

struct Frame {
    LAS unsigned char* lds;
    volatile LAS unsigned* MISC;
    gu32* ctl;
    int wave, G;
    const float* in[16]; float* out; unsigned char* ws;
};

typedef __bf16 bf16x2_t __attribute__((ext_vector_type(2)));
__device__ __forceinline__ int lane_id() { return (int)__builtin_amdgcn_mbcnt_hi(~0u, __builtin_amdgcn_mbcnt_lo(~0u, 0u)); }
__device__ __forceinline__ unsigned pkbf(float lo, float hi) { const f32x2 v = {lo, hi}; const bf16x2_t b = __builtin_convertvector(v, bf16x2_t); return __builtin_bit_cast(unsigned, b); }
__device__ __forceinline__ float bflo(unsigned u) { return __uint_as_float(u << 16); }
__device__ __forceinline__ float bfhi(unsigned u) { return __uint_as_float(u & 0xffff0000u); }
__device__ __forceinline__ float wave_sum(float v) {
#pragma unroll
    for (int o = 1; o < 64; o <<= 1) v += __shfl_xor(v, o);
    return v;
}
__device__ __forceinline__ f32x4 mfma16(bf16x8 a, bf16x8 b, f32x4 c) { return __builtin_amdgcn_mfma_f32_16x16x32_bf16(a, b, c, 0, 0, 0); }
__device__ __forceinline__ f32x16 mfma32(bf16x8 a, bf16x8 b, f32x16 c) { return __builtin_amdgcn_mfma_f32_32x32x16_bf16(a, b, c, 0, 0, 0); }
typedef short v4i16_t __attribute__((ext_vector_type(4)));
__device__ __forceinline__ s16x4 trrd(LAS const unsigned char* p) { return __builtin_bit_cast(s16x4, __builtin_amdgcn_ds_read_tr16_b64_v4i16((LAS v4i16_t*)p)); }
__device__ __forceinline__ bf16x8 cat8(s16x4 lo, s16x4 hi) { return (bf16x8){lo[0], lo[1], lo[2], lo[3], hi[0], hi[1], hi[2], hi[3]}; }
__device__ __forceinline__ v4u ldg16(const void* ubase, unsigned voff) { return *(const GAS v4u*)((const GAS char*)ubase + voff); }
__device__ __forceinline__ int crow(int r, int hi) { return (r & 3) + 8 * (r >> 2) + 4 * hi; }

#define CW_TAIL(k) (8192 + 64 * (k))
namespace pg8 {
struct TailOrder {
    int nN, G, c;
    __device__ __forceinline__ bool next(int i, Unit& u) const { const int L = i * G + c; if (L >= 4 * nN) return false; u.pm = TP / BM + (L & 3); u.pn = L >> 2; return true; }
    __device__ __forceinline__ void a_ready(const Unit&) const {}
    __device__ __forceinline__ void done(const Unit&) const {}
};
}
__device__ __forceinline__ int tail_wgs(const Frame& F, int nN) { return 4 * nN < F.G ? 4 * nN : F.G; }
__device__ __forceinline__ void tail_publish(Frame& F, int k) {
    asm volatile("s_waitcnt vmcnt(0)" ::: "memory");
    __syncthreads();
    if (F.wave == 0 && lane_id() == 0) {
        __builtin_amdgcn_fence(__ATOMIC_RELEASE, "agent");
        asm volatile("s_waitcnt vmcnt(0)" ::: "memory");
        (void)xb_add((unsigned*)(F.ctl + CW_TAIL(k)), 1u);
    }
}
__device__ __forceinline__ void tail_wait(Frame& F, int k, int n) {
    if (F.wave == 0 && lane_id() == 0) {
        unsigned* bar = (unsigned*)(F.ctl + CW_BAR);
        XB_SPIN(xb_ld((unsigned*)(F.ctl + CW_TAIL(k))) < (unsigned)n, bar);
        __builtin_amdgcn_fence(__ATOMIC_ACQUIRE, "agent");
        asm volatile("s_waitcnt vmcnt(0)" ::: "memory");
    }
    __syncthreads();
}

__device__ __forceinline__ void tail_wait_wave(Frame& F, int k, int n) {
    unsigned* bar = (unsigned*)(F.ctl + CW_BAR); unsigned* p = (unsigned*)(F.ctl + CW_TAIL(k));
    unsigned sp = 0;
    while ((unsigned)__builtin_amdgcn_readfirstlane((int)xb_ld(p)) < (unsigned)n) {
        __builtin_amdgcn_s_sleep(2);
        if ((++sp & 255u) == 0u) { if (__builtin_amdgcn_readfirstlane((int)xb_ld(&bar[XB_TMO])) != 0) break; if (sp > XB_SPIN_CAP) { if (lane_id() == 0) atomicAdd(&bar[XB_TMO], 1u); break; } }
    }
    __builtin_amdgcn_fence(__ATOMIC_ACQUIRE, "agent");
    asm volatile("s_waitcnt vmcnt(0)" ::: "memory");
}

__device__ __forceinline__ void p0_transpose_item(const float* W, int K, int N, bf16* WT, LAS float* scr, int item, int lane) {
    const int nblk = N / 32, kb = item / nblk, nb = item % nblk, k0 = 64 * kb, n0 = 32 * nb;
#pragma unroll 8
    for (int i = 0; i < 32; ++i) { const int kk = 2 * i + (lane >> 5); scr[kk * 33 + (lane & 31)] = W[(size_t)(k0 + kk) * N + n0 + (lane & 31)]; }
    LDS_WAIT(); asm volatile("" ::: "memory");
    const int c = lane & 7;
#pragma unroll
    for (int j = 0; j < 4; ++j) { const int n = (lane >> 3) + 8 * j; const LAS float* s = scr + (8 * c) * 33 + n;
        v4u o; o.x = pkbf(s[0 * 33], s[1 * 33]); o.y = pkbf(s[2 * 33], s[3 * 33]); o.z = pkbf(s[4 * 33], s[5 * 33]); o.w = pkbf(s[6 * 33], s[7 * 33]);
        *(GAS v4u*)(WT + (size_t)(n0 + n) * K + k0 + 8 * c) = o; }
    LDS_WAIT(); asm volatile("" ::: "memory");
}
__device__ __forceinline__ void cvt_bf16_span(const float* src, bf16* dst, size_t n8, size_t gt, size_t ngt) {
    for (size_t i = gt; i < n8; i += ngt) { const f32x4 a = *(const GAS f32x4*)(src + i * 8), b = *(const GAS f32x4*)(src + i * 8 + 4);
        v4u o; o.x = pkbf(a[0], a[1]); o.y = pkbf(a[2], a[3]); o.z = pkbf(b[0], b[1]); o.w = pkbf(b[2], b[3]); *(GAS v4u*)(dst + i * 8) = o; }
}
__device__ __forceinline__ float dpp_max0(float v, const int ctrl_sel) {
    int t;
    switch (ctrl_sel) {
        case 0: t = __builtin_amdgcn_update_dpp(0, __float_as_int(v), 0x111, 0xf, 0xf, false); break;
        case 1: t = __builtin_amdgcn_update_dpp(0, __float_as_int(v), 0x112, 0xf, 0xf, false); break;
        case 2: t = __builtin_amdgcn_update_dpp(0, __float_as_int(v), 0x114, 0xf, 0xf, false); break;
        case 3: t = __builtin_amdgcn_update_dpp(0, __float_as_int(v), 0x118, 0xf, 0xf, false); break;
        case 4: t = __builtin_amdgcn_update_dpp(0, __float_as_int(v), 0x142, 0xa, 0xf, false); break;
        default: t = __builtin_amdgcn_update_dpp(0, __float_as_int(v), 0x143, 0xc, 0xf, false); break;
    }
    return __builtin_fmaxf(v, __int_as_float(t));
}
__device__ __forceinline__ float dpp_add0(float v, const int ctrl_sel) {
    int t;
    switch (ctrl_sel) {
        case 0: t = __builtin_amdgcn_update_dpp(0, __float_as_int(v), 0x111, 0xf, 0xf, false); break;
        case 1: t = __builtin_amdgcn_update_dpp(0, __float_as_int(v), 0x112, 0xf, 0xf, false); break;
        case 2: t = __builtin_amdgcn_update_dpp(0, __float_as_int(v), 0x114, 0xf, 0xf, false); break;
        case 3: t = __builtin_amdgcn_update_dpp(0, __float_as_int(v), 0x118, 0xf, 0xf, false); break;
        case 4: t = __builtin_amdgcn_update_dpp(0, __float_as_int(v), 0x142, 0xa, 0xf, false); break;
        default: t = __builtin_amdgcn_update_dpp(0, __float_as_int(v), 0x143, 0xc, 0xf, false); break;
    }
    return v + __int_as_float(t);
}
__device__ __forceinline__ float wave_sum_dpp(float v) {
    v = dpp_add0(v, 0); v = dpp_add0(v, 1); v = dpp_add0(v, 2); v = dpp_add0(v, 3); v = dpp_add0(v, 4); v = dpp_add0(v, 5);
    return __int_as_float(__builtin_amdgcn_readlane(__float_as_int(v), 63));
}
__device__ __forceinline__ float wave_max_nonneg(float m) {
    m = dpp_max0(m, 0); m = dpp_max0(m, 1); m = dpp_max0(m, 2); m = dpp_max0(m, 3); m = dpp_max0(m, 4); m = dpp_max0(m, 5);
    return __int_as_float(__builtin_amdgcn_readlane(__float_as_int(m), 63));
}
__device__ __forceinline__ void quant_row(const f32x4 (&a)[4], unsigned char* dst, float* rs, int lane) {
    float m = 0.f;
#pragma unroll
    for (int i = 0; i < 4; ++i) m = __builtin_fmaxf(m, __builtin_fmaxf(__builtin_fmaxf(__builtin_fabsf(a[i][0]), __builtin_fabsf(a[i][1])), __builtin_fmaxf(__builtin_fabsf(a[i][2]), __builtin_fabsf(a[i][3]))));
    m = wave_max_nonneg(m);
    const float scale = (m > 1e-30f) ? 6.0f / m : 1.0f, rscale = (m > 1e-30f) ? m * (1.0f / 6.0f) : 1.0f;
    v2u w;
#pragma unroll
    for (int d = 0; d < 2; ++d) { unsigned q = 0u;
        q = __builtin_amdgcn_cvt_scalef32_pk_fp4_f32(q, a[2 * d][0] * scale, a[2 * d][1] * scale, 1.0f, 0);
        q = __builtin_amdgcn_cvt_scalef32_pk_fp4_f32(q, a[2 * d][2] * scale, a[2 * d][3] * scale, 1.0f, 1);
        q = __builtin_amdgcn_cvt_scalef32_pk_fp4_f32(q, a[2 * d + 1][0] * scale, a[2 * d + 1][1] * scale, 1.0f, 2);
        q = __builtin_amdgcn_cvt_scalef32_pk_fp4_f32(q, a[2 * d + 1][2] * scale, a[2 * d + 1][3] * scale, 1.0f, 3);
        w[d] = q; }
    *(GAS v2u*)(dst + 8 * lane) = w;
    if (lane == 0) *rs = rscale;
}
__device__ __forceinline__ void quant_row_c(const f32x4 (&a)[4], unsigned char* dst, float* rs, int lane) {
    float m = 0.f;
#pragma unroll
    for (int i = 0; i < 4; ++i) m = __builtin_fmaxf(m, __builtin_fmaxf(__builtin_fmaxf(__builtin_fabsf(a[i][0]), __builtin_fabsf(a[i][1])), __builtin_fmaxf(__builtin_fabsf(a[i][2]), __builtin_fabsf(a[i][3]))));
    m = wave_max_nonneg(m);
    const float scale = (m > 1e-30f) ? 6.0f / m : 1.0f, rscale = (m > 1e-30f) ? m * (1.0f / 6.0f) : 1.0f;
#pragma unroll
    for (int i = 0; i < 4; ++i) { unsigned q = 0u;
        q = __builtin_amdgcn_cvt_scalef32_pk_fp4_f32(q, a[i][0] * scale, a[i][1] * scale, 1.0f, 0);
        q = __builtin_amdgcn_cvt_scalef32_pk_fp4_f32(q, a[i][2] * scale, a[i][3] * scale, 1.0f, 1);
        *(GAS unsigned short*)(dst + 128 * i + 2 * lane) = (unsigned short)(q & 0xffffu); }
    if (lane == 0) *rs = rscale;
}
__device__ __forceinline__ const float* qrow_src(const Frame& F, int R) { return ((R >> 15) ? F.in[13] : F.in[12]) + (size_t)(R & 32767) * 1024; }
__device__ __forceinline__ unsigned char* qrow_dst(const Frame& F, int R) { return F.ws + ((R >> 15) ? WS_PV : WS_PU) + (size_t)(R & 32767) * 512; }
__device__ __forceinline__ float* qrow_rs(const Frame& F, int R) { return (float*)(F.ws + WS_RS) + (size_t)((R >> 14) & 1) * 32768 + (size_t)(R & 16383) * 2 + (R >> 15); }
__device__ __forceinline__ void sincos_d(double a, double& s, double& c) {
    const double kq = __builtin_rint(a * 0.63661977236758134308);
    const double y = (a - kq * 1.57079632673412561417e+00) - kq * 6.07710050650619224932e-11;
    const double y2 = y * y;
    const double sp = y * (1.0 + y2 * (-1.0 / 6 + y2 * (1.0 / 120 + y2 * (-1.0 / 5040 + y2 * (1.0 / 362880 + y2 * (-1.0 / 39916800 + y2 * (1.0 / 6227020800.0 + y2 * (-1.0 / 1307674368000.0))))))));
    const double cp = 1.0 + y2 * (-0.5 + y2 * (1.0 / 24 + y2 * (-1.0 / 720 + y2 * (1.0 / 40320 + y2 * (-1.0 / 3628800 + y2 * (1.0 / 479001600 + y2 * (-1.0 / 87178291200.0 + y2 * (1.0 / 20922789888000.0))))))));
    const int k = (int)kq & 3;
    s = (k == 0) ? sp : (k == 1) ? cp : (k == 2) ? -sp : -cp;
    c = (k == 0) ? cp : (k == 1) ? -sp : (k == 2) ? -cp : sp;
}
__device__ __forceinline__ void p0_prologue(Frame& F) {
    LAS float* scr = (LAS float*)(F.lds + F.wave * 16384);
    const int gw = blockIdx.x * NWAVES + F.wave, NGW = F.G * NWAVES;
    const float* ret_w_in = F.in[5]; const float* ret_w_o = F.in[6]; const float* sb_w_qkv = F.in[7]; const float* sb_w_o = F.in[8]; const float* peer_w_q = F.in[9];
    constexpr int I_IN = (1024 / 64) * (6144 / 32), I_RO = (2048 / 64) * (1024 / 32), I_QKV = (1024 / 64) * (3072 / 32), I_SO = (1024 / 64) * (1024 / 32), I_PQ = (1024 / 64) * (2048 / 32);
    constexpr int NITEMS = I_IN + I_RO + I_QKV + I_SO + 2 * I_PQ;
    for (int it = gw; it < NITEMS; it += NGW) {
        int r = it;
        if (r < I_IN) { p0_transpose_item(ret_w_in, 1024, 6144, (bf16*)(F.ws + WS_WIN), scr, r, lane_id()); continue; } r -= I_IN;
        if (r < I_RO) { p0_transpose_item(ret_w_o, 2048, 1024, (bf16*)(F.ws + WS_WRO), scr, r, lane_id()); continue; } r -= I_RO;
        if (r < I_QKV) { p0_transpose_item(sb_w_qkv, 1024, 3072, (bf16*)(F.ws + WS_WQKV), scr, r, lane_id()); continue; } r -= I_QKV;
        if (r < I_SO) { p0_transpose_item(sb_w_o, 1024, 1024, (bf16*)(F.ws + WS_WSO), scr, r, lane_id()); continue; } r -= I_SO;
        if (r < I_PQ) { p0_transpose_item(peer_w_q, 1024, 2048, (bf16*)(F.ws + WS_WPQ), scr, r, lane_id()); continue; } r -= I_PQ;
        p0_transpose_item(peer_w_q + (size_t)1024 * 2048, 1024, 2048, (bf16*)(F.ws + WS_WPQ + 4 * MiB), scr, r, lane_id());
    }
    const size_t gt = (size_t)blockIdx.x * NTHR + (F.wave * 64 + lane_id()), ngt = (size_t)F.G * NTHR;
    cvt_bf16_span(F.in[10], (bf16*)(F.ws + WS_KEYS), 131072 / 8, gt, ngt);
    cvt_bf16_span(F.in[11], (bf16*)(F.ws + WS_KEYS + 256 * 1024), 131072 / 8, gt, ngt);
    cvt_bf16_span(F.in[10] + 131072, (bf16*)(F.ws + WS_KEYS + 512 * 1024), 131072 / 8, gt, ngt);
    cvt_bf16_span(F.in[11] + 131072, (bf16*)(F.ws + WS_KEYS + 768 * 1024), 131072 / 8, gt, ngt);
#if !QUANT_IN_RET
    for (int R = gw; R < 65536; R += NGW) { f32x4 qa[4]; const float* qs = qrow_src(F, R) + 4 * lane_id();
#pragma unroll
        for (int i = 0; i < 4; ++i) qa[i] = __builtin_nontemporal_load((const GAS f32x4*)(qs + 256 * i));
        quant_row_c(qa, qrow_dst(F, R), qrow_rs(F, R), lane_id()); }
#endif
    cvt_bf16_span(F.in[0], (bf16*)(F.ws + WS_XB), (size_t)TP * D / 8, gt, ngt);
    cvt_bf16_span(F.in[1], (bf16*)(F.ws + WS_XB) + (size_t)TP * D, (size_t)TS * D / 8, gt, ngt);
    float* cosT = (float*)(F.ws + WS_COS); float* sinT = (float*)(F.ws + WS_SIN);
    for (size_t i = gt; i < (size_t)8192 * 128; i += ngt) {
        const int pos = (int)(i >> 7), fi = (int)(i & 127);
        const float inv = ROPE_INV[fi];
        const float ang = (float)pos * inv;
        double s, c; sincos_d((double)ang, s, c);
        cosT[i] = (float)c; sinT[i] = (float)s;
    }
}

__device__ __forceinline__ void ret_phase(Frame& F) {
    constexpr int QS = 0, KS = 33792, SS = 67584, VS = 101376, AS = 110592;
    LAS unsigned char* lds = F.lds;
    const int lane = lane_id(), tid = F.wave * 64 + lane, w = F.wave, fr = lane & 15, q4 = lane >> 4;
    const bf16* QK = (const bf16*)(F.out + O_KRP);
    bf16* VG = (bf16*)(F.ws + WS_VG);
    const int RPW = (65536 + F.G - 1) / F.G, qr0 = (int)blockIdx.x * RPW, qr1 = (qr0 + RPW < 65536) ? qr0 + RPW : 65536;
    const int RPC = (RPW + 127) / 128 < NWAVES ? (RPW + 127) / 128 : NWAVES;
    int qnext = qr0;
    for (int item = blockIdx.x; item < 768; item += F.G) {
        int bh, es, nchunk; size_t row0; const float* S0; float* Sout;
        if (item < 256) { bh = item & 31; es = item >> 5; nchunk = 128; row0 = (size_t)(bh >> 2) * 8192; S0 = nullptr; Sout = F.out + O_RSP + (size_t)bh * 131072; }
        else { const int it = item - 256; bh = it & 63; es = it >> 6; nchunk = 1; row0 = 65536 + (size_t)(bh >> 2) * 64; S0 = F.in[2] + (size_t)bh * 131072; Sout = F.out + O_RSS + (size_t)bh * 131072; }
        const int h = bh & 3;
        const float l2g = __builtin_amdgcn_logf(1.0f - __builtin_amdgcn_exp2f(-5.0f - (float)h));
        const float gam = __builtin_amdgcn_exp2f(l2g), gam64 = __builtin_amdgcn_exp2f(64.0f * l2g), rgam = __builtin_amdgcn_exp2f(-l2g);
        f32x4 S[2][4];
#pragma unroll
        for (int dl = 0; dl < 2; ++dl)
#pragma unroll
            for (int et = 0; et < 4; ++et) {
                f32x4 v = (f32x4){0.f, 0.f, 0.f, 0.f};
                if (S0) {
#pragma unroll
                    for (int j = 0; j < 4; ++j) v[j] = gam * S0[(size_t)(32 * w + 16 * dl + 4 * q4 + j) * 512 + es * 64 + et * 16 + fr];
                }
                S[dl][et] = v;
                v2u pk; pk.x = pkbf(v[0], v[1]); pk.y = pkbf(v[2], v[3]);
                *(LAS v2u*)(lds + SS + (et * 16 + fr) * 528 + (32 * w + 16 * dl + 4 * q4) * 2) = pk;
            }
        v4u pqA[4], pkA[4], pvA;
        const bf16* qbase = QK + row0 * 2048 + h * 256;
        bf16* vbase = VG + row0 * 4096 + h * 512 + es * 64;
#define RET_LOAD(c) do { _Pragma("unroll") for (int i_ = 0; i_ < 4; ++i_) { const int p_ = tid + 512 * i_; const bf16* s_ = qbase + (size_t)((c) * 64 + (p_ >> 5)) * 2048 + (p_ & 31) * 8; \
            pq[i_] = *(const GAS v4u*)s_; pk4[i_] = *(const GAS v4u*)(s_ + 1024); } \
            pv = *(const GAS v4u*)(vbase + (size_t)((c) * 64 + (tid >> 3)) * 4096 + (tid & 7) * 8); } while (0)
        { v4u (&pq)[4] = pqA; v4u (&pk4)[4] = pkA; v4u& pv = pvA; RET_LOAD(0); }
        auto chunk = [&](const int c, v4u (&pq)[4], v4u (&pk4)[4], v4u& pv) __attribute__((always_inline)) {
            __syncthreads();
#pragma unroll
            for (int i = 0; i < 4; ++i) { const int p = tid + 512 * i; const int off = (p >> 5) * 528 + (p & 31) * 16;
                *(LAS v4u*)(lds + QS + off) = pq[i]; *(LAS v4u*)(lds + KS + off) = pk4[i]; }
            *(LAS v4u*)(lds + VS + (tid >> 3) * 144 + (tid & 7) * 16) = pv;
            if (c + 1 < nchunk) RET_LOAD(c + 1);
            f32x4 qa[4]; int qR = -1;
            if (QUANT_IN_RET && nchunk > 1) { const int jw = (w - RPC * c) & 7; if (jw < RPC && qnext + jw < qr1) qR = qnext + jw; qnext += RPC; }
            if (qR >= 0) { const float* qs = qrow_src(F, qR) + 16 * lane;
#pragma unroll
                for (int i = 0; i < 4; ++i) qa[i] = __builtin_nontemporal_load((const f32x4*)(qs + 4 * i)); }
            __syncthreads();
            const int nt4 = w >> 1;
            bf16x8 qf[8];
#pragma unroll
            for (int ks = 0; ks < 8; ++ks) qf[ks] = *(const LAS bf16x8*)(lds + QS + (nt4 * 16 + fr) * 528 + (32 * ks + 8 * q4) * 2);
#pragma unroll
            for (int tt = 0; tt < 2; ++tt) { const int mt = 2 * (w & 1) + tt;
                f32x4 at = (f32x4){0.f, 0.f, 0.f, 0.f};
                if (mt <= nt4) {
#pragma unroll
                    for (int ks = 0; ks < 8; ++ks) { const bf16x8 ka = *(const LAS bf16x8*)(lds + KS + (mt * 16 + fr) * 528 + (32 * ks + 8 * q4) * 2); at = mfma16(ka, qf[ks], at); }
                }
                const int n = nt4 * 16 + fr; float v[4];
#pragma unroll
                for (int j = 0; j < 4; ++j) { const int m = mt * 16 + 4 * q4 + j; v[j] = (n >= m) ? at[j] : 0.f; }
                v2u pk; pk.x = pkbf(v[0], v[1]); pk.y = pkbf(v[2], v[3]);
                *(LAS v2u*)(lds + AS + n * 144 + (mt * 16 + 4 * q4) * 2) = pk; }
            f32x4 o[2] = {(f32x4){0.f, 0.f, 0.f, 0.f}, (f32x4){0.f, 0.f, 0.f, 0.f}};
#pragma unroll
            for (int ks = 0; ks < 8; ++ks) {
#pragma unroll
                for (int tt = 0; tt < 2; ++tt) { const int et = 2 * (w & 1) + tt;
                    const bf16x8 sb = *(const LAS bf16x8*)(lds + SS + (et * 16 + fr) * 528 + (32 * ks + 8 * q4) * 2);
                    o[tt] = mfma16(qf[ks], sb, o[tt]); }
            }
            __syncthreads();
#pragma unroll
            for (int ks = 0; ks < 2; ++ks) {
                if (ks == 1 && nt4 < 2) continue;
                const bf16x8 aa = *(const LAS bf16x8*)(lds + AS + (nt4 * 16 + fr) * 144 + (32 * ks + 8 * q4) * 2);
                const int m0 = 32 * ks + 8 * q4 + (fr >> 2);
#pragma unroll
                for (int tt = 0; tt < 2; ++tt) { const int et = 2 * (w & 1) + tt;
                    const s16x4 lo = trrd(lds + VS + m0 * 144 + et * 32 + 8 * (fr & 3)), hi = trrd(lds + VS + (m0 + 4) * 144 + et * 32 + 8 * (fr & 3));
                    o[tt] = mfma16(aa, cat8(lo, hi), o[tt]); }
            }
#pragma unroll
            for (int tt = 0; tt < 2; ++tt) { const int e = (2 * (w & 1) + tt) * 16 + fr;
#pragma unroll
                for (int j = 0; j < 4; ++j) { const int n = nt4 * 16 + 4 * q4 + j; vbase[(size_t)(c * 64 + n) * 4096 + e] = (bf16)(pkbf(o[tt][j], 0.f) & 0xffffu); } }
#pragma unroll
            for (int ks = 0; ks < 2; ++ks) {
                const int m0 = 32 * ks + 8 * q4 + (fr >> 2);
                bf16x8 ka[2], vb[4];
#pragma unroll
                for (int dl = 0; dl < 2; ++dl) { const int dt = 2 * w + dl;
                    ka[dl] = cat8(trrd(lds + KS + m0 * 528 + dt * 32 + 8 * (fr & 3)), trrd(lds + KS + (m0 + 4) * 528 + dt * 32 + 8 * (fr & 3))); }
#pragma unroll
                for (int et = 0; et < 4; ++et) vb[et] = cat8(trrd(lds + VS + m0 * 144 + et * 32 + 8 * (fr & 3)), trrd(lds + VS + (m0 + 4) * 144 + et * 32 + 8 * (fr & 3)));
#pragma unroll
                for (int dl = 0; dl < 2; ++dl)
#pragma unroll
                    for (int et = 0; et < 4; ++et) S[dl][et] = mfma16(ka[dl], vb[et], S[dl][et]);
            }
#pragma unroll
            for (int dl = 0; dl < 2; ++dl)
#pragma unroll
                for (int et = 0; et < 4; ++et) { S[dl][et] *= gam64; v2u pk; pk.x = pkbf(S[dl][et][0], S[dl][et][1]); pk.y = pkbf(S[dl][et][2], S[dl][et][3]);
                    *(LAS v2u*)(lds + SS + (et * 16 + fr) * 528 + (32 * w + 16 * dl + 4 * q4) * 2) = pk; }
            if (qR >= 0) quant_row(qa, qrow_dst(F, qR), qrow_rs(F, qR), lane);
        };
        for (int c = 0; c < nchunk; ++c) chunk(c, pqA, pkA, pvA);
#undef RET_LOAD
#pragma unroll
        for (int dl = 0; dl < 2; ++dl)
#pragma unroll
            for (int et = 0; et < 4; ++et)
#pragma unroll
                for (int j = 0; j < 4; ++j) Sout[(size_t)(32 * w + 16 * dl + 4 * q4 + j) * 512 + es * 64 + et * 16 + fr] = S[dl][et][j] * rgam;
        __syncthreads();
    }
    if (qnext < qr0) qnext = qr0;
    if (QUANT_IN_RET) for (int R = qnext + w; R < qr1; R += NWAVES) { f32x4 qa[4]; const float* qs = qrow_src(F, R) + 16 * lane;
#pragma unroll
        for (int i = 0; i < 4; ++i) qa[i] = *(const GAS f32x4*)(qs + 4 * i);
        quant_row(qa, qrow_dst(F, R), qrow_rs(F, R), lane); }
}

__device__ __forceinline__ void gn_gate_phase(Frame& F) {
    bf16* VG = (bf16*)(F.ws + WS_VG);
    const int gw = blockIdx.x * NWAVES + F.wave, NGW = F.G * NWAVES, lane = lane_id();
    for (int t0 = gw; t0 < T; t0 += 2 * NGW) {
        const bool two = t0 + NGW < T;
        v4u ov[2][4], gv[2][4];
#pragma unroll
        for (int u = 0; u < 2; ++u) if (u == 0 || two) { const bf16* orow = VG + (size_t)(t0 + u * NGW) * 4096 + lane * 8;
#pragma unroll
            for (int i = 0; i < 4; ++i) { ov[u][i] = __builtin_nontemporal_load((const v4u*)(orow + 512 * i)); gv[u][i] = __builtin_nontemporal_load((const v4u*)(orow + 2048 + 512 * i)); } }
#pragma unroll
        for (int u = 0; u < 2; ++u) if (u == 0 || two) {
            bf16* orow = VG + (size_t)(t0 + u * NGW) * 4096 + lane * 8;
#pragma unroll
            for (int i = 0; i < 4; ++i) {
                float o[8];
#pragma unroll
                for (int k = 0; k < 4; ++k) { o[2 * k] = bflo(ov[u][i][k]); o[2 * k + 1] = bfhi(ov[u][i][k]); }
                float s = ((o[0] + o[1]) + (o[2] + o[3])) + ((o[4] + o[5]) + (o[6] + o[7]));
                const float mu = wave_sum_dpp(s) * (1.0f / 512.0f);
                float q = 0.f;
#pragma unroll
                for (int k = 0; k < 8; ++k) { o[k] -= mu; q += o[k] * o[k]; }
                const float rstd = __builtin_amdgcn_rsqf(wave_sum_dpp(q) * (1.0f / 512.0f) + GN_EPS);
                v4u w;
#pragma unroll
                for (int k = 0; k < 4; ++k) {
                    const float g0 = bflo(gv[u][i][k]), g1 = bfhi(gv[u][i][k]);
                    const float s0 = g0 * __builtin_amdgcn_rcpf(1.0f + __builtin_amdgcn_exp2f(-g0 * LOG2E)), s1 = g1 * __builtin_amdgcn_rcpf(1.0f + __builtin_amdgcn_exp2f(-g1 * LOG2E));
                    w[k] = pkbf(s0 * o[2 * k] * rstd, s1 * o[2 * k + 1] * rstd);
                }
                *(GAS v4u*)(orow + 512 * i) = w;
            }
        }
    }
}

__device__ __forceinline__ void ln_rows2(Frame& F, int layer, const f32x4 (&gg)[4], const f32x4 (&bb)[4], int ta, int tb, bool two, int lane) {
    const bf16* M1 = (const bf16*)(F.ws + WS_M1); bf16* XB = (bf16*)(F.ws + WS_XB);
    f32x4 xv[2][4]; v2u mv[2][4];
#pragma unroll
    for (int u = 0; u < 2; ++u) if (u == 0 || two) { const int t = u ? tb : ta;
        if (layer == 0) { const float* xrow = (t < TP ? F.in[0] + (size_t)t * D : F.in[1] + (size_t)(t - TP) * D);
#pragma unroll
            for (int j = 0; j < 4; ++j) xv[u][j] = __builtin_nontemporal_load((const f32x4*)(xrow + 4 * lane + 256 * j)); }
        else {
#pragma unroll
            for (int j = 0; j < 4; ++j) { const v2u xb = *(const GAS v2u*)(XB + (size_t)t * D + 4 * lane + 256 * j); xv[u][j] = (f32x4){bflo(xb.x), bfhi(xb.x), bflo(xb.y), bfhi(xb.y)}; } }
#pragma unroll
        for (int j = 0; j < 4; ++j) mv[u][j] = __builtin_nontemporal_load((const v2u*)(M1 + (size_t)t * D + 4 * lane + 256 * j)); }
#pragma unroll
    for (int u = 0; u < 2; ++u) if (u == 0 || two) { const int t = u ? tb : ta;
        f32x4 v[4]; float s = 0.f;
#pragma unroll
        for (int j = 0; j < 4; ++j) { v[j] = xv[u][j] * ALPHA + (f32x4){bflo(mv[u][j].x), bfhi(mv[u][j].x), bflo(mv[u][j].y), bfhi(mv[u][j].y)}; s += (v[j][0] + v[j][1]) + (v[j][2] + v[j][3]); }
        const float mean = wave_sum_dpp(s) * (1.0f / D); float s2 = 0.f;
#pragma unroll
        for (int j = 0; j < 4; ++j) { v[j] = v[j] - mean; s2 += (v[j][0] * v[j][0] + v[j][1] * v[j][1]) + (v[j][2] * v[j][2] + v[j][3] * v[j][3]); }
        const float rstd = __builtin_amdgcn_rsqf(wave_sum_dpp(s2) * (1.0f / D) + LN_EPS);
#pragma unroll
        for (int j = 0; j < 4; ++j) { const f32x4 y = v[j] * rstd * gg[j] + bb[j];
            v2u o; o.x = pkbf(y[0], y[1]); o.y = pkbf(y[2], y[3]); *(GAS v2u*)(XB + (size_t)t * D + 4 * lane + 256 * j) = o; }
    }
}
__device__ __forceinline__ void ln_phase(Frame& F, int layer, int seam, int drows) {
    const float* gam = F.in[14] + (size_t)(layer * 2 + 0) * D; const float* bet = F.in[15] + (size_t)(layer * 2 + 0) * D;
    const int lane = lane_id(), c = (int)blockIdx.x;
    f32x4 gg[4], bb[4];
#pragma unroll
    for (int j = 0; j < 4; ++j) { gg[j] = *(const GAS f32x4*)(gam + 4 * lane + 256 * j); bb[j] = *(const GAS f32x4*)(bet + 4 * lane + 256 * j); }
    const int ntw = tail_wgs(F, 4);
    const int d = (F.G >= 64) ? drows : 0;
    const int qn = (TP + ntw * d + F.G - 1) / F.G, qt = qn - d;
    int r0 = (c < ntw) ? c * qt : ntw * qt + (c - ntw) * qn, r1 = r0 + ((c < ntw) ? qt : qn);
    r0 = r0 < TP ? r0 : TP; r1 = r1 < TP ? r1 : TP;
    for (int t = r0 + F.wave; t < r1; t += 2 * NWAVES) ln_rows2(F, layer, gg, bb, t, t + NWAVES, t + NWAVES < r1, lane);
    tail_wait(F, seam, ntw);
    for (int t = TP + F.wave * F.G + c; t < T; t += NWAVES * F.G) ln_rows2(F, layer, gg, bb, t, t, false, lane);
}

__device__ __forceinline__ int f2key(float s) { const int u = __float_as_int(s); return u ^ ((u >> 31) & 0x7fffffff); }
__device__ __forceinline__ float key2f(int k) { return __int_as_float(k ^ ((k >> 31) & 0x7fffffff)); }
__device__ __forceinline__ int med3i(int a, int b, int c) { int r; asm("v_med3_i32 %0, %1, %2, %3" : "=v"(r) : "v"(a), "v"(b), "v"(c)); return r; }
__device__ __forceinline__ int maxi(int a, int b) { return a > b ? a : b; }
#define KEY_NEG_INF ((int)0x80000000)
#define TOPK_INSERT(L, x) do { _Pragma("unroll") for (int i_ = 15; i_ >= 1; --i_) L[i_] = med3i(L[i_ - 1], L[i_], (x)); L[0] = maxi(L[0], (x)); } while (0)
#define TK_DMA(rsrc_, reg_, dv_, rowstride_, sbase_) do { _Pragma("unroll") for (int i_ = 0; i_ < 8; ++i_) \
        __builtin_amdgcn_raw_ptr_buffer_load_lds((rsrc_), (LAS void*)((reg_) + i_ * 1024), 16, (dv_)[i_ & 1], (sbase_) + 8 * (i_ & 3) * (rowstride_) + 128 * (i_ >> 2), 0, 0); } while (0)
#define TK_FRAGS(dst_, rega_) do { const unsigned a0_ = (rega_) + rd[0], a1_ = (rega_) + rd[1], a2_ = (rega_) + rd[2], a3_ = (rega_) + rd[3]; v4u f_[8]; \
        asm volatile("s_waitcnt vmcnt(0)\n\tds_read_b128 %0, %8\n\tds_read_b128 %1, %9\n\tds_read_b128 %2, %10\n\tds_read_b128 %3, %11\n\t" \
                     "ds_read_b128 %4, %8 offset:4096\n\tds_read_b128 %5, %9 offset:4096\n\tds_read_b128 %6, %10 offset:4096\n\tds_read_b128 %7, %11 offset:4096\n\ts_waitcnt lgkmcnt(0)" \
                     : "=&v"(f_[0]), "=&v"(f_[1]), "=&v"(f_[2]), "=&v"(f_[3]), "=&v"(f_[4]), "=&v"(f_[5]), "=&v"(f_[6]), "=&v"(f_[7]) : "v"(a0_), "v"(a1_), "v"(a2_), "v"(a3_) : "memory"); \
        _Pragma("unroll") for (int ks = 0; ks < 8; ++ks) dst_[ks] = __builtin_bit_cast(bf16x8, f_[ks]); } while (0)
__device__ __forceinline__ void topk_pass(const __amdgpu_buffer_rsrc_t rsrcQ, const __amdgpu_buffer_rsrc_t rsrcK, int t0, int h, int lane, LAS unsigned char* wl, int (&La)[16], int (&Lb)[16]) {
    const int r = lane & 31, h2 = lane >> 5;
    const int h2x4 = 4 * h2;
    const unsigned qreg_a = (unsigned)(size_t)wl, kreg_a = qreg_a + 8448u;
    unsigned rd[4];
#pragma unroll
    for (int q = 0; q < 4; ++q) rd[q] = (unsigned)(r * 128 + 16 * ((2 * q + h2) ^ ((r >> 1) & 7)));
    int dvK[2], dvQ[2];
#pragma unroll
    for (int b = 0; b < 2; ++b) { const int ch = 16 * ((lane & 7) ^ ((lane >> 4) + 4 * b)); dvK[b] = (lane >> 3) * 256 + ch; dvQ[b] = (lane >> 3) * 4096 + ch; }
#pragma unroll
    for (int half = 0; half < 2; ++half) {
        bf16x8 qf[8];
        int zs = 0; asm volatile("" : "+s"(zs));
        const int qs = t0 * 4096 + h * 512 + half * 256 + zs;
        const int kbs = half * 262144 + h * 32768 + zs;
        if (half == 0) { TK_DMA(rsrcQ, wl, dvQ, 4096, qs); TK_DMA(rsrcK, wl + 8448, dvK, 256, kbs); }
        bf16x8 kf[8];
        TK_FRAGS(qf, qreg_a);
        TK_FRAGS(kf, kreg_a);
        if (half == 0) TK_DMA(rsrcQ, wl, dvQ, 4096, qs + 256);
        int L[16];
#pragma unroll
        for (int tile = 0; tile < 4; ++tile) {
            if (tile < 3) TK_DMA(rsrcK, wl + 8448, dvK, 256, kbs + (tile + 1) * 8192);
            else if (half == 0) TK_DMA(rsrcK, wl + 8448, dvK, 256, kbs + 262144);
            f32x16 acc;
#pragma unroll
            for (int i = 0; i < 16; ++i) acc[i] = 0.f;
#pragma unroll
            for (int ks = 0; ks < 8; ++ks) acc = mfma32(kf[ks], qf[ks], acc);
            __builtin_amdgcn_sched_barrier(0);
            int Kt[16];
#pragma unroll
            for (int i = 0; i < 16; ++i) Kt[i] = ((f2key(acc[i]) & ~127) | (127 - (32 * tile + (i & 3) + 8 * (i >> 2)))) - h2x4;
            SORT16(Kt);
            if (tile == 0) {
#pragma unroll
                for (int i = 0; i < 16; ++i) L[i] = Kt[i];
            } else MERGE_PRUNE(L, Kt);
            __builtin_amdgcn_sched_barrier(0);
            if (tile < 3) TK_FRAGS(kf, kreg_a);
        }
        int A[16], B[16];
#pragma unroll
        for (int i = 0; i < 16; ++i) { auto rr = __builtin_amdgcn_permlane32_swap((unsigned)L[i], (unsigned)L[i], false, false); A[i] = (int)rr[0]; B[i] = (int)rr[1]; }
        MERGE_PRUNE(A, B);
#pragma unroll
        for (int i = 0; i < 16; ++i) { if (half == 0) La[i] = A[i]; else Lb[i] = A[i]; }
        __builtin_amdgcn_sched_barrier(0);
    }
}
__device__ __forceinline__ void topk_phase(Frame& F, int layer, int seam) {
    const bf16* QP = (const bf16*)(F.ws + WS_VG);
    const bf16* KEYS = (const bf16*)(F.ws + WS_KEYS + (size_t)layer * 512 * 1024);
    int* IDX = (int*)(F.ws + WS_IDX); float* GATE = (float*)(F.ws + WS_GATE);
    const int lane = lane_id(), h = F.wave;
    LAS unsigned char* wl = F.lds + h * 19456;
    LAS unsigned* tab = (LAS unsigned*)wl + lane * 33;
    const __amdgpu_buffer_rsrc_t rsrcQ = __builtin_amdgcn_make_buffer_rsrc((void*)QP, 0, T * 4096, 0x00020000);
    const __amdgpu_buffer_rsrc_t rsrcK = __builtin_amdgcn_make_buffer_rsrc((void*)KEYS, 0, 512 * 1024, 0x00020000);
    constexpr int NBP = TP / 32, NBS = TS / 32;
    const int cwg = (int)blockIdx.x, ntw = tail_wgs(F, 8);
    const int npair = cwg < NBP ? (NBP - cwg + 2 * F.G - 1) / (2 * F.G) : 0;
    const int j0 = (cwg - ntw + F.G) % F.G, nsamp = j0 < NBS ? (NBS - j0 + F.G - 1) / F.G : 0;
    for (int it = 0; it < npair + nsamp; ++it) {
        int bA, bB; bool two;
        if (it < npair) { bA = cwg + it * 2 * F.G; bB = bA + F.G; two = bB < NBP; }
        else { if (it == npair) tail_wait(F, seam, ntw); bA = NBP + j0 + (it - npair) * F.G; bB = bA; two = false; }
        int La[16], Lb[16];
        topk_pass(rsrcQ, rsrcK, 32 * bA, h, lane, wl, La, Lb);
        if (two) { int La2[16], Lb2[16];
            topk_pass(rsrcQ, rsrcK, 32 * bB, h, lane, wl, La2, Lb2);
#pragma unroll
            for (int i = 0; i < 16; ++i) { La[i] = (lane < 32) ? La[i] : La2[i]; Lb[i] = (lane < 32) ? Lb[i] : Lb2[i]; } }
        const int t = (lane < 32) ? 32 * bA + lane : 32 * bB + (lane - 32);
        float va[16], vb[16];
#pragma unroll
        for (int i = 0; i < 16; ++i) { va[i] = key2f(La[i] & ~127); vb[i] = key2f(Lb[i] & ~127); }
        int C[16];
#pragma unroll
        for (int j = 0; j < 16; ++j) C[j] = (f2key(va[0] + vb[j]) & ~255) | (255 - j);
#pragma unroll
        for (int i = 1; i < 16; ++i)
#pragma unroll
            for (int j = 0; j < 16; ++j)
                if ((i + 1) * (j + 1) <= 16) { const int x = (f2key(va[i] + vb[j]) & ~255) | (255 - (i * 16 + j)); TOPK_INSERT(C, x); }
#pragma unroll
        for (int i = 0; i < 16; ++i) { tab[i] = 127u - (unsigned)(La[i] & 127); tab[16 + i] = 127u - (unsigned)(Lb[i] & 127); }
        LDS_WAIT(); asm volatile("" ::: "memory");
        int ex[16]; float sc[16];
#pragma unroll
        for (int k = 0; k < 16; ++k) { const unsigned cidx = 255u - (unsigned)(C[k] & 255); ex[k] = (int)(tab[cidx >> 4] * 128u + tab[16 + (cidx & 15u)]); sc[k] = key2f(C[k] & ~255); }
        float ssum = 0.f;
        const float smax = sc[0];
#pragma unroll
        for (int k = 0; k < 16; ++k) { sc[k] = __builtin_amdgcn_exp2f((sc[k] - smax) * LOG2E); ssum += sc[k]; }
        const float rinv = 1.0f / ssum;
        if (lane < 32 || two) {
            int* ip = IDX + (size_t)t * 128 + h * 16; float* gp = GATE + (size_t)t * 128 + h * 16;
#pragma unroll
            for (int k = 0; k < 4; ++k) { *(GAS v4u*)(ip + 4 * k) = (v4u){(unsigned)ex[4 * k], (unsigned)ex[4 * k + 1], (unsigned)ex[4 * k + 2], (unsigned)ex[4 * k + 3]};
                *(GAS f32x4*)(gp + 4 * k) = (f32x4){sc[4 * k] * rinv, sc[4 * k + 1] * rinv, sc[4 * k + 2] * rinv, sc[4 * k + 3] * rinv}; }
        }
        LDS_WAIT(); asm volatile("" ::: "memory");
    }
}

typedef int v8i_t __attribute__((ext_vector_type(8)));
__device__ __forceinline__ float gelu1(float v) { const f32x2 g = pg8::gelu_pk((f32x2){v, v}); return g.x; }
#define FP4_ACC(W, D_, WK) do { f32x2 f_; \
        f_ = __builtin_amdgcn_cvt_scalef32_pk_f32_fp4((W), 1.0f, 0); acc[8 * (D_) + 0] += (WK) * f_.x; acc[8 * (D_) + 1] += (WK) * f_.y; \
        f_ = __builtin_amdgcn_cvt_scalef32_pk_f32_fp4((W), 1.0f, 1); acc[8 * (D_) + 2] += (WK) * f_.x; acc[8 * (D_) + 3] += (WK) * f_.y; \
        f_ = __builtin_amdgcn_cvt_scalef32_pk_f32_fp4((W), 1.0f, 2); acc[8 * (D_) + 4] += (WK) * f_.x; acc[8 * (D_) + 5] += (WK) * f_.y; \
        f_ = __builtin_amdgcn_cvt_scalef32_pk_f32_fp4((W), 1.0f, 3); acc[8 * (D_) + 6] += (WK) * f_.x; acc[8 * (D_) + 7] += (WK) * f_.y; } while (0)
#define GATHER_LOADU(kb_) do { const int el_ = __shfl(((kb_) < 4) ? idv0 : idv1, ((kb_) & 3) * 16 + fr); const int vo_ = el_ * 512 + q4 * 16; \
        _Pragma("unroll") for (int j = 0; j < 8; ++j) uA[j] = __builtin_amdgcn_raw_buffer_load_b128(rsrcU, vo_, 64 * j, 0); } while (0)
#define GATHER_LOADV(VH, kb_, hf_) do { const int idv_ = ((kb_) < 4) ? idv0 : idv1; const int kbase_ = ((kb_) & 3) * 16 + 8 * (hf_); \
        _Pragma("unroll") for (int kk = 0; kk < 8; ++kk) { const int e_ = __builtin_amdgcn_readlane(idv_, kbase_ + kk); VH[kk] = __builtin_amdgcn_raw_buffer_load_b64(rsrcV, lane8, e_ * 512, 0); } } while (0)
#define GATHER_LOADU2(UB, kb_) do { const int el_ = __shfl(((kb_) < 4) ? idv0 : idv1, ((kb_) & 3) * 16 + fr); const int vo_ = el_ * 512 + q4 * 16; \
        _Pragma("unroll") for (int j = 0; j < 8; ++j) UB[j] = __builtin_amdgcn_raw_buffer_load_b128(rsrcU, vo_, 64 * j, 0); } while (0)
__device__ __forceinline__ void stage_x_fp4(const unsigned (&xw)[8], LAS unsigned char* xs_, int lane, float& xinv, float& xinv2) {
    float m = 0.f;
#pragma unroll
    for (int k = 0; k < 8; ++k) m = __builtin_fmaxf(m, __builtin_fmaxf(__builtin_fabsf(bflo(xw[k])), __builtin_fabsf(bfhi(xw[k]))));
    m = wave_max_nonneg(m);
    const float xsc = (m > 1e-30f) ? 6.0f / m : 1.0f; xinv = (m > 1e-30f) ? m * (1.0f / 6.0f) : 1.0f;
    float xr[16]; v2u q; float m2 = 0.f;
#pragma unroll
    for (int d = 0; d < 2; ++d) { unsigned w_ = 0u;
        w_ = __builtin_amdgcn_cvt_scalef32_pk_fp4_f32(w_, bflo(xw[4 * d]) * xsc, bfhi(xw[4 * d]) * xsc, 1.0f, 0);
        w_ = __builtin_amdgcn_cvt_scalef32_pk_fp4_f32(w_, bflo(xw[4 * d + 1]) * xsc, bfhi(xw[4 * d + 1]) * xsc, 1.0f, 1);
        w_ = __builtin_amdgcn_cvt_scalef32_pk_fp4_f32(w_, bflo(xw[4 * d + 2]) * xsc, bfhi(xw[4 * d + 2]) * xsc, 1.0f, 2);
        w_ = __builtin_amdgcn_cvt_scalef32_pk_fp4_f32(w_, bflo(xw[4 * d + 3]) * xsc, bfhi(xw[4 * d + 3]) * xsc, 1.0f, 3);
        q[d] = w_;
        f32x2 f;
        f = __builtin_amdgcn_cvt_scalef32_pk_f32_fp4(w_, 1.0f, 0); xr[8 * d + 0] = bflo(xw[4 * d]) - f.x * xinv;     xr[8 * d + 1] = bfhi(xw[4 * d]) - f.y * xinv;
        f = __builtin_amdgcn_cvt_scalef32_pk_f32_fp4(w_, 1.0f, 1); xr[8 * d + 2] = bflo(xw[4 * d + 1]) - f.x * xinv; xr[8 * d + 3] = bfhi(xw[4 * d + 1]) - f.y * xinv;
        f = __builtin_amdgcn_cvt_scalef32_pk_f32_fp4(w_, 1.0f, 2); xr[8 * d + 4] = bflo(xw[4 * d + 2]) - f.x * xinv; xr[8 * d + 5] = bfhi(xw[4 * d + 2]) - f.y * xinv;
        f = __builtin_amdgcn_cvt_scalef32_pk_f32_fp4(w_, 1.0f, 3); xr[8 * d + 6] = bflo(xw[4 * d + 3]) - f.x * xinv; xr[8 * d + 7] = bfhi(xw[4 * d + 3]) - f.y * xinv; }
    *(LAS v2u*)(xs_ + 8 * lane) = q;
#pragma unroll
    for (int i = 0; i < 16; ++i) m2 = __builtin_fmaxf(m2, __builtin_fabsf(xr[i]));
    m2 = wave_max_nonneg(m2);
    const float xsc2 = (m2 > 1e-30f) ? 6.0f / m2 : 1.0f; xinv2 = (m2 > 1e-30f) ? m2 * (1.0f / 6.0f) : 0.0f;
#pragma unroll
    for (int d = 0; d < 2; ++d) { unsigned w_ = 0u;
        w_ = __builtin_amdgcn_cvt_scalef32_pk_fp4_f32(w_, xr[8 * d + 0] * xsc2, xr[8 * d + 1] * xsc2, 1.0f, 0);
        w_ = __builtin_amdgcn_cvt_scalef32_pk_fp4_f32(w_, xr[8 * d + 2] * xsc2, xr[8 * d + 3] * xsc2, 1.0f, 1);
        w_ = __builtin_amdgcn_cvt_scalef32_pk_fp4_f32(w_, xr[8 * d + 4] * xsc2, xr[8 * d + 5] * xsc2, 1.0f, 2);
        w_ = __builtin_amdgcn_cvt_scalef32_pk_fp4_f32(w_, xr[8 * d + 6] * xsc2, xr[8 * d + 7] * xsc2, 1.0f, 3);
        q[d] = w_; }
    *(LAS v2u*)(xs_ + 512 + 8 * lane) = q;
}
__device__ __forceinline__ void lds_w64(unsigned a, v2u v);
__device__ __forceinline__ void stage_x_fp4_asm(const unsigned (&xw)[8], unsigned xs_, int lane, float& xinv, float& xinv2) {
    float m = 0.f;
#pragma unroll
    for (int k = 0; k < 8; ++k) m = __builtin_fmaxf(m, __builtin_fmaxf(__builtin_fabsf(bflo(xw[k])), __builtin_fabsf(bfhi(xw[k]))));
    m = wave_max_nonneg(m);
    const float xsc = (m > 1e-30f) ? 6.0f / m : 1.0f; xinv = (m > 1e-30f) ? m * (1.0f / 6.0f) : 1.0f;
    float xr[16]; v2u q; float m2 = 0.f;
#pragma unroll
    for (int d = 0; d < 2; ++d) { unsigned w_ = 0u;
        w_ = __builtin_amdgcn_cvt_scalef32_pk_fp4_f32(w_, bflo(xw[4 * d]) * xsc, bfhi(xw[4 * d]) * xsc, 1.0f, 0);
        w_ = __builtin_amdgcn_cvt_scalef32_pk_fp4_f32(w_, bflo(xw[4 * d + 1]) * xsc, bfhi(xw[4 * d + 1]) * xsc, 1.0f, 1);
        w_ = __builtin_amdgcn_cvt_scalef32_pk_fp4_f32(w_, bflo(xw[4 * d + 2]) * xsc, bfhi(xw[4 * d + 2]) * xsc, 1.0f, 2);
        w_ = __builtin_amdgcn_cvt_scalef32_pk_fp4_f32(w_, bflo(xw[4 * d + 3]) * xsc, bfhi(xw[4 * d + 3]) * xsc, 1.0f, 3);
        q[d] = w_;
        f32x2 f;
        f = __builtin_amdgcn_cvt_scalef32_pk_f32_fp4(w_, 1.0f, 0); xr[8 * d + 0] = bflo(xw[4 * d]) - f.x * xinv;     xr[8 * d + 1] = bfhi(xw[4 * d]) - f.y * xinv;
        f = __builtin_amdgcn_cvt_scalef32_pk_f32_fp4(w_, 1.0f, 1); xr[8 * d + 2] = bflo(xw[4 * d + 1]) - f.x * xinv; xr[8 * d + 3] = bfhi(xw[4 * d + 1]) - f.y * xinv;
        f = __builtin_amdgcn_cvt_scalef32_pk_f32_fp4(w_, 1.0f, 2); xr[8 * d + 4] = bflo(xw[4 * d + 2]) - f.x * xinv; xr[8 * d + 5] = bfhi(xw[4 * d + 2]) - f.y * xinv;
        f = __builtin_amdgcn_cvt_scalef32_pk_f32_fp4(w_, 1.0f, 3); xr[8 * d + 6] = bflo(xw[4 * d + 3]) - f.x * xinv; xr[8 * d + 7] = bfhi(xw[4 * d + 3]) - f.y * xinv; }
    lds_w64(xs_ + 8u * (unsigned)lane, q);
#pragma unroll
    for (int i = 0; i < 16; ++i) m2 = __builtin_fmaxf(m2, __builtin_fabsf(xr[i]));
    m2 = wave_max_nonneg(m2);
    const float xsc2 = (m2 > 1e-30f) ? 6.0f / m2 : 1.0f; xinv2 = (m2 > 1e-30f) ? m2 * (1.0f / 6.0f) : 0.0f;
#pragma unroll
    for (int d = 0; d < 2; ++d) { unsigned w_ = 0u;
        w_ = __builtin_amdgcn_cvt_scalef32_pk_fp4_f32(w_, xr[8 * d + 0] * xsc2, xr[8 * d + 1] * xsc2, 1.0f, 0);
        w_ = __builtin_amdgcn_cvt_scalef32_pk_fp4_f32(w_, xr[8 * d + 2] * xsc2, xr[8 * d + 3] * xsc2, 1.0f, 1);
        w_ = __builtin_amdgcn_cvt_scalef32_pk_fp4_f32(w_, xr[8 * d + 4] * xsc2, xr[8 * d + 5] * xsc2, 1.0f, 2);
        w_ = __builtin_amdgcn_cvt_scalef32_pk_fp4_f32(w_, xr[8 * d + 6] * xsc2, xr[8 * d + 7] * xsc2, 1.0f, 3);
        q[d] = w_; }
    lds_w64(xs_ + 512u + 8u * (unsigned)lane, q);
}
__device__ __forceinline__ void lds_w64(unsigned a, v2u v) { asm volatile("ds_write_b64 %0, %1" :: "v"(a), "v"(v) : "memory"); }
__device__ __forceinline__ void lds_w128(unsigned a, f32x4 v) { asm volatile("ds_write_b128 %0, %1" :: "v"(a), "v"(v) : "memory"); }
__device__ __forceinline__ float lds_r32_wait(unsigned a) { float r; asm volatile("s_waitcnt lgkmcnt(0)\n\tds_read_b32 %0, %1\n\ts_waitcnt lgkmcnt(0)" : "=v"(r) : "v"(a) : "memory"); return r; }
__device__ __forceinline__ float dpp_ror8(float x) { return __int_as_float(__builtin_amdgcn_update_dpp(0, __float_as_int(x), 0x128, 0xf, 0xf, true)); }
__device__ __forceinline__ void gather_u_phase(Frame& F, int layer) {
    const unsigned char* PU = F.ws + WS_PU + (size_t)layer * 16384 * 512;
    const float* RSU = (const float*)(F.ws + WS_RS) + (size_t)layer * 32768;
    const int* IDX = (const int*)(F.ws + WS_IDX); float* GATE = (float*)(F.ws + WS_GATE);
    const bf16* XB = (const bf16*)(F.ws + WS_XB);
    const int lane = lane_id(), fr = lane & 15, q4 = lane >> 4;
    const int gw = blockIdx.x * NWAVES + F.wave, NGW = F.G * NWAVES;
    LAS unsigned char* wl = F.lds + F.wave * 19456;
    const unsigned wl_a = (unsigned)(size_t)wl;
    const unsigned xs_a = wl_a + 16384, hb_a = wl_a + 18432;
    const __amdgpu_buffer_rsrc_t rsrcU = __builtin_amdgcn_make_buffer_rsrc((void*)PU, 0, 16384 * 512, 0x00020000);
    const __amdgpu_buffer_rsrc_t rsrcS = __builtin_amdgcn_make_buffer_rsrc((void*)RSU, 0, 2 * 65536, 0x00020000);
    int t = gw;
    if (t >= T) return;
    const int dma_c = (((lane & 7) ^ (lane >> 3)) & 7) * 16;
    const int rr = fr & 7;
    const unsigned rdA0 = (unsigned)((fr >> 3) * 4096 + rr * 128 + ((q4 ^ rr) & 7) * 16), rdA1 = (unsigned)((fr >> 3) * 4096 + rr * 128 + (((4 + q4) ^ rr) & 7) * 16);
    const unsigned rdX = xs_a + 16 * q4;
#define GU_DMA(buf_, i0_, i1_, kb_) do { const int iv_ = ((kb_) < 4) ? (i0_) : (i1_); \
        _Pragma("unroll") for (int h_ = 0; h_ < 2; ++h_) { const int vo_ = __shfl(iv_, ((kb_) & 3) * 16 + 8 * h_ + (lane >> 3)) * 512 + dma_c; \
            _Pragma("unroll") for (int m_ = 0; m_ < 4; ++m_) __builtin_amdgcn_raw_ptr_buffer_load_lds(rsrcU, (LAS void*)(wl + (buf_) * 8192 + (h_ * 4 + m_) * 1024), 16, vo_, 128 * m_, 0, 0); } } while (0)
#define GU_READA(buf_) do { const unsigned a0_ = wl_a + (buf_) * 8192 + rdA0, a1_ = wl_a + (buf_) * 8192 + rdA1; \
        asm volatile("ds_read_b128 %0, %8\n\tds_read_b128 %1, %9\n\tds_read_b128 %2, %8 offset:1024\n\tds_read_b128 %3, %9 offset:1024\n\t" \
                     "ds_read_b128 %4, %8 offset:2048\n\tds_read_b128 %5, %9 offset:2048\n\tds_read_b128 %6, %8 offset:3072\n\tds_read_b128 %7, %9 offset:3072\n\ts_waitcnt lgkmcnt(0)" \
                     : "=&v"(ua[0]), "=&v"(ua[1]), "=&v"(ua[2]), "=&v"(ua[3]), "=&v"(ua[4]), "=&v"(ua[5]), "=&v"(ua[6]), "=&v"(ua[7]) : "v"(a0_), "v"(a1_) : "memory"); } while (0)
#define GU_LOADB(xa_) do { const unsigned b_ = (xa_) + 16 * q4 + ((fr & 8) ? 512u : 0u);     \
        asm volatile("ds_read_b128 %0, %8\n\tds_read_b128 %1, %8 offset:64\n\tds_read_b128 %2, %8 offset:128\n\tds_read_b128 %3, %8 offset:192\n\t" \
                     "ds_read_b128 %4, %8 offset:256\n\tds_read_b128 %5, %8 offset:320\n\tds_read_b128 %6, %8 offset:384\n\tds_read_b128 %7, %8 offset:448\n\ts_waitcnt lgkmcnt(0)" \
                     : "=&v"(xb0[0]), "=&v"(xb0[1]), "=&v"(xb0[2]), "=&v"(xb0[3]), "=&v"(xb0[4]), "=&v"(xb0[5]), "=&v"(xb0[6]), "=&v"(xb0[7]) : "v"(b_) : "memory"); } while (0)
#define GU_BATCH(buf_, kb_, NEXT_DMA) do { \
        asm volatile("s_waitcnt vmcnt(8)" ::: "memory"); \
        v4u ua[8]; GU_READA(buf_); \
        NEXT_DMA; \
        f32x4 dacc = (f32x4){0.f, 0.f, 0.f, 0.f}; \
        _Pragma("unroll") for (int j = 0; j < 8; ++j) { \
            const v8i_t A_ = (v8i_t){(int)ua[j].x, (int)ua[j].y, (int)ua[j].z, (int)ua[j].w, 0, 0, 0, 0}; \
            const v8i_t B_ = (v8i_t){(int)xb0[j].x, (int)xb0[j].y, (int)xb0[j].z, (int)xb0[j].w, 0, 0, 0, 0}; \
            dacc = __builtin_amdgcn_mfma_scale_f32_16x16x128_f8f6f4(A_, B_, dacc, 4, 4, 0, 127, 0, 127); } \
        { const float sc_ = (fr & 8) ? xinv2 : xinv;     \
          _Pragma("unroll") for (int i = 0; i < 4; ++i) { const float h_ = dacc[i] * sc_; dacc[i] = h_ + dpp_ror8(h_); } } \
        if (fr == 0) lds_w128(hb_a + (unsigned)((((kb_) & 3) * 16 + 4 * q4) * 4), dacc);     \
        } while (0)
#define GU_HALF(gt_, ru_, rv_, half_) do { const float h_ = lds_r32_wait(hb_a + 4u * (unsigned)lane); \
        wrow[64 * (half_) + lane] = (gt_) * gelu1(h_ * (ru_)) * (rv_); } while (0)
    int idv0, idv1; float gtv0, gtv1, rsu0, rsu1, rsv0, rsv1, xinv, xinv2;
    int cur = 0;
    v4u xb0[8];
    { const unsigned l32 = (unsigned)lane * 32u, l4 = (unsigned)lane * 4u;
      unsigned xw[8];
      { const v4u a = ldg16(XB + (size_t)t * D, l32), b = ldg16(XB + (size_t)t * D + 8, l32);
#pragma unroll
        for (int k = 0; k < 4; ++k) { xw[k] = a[k]; xw[4 + k] = b[k]; } }
      idv0 = *(const GAS int*)((const GAS char*)(IDX + (size_t)t * 128) + l4); idv1 = *(const GAS int*)((const GAS char*)(IDX + (size_t)t * 128 + 64) + l4);
      gtv0 = *(const GAS float*)((const GAS char*)(GATE + (size_t)t * 128) + l4); gtv1 = *(const GAS float*)((const GAS char*)(GATE + (size_t)t * 128 + 64) + l4);
      { const v2u s0_ = __builtin_amdgcn_raw_buffer_load_b64(rsrcS, idv0 * 8, 0, 0), s1_ = __builtin_amdgcn_raw_buffer_load_b64(rsrcS, idv1 * 8, 0, 0);
        rsu0 = __uint_as_float(s0_.x); rsv0 = __uint_as_float(s0_.y); rsu1 = __uint_as_float(s1_.x); rsv1 = __uint_as_float(s1_.y); }
      stage_x_fp4_asm(xw, xs_a, lane, xinv, xinv2);
      asm volatile("s_waitcnt vmcnt(0)" ::: "memory");
      GU_DMA(0, idv0, idv1, 0); GU_DMA(1, idv0, idv1, 1);
      GU_LOADB(xs_a); }
    for (; t < T; t += NGW) {
        unsigned l32 = (unsigned)lane * 32u, l4 = (unsigned)lane * 4u;
        asm volatile("" : "+v"(l32), "+v"(l4));
        const int tn = (t + NGW < T) ? t + NGW : t;
        float* wrow = GATE + (size_t)t * 128;
        unsigned xwn[8]; int idn0, idn1; float gtn0, gtn1, rsun0, rsun1, rsvn0, rsvn1;
#define GU_PRE_NEXT do { const v4u a = ldg16(XB + (size_t)tn * D, l32), b = ldg16(XB + (size_t)tn * D + 8, l32); \
            _Pragma("unroll") for (int k = 0; k < 4; ++k) { xwn[k] = a[k]; xwn[4 + k] = b[k]; } \
            idn0 = *(const GAS int*)((const GAS char*)(IDX + (size_t)tn * 128) + l4); idn1 = *(const GAS int*)((const GAS char*)(IDX + (size_t)tn * 128 + 64) + l4); \
            gtn0 = *(const GAS float*)((const GAS char*)(GATE + (size_t)tn * 128) + l4); gtn1 = *(const GAS float*)((const GAS char*)(GATE + (size_t)tn * 128 + 64) + l4); } while (0)
#define GU_PRE_RS do { const v2u s0_ = __builtin_amdgcn_raw_buffer_load_b64(rsrcS, idn0 * 8, 0, 0), s1_ = __builtin_amdgcn_raw_buffer_load_b64(rsrcS, idn1 * 8, 0, 0); \
            rsun0 = __uint_as_float(s0_.x); rsvn0 = __uint_as_float(s0_.y); rsun1 = __uint_as_float(s1_.x); rsvn1 = __uint_as_float(s1_.y); } while (0)
        GU_BATCH(0, 0, GU_PRE_NEXT; GU_DMA(0, idv0, idv1, 2));
        GU_BATCH(1, 1, GU_DMA(1, idv0, idv1, 3));
        GU_BATCH(0, 2, GU_DMA(0, idv0, idv1, 4));
        GU_BATCH(1, 3, GU_DMA(1, idv0, idv1, 5));
        GU_BATCH(0, 4, GU_HALF(gtv0, rsu0, rsv0, 0); GU_DMA(0, idv0, idv1, 6));
        GU_BATCH(1, 5, GU_PRE_RS; GU_DMA(1, idv0, idv1, 7));
        float xinvn, xinv2n;
        stage_x_fp4_asm(xwn, xs_a + (unsigned)((cur ^ 1) * 1024), lane, xinvn, xinv2n);
        GU_BATCH(0, 6, GU_DMA(0, idn0, idn1, 0));
        GU_BATCH(1, 7, GU_DMA(1, idn0, idn1, 1));
        GU_HALF(gtv1, rsu1, rsv1, 1);
#undef GU_PRE_NEXT
#undef GU_PRE_RS
        cur ^= 1;
        GU_LOADB(xs_a + (unsigned)(cur * 1024));
        idv0 = idn0; idv1 = idn1; gtv0 = gtn0; gtv1 = gtn1; rsu0 = rsun0; rsu1 = rsun1; rsv0 = rsvn0; rsv1 = rsvn1; xinv = xinvn; xinv2 = xinv2n;
    }
    asm volatile("s_waitcnt vmcnt(0)" ::: "memory");
#undef GU_DMA
#undef GU_READA
#undef GU_LOADB
#undef GU_BATCH
#undef GU_HALF
}
__device__ __forceinline__ float swz16(float x) { return __int_as_float(__builtin_amdgcn_ds_swizzle(__float_as_int(x), 0x401F)); }
__device__ __forceinline__ void gather_v_phase(Frame& F, int layer) {
    const unsigned char* PV = F.ws + WS_PV + (size_t)layer * 16384 * 512;
    const int* IDX = (const int*)(F.ws + WS_IDX); const float* GATE = (const float*)(F.ws + WS_GATE);
    bf16* XB = (bf16*)(F.ws + WS_XB); float* Y = F.out + O_Y;
    const float* gam = F.in[14] + (size_t)(layer * 2 + 1) * D; const float* bet = F.in[15] + (size_t)(layer * 2 + 1) * D;
    const int lane = lane_id(), np = lane & 31, hh = lane >> 5, np15 = np & 15, rowsel = np >> 4;
    const int gw = blockIdx.x * NWAVES + F.wave, NGW = F.G * NWAVES;
    const __amdgpu_buffer_rsrc_t rsrcV = __builtin_amdgcn_make_buffer_rsrc((void*)PV, 0, 16384 * 512, 0x00020000);
    int t = gw;
    if (t >= T) return;
    const int lane_off = 32 * np15 + 16 * hh;
    const int bp = 4 * rowsel;
    const int col0 = 64 * np15 + 4 * hh;
    int A[2][4];
    { const int m = np, par = m & 1, byt = (m & 7) >> 1, d0 = m >> 3;
      const float fa = par ? 0.f : 1.f, fb = par ? 1.f : 0.f;
      const unsigned v0 = __builtin_amdgcn_cvt_scalef32_pk_fp4_f32(0u, fa, fb, 1.0f, 0), v1 = __builtin_amdgcn_cvt_scalef32_pk_fp4_f32(0u, fa, fb, 1.0f, 1);
      const unsigned v2 = __builtin_amdgcn_cvt_scalef32_pk_fp4_f32(0u, fa, fb, 1.0f, 2), v3 = __builtin_amdgcn_cvt_scalef32_pk_fp4_f32(0u, fa, fb, 1.0f, 3);
      const unsigned val = (byt == 0) ? v0 : (byt == 1) ? v1 : (byt == 2) ? v2 : v3;
#pragma unroll
      for (int s_ = 0; s_ < 2; ++s_)
#pragma unroll
          for (int d = 0; d < 4; ++d) A[s_][d] = (hh == s_ && d == d0) ? (int)val : 0; }
    LAS f32x4* gbl = (LAS f32x4*)(F.lds + F.wave * 16384) + lane;
#pragma unroll
    for (int s_ = 0; s_ < 8; ++s_) { gbl[64 * s_] = *(const GAS f32x4*)(gam + col0 + 8 * s_); gbl[64 * (8 + s_)] = *(const GAS f32x4*)(bet + col0 + 8 * s_); }
    int idv0, idv1; float wv0, wv1;
    { const unsigned l4 = (unsigned)lane * 4u;
      idv0 = *(const GAS int*)((const GAS char*)(IDX + (size_t)t * 128) + l4); idv1 = *(const GAS int*)((const GAS char*)(IDX + (size_t)t * 128 + 64) + l4);
      wv0 = *(const GAS float*)((const GAS char*)(GATE + (size_t)t * 128) + l4); wv1 = *(const GAS float*)((const GAS char*)(GATE + (size_t)t * 128 + 64) + l4); }
    v4u vb[16]; float wl[16];
#define V2_ISSUE(u_, iv_, wv_, jj_) do { const int ba_ = bp + 8 * (jj_); const int e_ = __builtin_amdgcn_ds_bpermute(ba_, (iv_)); \
        wl[u_] = __int_as_float(__builtin_amdgcn_ds_bpermute(ba_, __float_as_int(wv_))); \
        vb[u_] = __builtin_amdgcn_raw_buffer_load_b128(rsrcV, e_ * 512 + lane_off, 0, 0); } while (0)
#define V2_STEP(DC, DP, u_, HAS_PREV) do { const v8i_t B_ = (v8i_t){(int)vb[u_].x, (int)vb[u_].y, (int)vb[u_].z, (int)vb[u_].w, 0, 0, 0, 0}; const float wc_ = wl[u_]; \
        _Pragma("unroll") for (int s_ = 0; s_ < 2; ++s_) { const v8i_t A_ = (v8i_t){A[s_][0], A[s_][1], A[s_][2], A[s_][3], 0, 0, 0, 0}; \
            DC[s_] = __builtin_amdgcn_mfma_scale_f32_32x32x64_f8f6f4(A_, B_, zero16, 4, 4, 0, 127, 0, 127); \
            if (HAS_PREV) { _Pragma("unroll") for (int j_ = 0; j_ < 4; ++j_) acc[4 * s_ + j_] += (f32x4){DP[s_][4 * j_], DP[s_][4 * j_ + 1], DP[s_][4 * j_ + 2], DP[s_][4 * j_ + 3]} * wp; } } \
        wp = wc_; } while (0)
    f32x16 zero16;
#pragma unroll
    for (int i = 0; i < 16; ++i) zero16[i] = 0.f;
#pragma unroll
    for (int u = 0; u < 8; ++u) V2_ISSUE(u, idv0, wv0, u);
    for (; t < T; t += NGW) {
        unsigned l4 = (unsigned)lane * 4u;
        asm volatile("" : "+v"(l4));
        const int tn = (t + NGW < T) ? t + NGW : t;
        const int idn0 = *(const GAS int*)((const GAS char*)(IDX + (size_t)tn * 128) + l4), idn1 = *(const GAS int*)((const GAS char*)(IDX + (size_t)tn * 128 + 64) + l4);
        const float wn0 = *(const GAS float*)((const GAS char*)(GATE + (size_t)tn * 128) + l4), wn1 = *(const GAS float*)((const GAS char*)(GATE + (size_t)tn * 128 + 64) + l4);
        f32x4 acc[8]; f32x16 dA[2], dB[2]; float wp = 0.f;
#pragma unroll
        for (int s_ = 0; s_ < 8; ++s_) acc[s_] = (f32x4){0.f, 0.f, 0.f, 0.f};
#define V2_GROUP(g_, NIV, NWV, NJB) do { \
        _Pragma("unroll") for (int u_ = 0; u_ < 8; ++u_) V2_ISSUE(8 * (((g_) + 1) & 1) + u_, NIV, NWV, (NJB) + u_); \
        asm volatile("" ::: "memory"); \
        V2_STEP(dA, dB, 8 * ((g_) & 1) + 0, (g_) > 0); V2_STEP(dB, dA, 8 * ((g_) & 1) + 1, true); V2_STEP(dA, dB, 8 * ((g_) & 1) + 2, true); V2_STEP(dB, dA, 8 * ((g_) & 1) + 3, true); \
        V2_STEP(dA, dB, 8 * ((g_) & 1) + 4, true); V2_STEP(dB, dA, 8 * ((g_) & 1) + 5, true); V2_STEP(dA, dB, 8 * ((g_) & 1) + 6, true); V2_STEP(dB, dA, 8 * ((g_) & 1) + 7, true); \
        asm volatile("" ::: "memory"); } while (0)
        V2_GROUP(0, idv0, wv0, 8);  V2_GROUP(1, idv0, wv0, 16); V2_GROUP(2, idv0, wv0, 24); V2_GROUP(3, idv1, wv1, 0);
        V2_GROUP(4, idv1, wv1, 8);  V2_GROUP(5, idv1, wv1, 16); V2_GROUP(6, idv1, wv1, 24); V2_GROUP(7, idn0, wn0, 0);
#undef V2_GROUP
#pragma unroll
        for (int s_ = 0; s_ < 2; ++s_)
#pragma unroll
            for (int j_ = 0; j_ < 4; ++j_) acc[4 * s_ + j_] += (f32x4){dB[s_][4 * j_], dB[s_][4 * j_ + 1], dB[s_][4 * j_ + 2], dB[s_][4 * j_ + 3]} * wp;
        const bf16* xrow = XB + (size_t)t * D + col0;
        float ssum = 0.f;
#pragma unroll
        for (int s_ = 0; s_ < 8; ++s_) { const v2u xb = *(const GAS v2u*)(xrow + 8 * s_);
            const f32x4 xr = (f32x4){bflo(xb.x), bfhi(xb.x), bflo(xb.y), bfhi(xb.y)};
#pragma unroll
            for (int i = 0; i < 4; ++i) { acc[s_][i] = acc[s_][i] + swz16(acc[s_][i]) + ALPHA * xr[i]; ssum += acc[s_][i]; } }
        const float mean = wave_sum(ssum) * (0.5f / D); float s2 = 0.f;
#pragma unroll
        for (int s_ = 0; s_ < 8; ++s_)
#pragma unroll
            for (int i = 0; i < 4; ++i) { acc[s_][i] -= mean; s2 += acc[s_][i] * acc[s_][i]; }
        const float rstd = __builtin_amdgcn_rsqf(wave_sum(s2) * (0.5f / D) + LN_EPS);
        if (rowsel == 0) {
#pragma unroll
            for (int s_ = 0; s_ < 8; ++s_) { const f32x4 g4 = gbl[64 * s_], b4 = gbl[64 * (8 + s_)];
                const f32x4 y = acc[s_] * rstd * g4 + b4;
                if (layer == 1) __builtin_nontemporal_store(y, (f32x4*)(Y + (size_t)t * D + col0 + 8 * s_));
                else { v2u o; o.x = pkbf(y[0], y[1]); o.y = pkbf(y[2], y[3]); *(GAS v2u*)(XB + (size_t)t * D + col0 + 8 * s_) = o; } }
        }
        idv0 = idn0; idv1 = idn1; wv0 = wn0; wv1 = wn1;
    }
#undef V2_ISSUE
#undef V2_STEP
}
template <bool MASKED> __device__ __forceinline__ void sb_tile(f32x16& p, float& c, f32x16 (&o)[2], LAS const unsigned char* vs, int kv0, int ql, int lane) {
    const int h2 = lane >> 5, fr = lane & 15;
    float rm[16];
#pragma unroll
    for (int i = 0; i < 16; ++i) { const float z = p[i];
        const float t = __builtin_amdgcn_exp2f(-z * LOG2E);
        float be = __builtin_amdgcn_rcpf(1.0f + t);
        float r1 = 1.0f - be;
        if (MASKED) { const bool v = (kv0 + crow(i, h2) < ql); be = v ? be : 0.f; r1 = v ? r1 : 1.0f; }
        p[i] = be; rm[i] = r1; }
    float pp[4], hiv[4];
#pragma unroll
    for (int g = 0; g < 4; ++g) { const float gs = (rm[4 * g] * rm[4 * g + 1]) * (rm[4 * g + 2] * rm[4 * g + 3]);
        auto rr = __builtin_amdgcn_permlane32_swap(__float_as_uint(gs), __float_as_uint(gs), false, false);
        const float lo = __uint_as_float(rr[0]), hi = __uint_as_float(rr[1]); pp[g] = lo * hi; hiv[g] = hi; }
    float sp4[4]; sp4[3] = 1.0f;
#pragma unroll
    for (int g = 2; g >= 0; --g) sp4[g] = sp4[g + 1] * pp[g + 1];
    const float total = sp4[0] * pp[0];
    const float E = __builtin_amdgcn_exp2f(c * LOG2E);
#pragma unroll
    for (int g = 0; g < 4; ++g) { float run = E * sp4[g] * (h2 ? 1.0f : hiv[g]);
#pragma unroll
        for (int e = 3; e >= 0; --e) { const int ix = 4 * g + e; const float wgt = p[ix] * run; run *= rm[ix]; p[ix] = wgt; } }
    if (__builtin_expect(__any(total < 7.9e-31f), 0)) {
        float sl = 0.f;
#pragma unroll
        for (int i = 0; i < 16; ++i) sl += __builtin_amdgcn_logf(rm[i]);
        auto rr = __builtin_amdgcn_permlane32_swap(__float_as_uint(sl), __float_as_uint(sl), false, false);
        c += LN2 * (__uint_as_float(rr[0]) + __uint_as_float(rr[1]));
    } else c += LN2 * __builtin_amdgcn_logf(total);
    v2u tv[8];
    { const unsigned va = (unsigned)(size_t)vs + (unsigned)((4 * h2 + (fr >> 2)) * 128 + 32 * ((lane >> 4) & 1) + 8 * (fr & 3));
      asm volatile("ds_read_b64_tr_b16 %0, %8\n\tds_read_b64_tr_b16 %1, %8 offset:1024\n\tds_read_b64_tr_b16 %2, %8 offset:64\n\tds_read_b64_tr_b16 %3, %8 offset:1088\n\t"
                   "ds_read_b64_tr_b16 %4, %8 offset:2048\n\tds_read_b64_tr_b16 %5, %8 offset:3072\n\tds_read_b64_tr_b16 %6, %8 offset:2112\n\tds_read_b64_tr_b16 %7, %8 offset:3136\n\ts_waitcnt lgkmcnt(0)"
                   : "=&v"(tv[0]), "=&v"(tv[1]), "=&v"(tv[2]), "=&v"(tv[3]), "=&v"(tv[4]), "=&v"(tv[5]), "=&v"(tv[6]), "=&v"(tv[7]) : "v"(va) : "memory"); }
#pragma unroll
    for (int ss = 0; ss < 2; ++ss) {
        v4u pa; pa.x = pkbf(p[8 * ss], p[8 * ss + 1]); pa.y = pkbf(p[8 * ss + 2], p[8 * ss + 3]); pa.z = pkbf(p[8 * ss + 4], p[8 * ss + 5]); pa.w = pkbf(p[8 * ss + 6], p[8 * ss + 7]);
#pragma unroll
        for (int db = 0; db < 2; ++db) { const v2u lo = tv[4 * ss + 2 * db], hi = tv[4 * ss + 2 * db + 1];
            const v4u vv = (v4u){lo.x, lo.y, hi.x, hi.y};
            o[db] = mfma32(__builtin_bit_cast(bf16x8, pa), __builtin_bit_cast(bf16x8, vv), o[db]); } }
}
__device__ __forceinline__ void attn_phase(Frame& F) {
    bf16* Q1 = (bf16*)(F.ws + WS_VG); const bf16* K1 = Q1 + (size_t)T * D; const bf16* V1 = Q1 + (size_t)2 * T * D;
    const float* CK = F.in[3]; const float* CV = F.in[4];
    const int lane = lane_id(), r = lane & 31, h2 = lane >> 5;
    LAS unsigned char* vs0 = F.lds + F.wave * 8192;
    const int gw = blockIdx.x * NWAVES + F.wave, NGW = F.G * NWAVES;
    const unsigned offq = (unsigned)(r * 2048 + h2 * 16);
    const unsigned offv = (unsigned)((lane >> 3) * 2048 + (lane & 7) * 16);
    const unsigned offo = (unsigned)(h2 * 4 * 2048 + r * 2);
    const unsigned offck = (unsigned)(r * 256 + h2 * 32);
    const unsigned offcv = (unsigned)((lane >> 4) * 256 + (lane & 15) * 16);
    const int ntw = tail_wgs(F, 12);
    const int nP = gw < 32768 ? (32768 - gw + NGW - 1) / NGW : 0;
    const int v0 = (gw - ntw * NWAVES + NGW) % NGW, nS = v0 < 512 ? (512 - v0 + NGW - 1) / NGW : 0;
    for (int it = 0; it < nP + nS; ++it) {
        if (it == nP) tail_wait_wave(F, 4, ntw);
        const int u = it < nP ? gw + it * NGW : 32768 + v0 + (it - nP) * NGW;
        int hd, qblk; size_t seq0; const float* ck = nullptr; const float* cv = nullptr;
        if (u < 32768) { const int bh = u >> 8; qblk = u & 255; hd = bh & 15; seq0 = (size_t)(bh >> 4) * 8192; }
        else { const int v = u - 32768; const int bh = v >> 1; qblk = v & 1; hd = bh & 15; seq0 = 65536 + (size_t)(bh >> 4) * 64; ck = CK + (size_t)bh * 4096 * 64; cv = CV + (size_t)bh * 4096 * 64; }
        const bf16* qp = Q1 + (seq0 + 32 * qblk) * D + hd * 64;
        bf16x8 qf[4];
#pragma unroll
        for (int ks = 0; ks < 4; ++ks) qf[ks] = __builtin_bit_cast(bf16x8, ldg16(qp + 16 * ks, offq));
        f32x16 o[2];
#pragma unroll
        for (int i = 0; i < 16; ++i) { o[0][i] = 0.f; o[1][i] = 0.f; }
        float c = 0.f; const int ql = 32 * qblk + r;
        bool live = true;
        bf16x8 kf[4]; int vb = 0;
#define SB_FETCH(tk_, buf_) do { const bf16* kt_ = K1 + (seq0 + 32 * (tk_)) * D + hd * 64; const bf16* vt_ = V1 + (seq0 + 32 * (tk_)) * D + hd * 64; \
            _Pragma("unroll") for (int ks = 0; ks < 4; ++ks) kf[ks] = __builtin_bit_cast(bf16x8, ldg16(kt_ + 16 * ks, offq)); \
            _Pragma("unroll") for (int i = 0; i < 4; ++i) __builtin_amdgcn_global_load_lds((const unsigned*)((const char*)(vt_ + (size_t)(8 * i) * D) + offv), (LAS unsigned*)(vs0 + (buf_) * 4096 + i * 1024), 16, 0, 0); } while (0)
        SB_FETCH(qblk, 0);
#pragma unroll 1
        for (int tk = qblk; tk >= 0; --tk) {
            f32x16 p;
#pragma unroll
            for (int i = 0; i < 16; ++i) p[i] = 0.f;
            asm volatile("s_waitcnt vmcnt(0)" ::: "memory");
#pragma unroll
            for (int ks = 0; ks < 4; ++ks) p = mfma32(kf[ks], qf[ks], p);
            asm volatile("" ::: "memory");
            if (tk > 0) SB_FETCH(tk - 1, vb ^ 1);
            asm volatile("" ::: "memory");
            if (tk == qblk) sb_tile<true>(p, c, o, vs0 + vb * 4096, 32 * tk, ql, lane); else sb_tile<false>(p, c, o, vs0 + vb * 4096, 32 * tk, ql, lane);
            LDS_WAIT(); asm volatile("" ::: "memory");
            vb ^= 1;
            if (__all(c < SB_EXIT)) { live = false; break; }
        }
#undef SB_FETCH
        asm volatile("s_waitcnt vmcnt(0)" ::: "memory");
        if (ck && live) {
#pragma unroll 1
            for (int tc = 127; tc >= 0; --tc) {
                const float* kt = ck + (size_t)tc * 32 * 64; const float* vt = cv + (size_t)tc * 32 * 64;
#pragma unroll
                for (int ch = 0; ch < 2; ++ch) {
                    v4u a[4];
#pragma unroll
                    for (int i = 0; i < 4; ++i) a[i] = ldg16(vt + (size_t)(4 * (4 * ch + i)) * 64, offcv);
#pragma unroll
                    for (int i = 0; i < 4; ++i) { const int pz = lane + 64 * (4 * ch + i); v2u w2; w2.x = pkbf(__uint_as_float(a[i].x), __uint_as_float(a[i].y)); w2.y = pkbf(__uint_as_float(a[i].z), __uint_as_float(a[i].w));
                        *(LAS v2u*)(vs0 + (pz >> 4) * 128 + (pz & 15) * 8) = w2; }
                    asm volatile("" ::: "memory");
                }
                f32x16 p;
#pragma unroll
                for (int i = 0; i < 16; ++i) p[i] = 0.f;
#pragma unroll
                for (int kh = 0; kh < 2; ++kh) {
                    v4u a[2][2];
#pragma unroll
                    for (int k2 = 0; k2 < 2; ++k2) { const float* kr = kt + 16 * (2 * kh + k2); a[k2][0] = ldg16(kr, offck); a[k2][1] = ldg16(kr + 4, offck); }
#pragma unroll
                    for (int k2 = 0; k2 < 2; ++k2) { v4u kk; kk.x = pkbf(__uint_as_float(a[k2][0].x), __uint_as_float(a[k2][0].y)); kk.y = pkbf(__uint_as_float(a[k2][0].z), __uint_as_float(a[k2][0].w));
                        kk.z = pkbf(__uint_as_float(a[k2][1].x), __uint_as_float(a[k2][1].y)); kk.w = pkbf(__uint_as_float(a[k2][1].z), __uint_as_float(a[k2][1].w));
                        p = mfma32(__builtin_bit_cast(bf16x8, kk), qf[2 * kh + k2], p); }
                    asm volatile("" ::: "memory");
                }
                LDS_WAIT(); asm volatile("" ::: "memory");
                sb_tile<false>(p, c, o, vs0, 0, 0, lane);
                LDS_WAIT(); asm volatile("" ::: "memory");
                if (__all(c < SB_EXIT)) break;
            }
        }
        {
            const size_t rloc = (u < 32768) ? ((size_t)((u >> 8) >> 4) * 16 + hd) * 8192 + 32 * qblk : ((size_t)(((u - 32768) >> 1) >> 4) * 16 + hd) * 64 + 32 * qblk;
            float* kdst = F.out + (u < 32768 ? O_KRP : O_KRS) + rloc * 64 + lane * 4;
            float* vdst = kdst + (u < 32768 ? (O_VRP - O_KRP) : (O_VRS - O_KRS));
            const unsigned offkv = (unsigned)((lane >> 4) * 2048 + (lane & 15) * 8);
            const bf16* ksrc = K1 + (seq0 + 32 * qblk) * D + hd * 64; const bf16* vsrc = ksrc + (size_t)T * D;
            v2u kr[8], vr8[8];
#pragma unroll
            for (int i = 0; i < 8; ++i) { kr[i] = *(const GAS v2u*)((const GAS char*)(ksrc + (size_t)(4 * i) * D) + offkv); vr8[i] = *(const GAS v2u*)((const GAS char*)(vsrc + (size_t)(4 * i) * D) + offkv); }
#pragma unroll
            for (int i = 0; i < 8; ++i) {
                __builtin_nontemporal_store((f32x4){bflo(kr[i].x), bfhi(kr[i].x), bflo(kr[i].y), bfhi(kr[i].y)}, (f32x4*)(kdst + 256 * i));
                __builtin_nontemporal_store((f32x4){bflo(vr8[i].x), bfhi(vr8[i].x), bflo(vr8[i].y), bfhi(vr8[i].y)}, (f32x4*)(vdst + 256 * i)); }
        }
        bf16* op = Q1 + (seq0 + 32 * qblk) * D + hd * 64;
#pragma unroll
        for (int db = 0; db < 2; ++db)
#pragma unroll
            for (int i = 0; i < 16; ++i) *(GAS bf16*)((GAS char*)(op + (size_t)((i & 3) + 8 * (i >> 2)) * D + 32 * db) + offo) = (bf16)(pkbf(o[db][i], 0.f) & 0xffffu);
    }
}

struct Args { const float* in[16]; float* out; unsigned char* ws; int ph_lo, ph_hi; };
#ifndef DUP_LO
#define DUP_LO 16
#endif
#ifndef DUP_HI
#define DUP_HI 16
#endif
template <int PLO, int PHI> __device__ __forceinline__ void run_phases(Frame& F, const XcdBarrier& bar, int lo, int hi) {
#ifndef ONLY_PHASE
#define ONLY_PHASE -1
#endif
#define IN(k) ((ONLY_PHASE < 0 || ONLY_PHASE == (k)) && PLO <= (k) && (k) < PHI && lo <= (k) && (k) < hi)
#define SEAM(k) do { if ((k) + 1 < hi) xcd_barrier(bar, F.wave == 0 && lane_id() == 0); } while (0)
    bf16* XB = (bf16*)(F.ws + WS_XB); bf16* M1 = (bf16*)(F.ws + WS_M1); bf16* VG = (bf16*)(F.ws + WS_VG);
    if (IN(0)) { p0_prologue(F); SEAM(0); }
    if (IN(1)) {
        pg8::Gemm g{XB, (const bf16*)(F.ws + WS_WIN), T, 6144, 1024, 1024, 1024}; pg8::StaticOrder S; S.init(T, 6144, F.G, (int)blockIdx.x);
        pg8::EpiRot E{(bf16*)(F.out + O_KRP), VG, (const float*)(F.ws + WS_COS), (const float*)(F.ws + WS_SIN)};
        pg8::gemm_phase<pg8::EpiRot, pg8::StaticOrder, PG8_ALIGN, PG8_SP2>(F.lds, g, S, E, F.wave); SEAM(1);
    }
    if (IN(2)) { ret_phase(F); SEAM(2); }
    if (IN(3)) { gn_gate_phase(F); SEAM(3); }
    if (IN(4)) {
        pg8::Gemm g{VG, (const bf16*)(F.ws + WS_WRO), TP, 1024, 2048, 4096, 2048}; pg8::StaticOrder S; S.init(TP, 1024, F.G, (int)blockIdx.x);
        pg8::EpiBf16<0> E{M1, 1024, nullptr, 0, 0, 1.f};
        pg8::gemm_phase<pg8::EpiBf16<0>, pg8::StaticOrder, PG8_ALIGN, PG8_SP2>(F.lds, g, S, E, F.wave); SEAM(4);
    }
    if (IN(5)) {
        if ((int)blockIdx.x < tail_wgs(F, 4)) {
            pg8::Gemm g{VG, (const bf16*)(F.ws + WS_WRO), T, 1024, 2048, 4096, 2048}; pg8::TailOrder S{4, F.G, (int)blockIdx.x};
            pg8::EpiBf16<0> E{M1, 1024, nullptr, 0, 0, 1.f};
            pg8::gemm_phase<pg8::EpiBf16<0>, pg8::TailOrder, PG8_ALIGN, PG8_SP2>(F.lds, g, S, E, F.wave); tail_publish(F, 0);
        }
        ln_phase(F, 0, 0, LN_TAIL_ROWS0); SEAM(5);
    }
#define PEER_PHASES(layer, pb) do { \
        if (IN(pb)) { \
            pg8::Gemm g{XB, (const bf16*)(F.ws + WS_WPQ + (size_t)(layer) * 4 * MiB), TP, 2048, 1024, 1024, 1024}; pg8::StaticOrder S; S.init(TP, 2048, F.G, (int)blockIdx.x); \
            pg8::EpiBf16<0> E{VG, 2048, nullptr, 0, 0, 1.f}; \
            pg8::gemm_phase<pg8::EpiBf16<0>, pg8::StaticOrder, PG8_ALIGN, PG8_SP2>(F.lds, g, S, E, F.wave); SEAM(pb); \
        } \
        if (IN((pb) + 1)) { \
            if ((int)blockIdx.x < tail_wgs(F, 8)) {                       \
                pg8::Gemm g{XB, (const bf16*)(F.ws + WS_WPQ + (size_t)(layer) * 4 * MiB), T, 2048, 1024, 1024, 1024}; pg8::TailOrder S{8, F.G, (int)blockIdx.x}; \
                pg8::EpiBf16<0> E{VG, 2048, nullptr, 0, 0, 1.f}; \
                pg8::gemm_phase<pg8::EpiBf16<0>, pg8::TailOrder, PG8_ALIGN, PG8_SP2>(F.lds, g, S, E, F.wave); tail_publish(F, 2 + (layer)); \
            } \
            topk_phase(F, (layer), 2 + (layer)); SEAM((pb) + 1); } \
        if (IN((pb) + 2)) { gather_u_phase(F, (layer)); SEAM((pb) + 2); } \
        if (IN((pb) + 3)) { gather_v_phase(F, (layer)); SEAM((pb) + 3); } } while (0)
    PEER_PHASES(0, 6);
    if (IN(10)) {
        pg8::Gemm g{XB, (const bf16*)(F.ws + WS_WQKV), TP, 3072, 1024, 1024, 1024}; pg8::StaticOrder S; S.init(TP, 3072, F.G, (int)blockIdx.x);
        pg8::EpiQKV1 E{VG, (size_t)T * D, F.out + O_KRP, F.out + O_VRP, F.out + O_KRS, F.out + O_VRS};
        pg8::gemm_phase<pg8::EpiQKV1, pg8::StaticOrder, PG8_ALIGN, PG8_SP2>(F.lds, g, S, E, F.wave); SEAM(10);
    }
    if (IN(11)) {
        if ((int)blockIdx.x < tail_wgs(F, 12)) {
            pg8::Gemm g{XB, (const bf16*)(F.ws + WS_WQKV), T, 3072, 1024, 1024, 1024}; pg8::TailOrder S{12, F.G, (int)blockIdx.x};
            pg8::EpiQKV1 E{VG, (size_t)T * D, F.out + O_KRP, F.out + O_VRP, F.out + O_KRS, F.out + O_VRS};
            pg8::gemm_phase<pg8::EpiQKV1, pg8::TailOrder, PG8_ALIGN, PG8_SP2>(F.lds, g, S, E, F.wave); tail_publish(F, 4);
        }
        attn_phase(F); SEAM(11);
    }
    if (IN(12)) {
        pg8::Gemm g{VG, (const bf16*)(F.ws + WS_WSO), TP, 1024, 1024, 1024, 1024}; pg8::StaticOrder S; S.init(TP, 1024, F.G, (int)blockIdx.x);
        pg8::EpiBf16<0> E{M1, 1024, nullptr, 0, 0, 1.f};
        pg8::gemm_phase<pg8::EpiBf16<0>, pg8::StaticOrder, PG8_ALIGN, PG8_SP2>(F.lds, g, S, E, F.wave); SEAM(12);
    }
    if (IN(13)) {
        if ((int)blockIdx.x < tail_wgs(F, 4)) {
            pg8::Gemm g{VG, (const bf16*)(F.ws + WS_WSO), T, 1024, 1024, 1024, 1024}; pg8::TailOrder S{4, F.G, (int)blockIdx.x};
            pg8::EpiBf16<0> E{M1, 1024, nullptr, 0, 0, 1.f};
            pg8::gemm_phase<pg8::EpiBf16<0>, pg8::TailOrder, PG8_ALIGN, PG8_SP2>(F.lds, g, S, E, F.wave); tail_publish(F, 1);
        }
        ln_phase(F, 1, 1, LN_TAIL_ROWS1); SEAM(13);
    }
    PEER_PHASES(1, 14);
#undef PEER_PHASES
#undef IN
#undef SEAM
}
__global__ void __launch_bounds__(NTHR, 2) fwd(Args args) {
    extern __shared__ __attribute__((aligned(16))) unsigned char lds[];
    Frame F;
    F.lds = (LAS unsigned char*)lds; F.MISC = (volatile LAS unsigned*)(F.lds + MISC_OFF);
    F.wave = __builtin_amdgcn_readfirstlane((int)threadIdx.x >> 6); F.G = gridDim.x;
#pragma unroll
    for (int i = 0; i < 16; ++i) F.in[i] = args.in[i];
    F.out = args.out; F.ws = args.ws; F.ctl = (gu32*)(args.ws + WS_CTL);
    for (int u = F.wave * 64 + lane_id(); u < (LDS_BYTES - LDSCTL_OFF) / 4; u += NTHR) ((LAS unsigned*)(F.lds + LDSCTL_OFF))[u] = 0u;
    __syncthreads();
    const int lo = args.ph_lo, hi = args.ph_hi;
    XcdBarrier bar; bar.bar = (unsigned*)(F.ctl + CW_BAR); bar.x = 0; bar.st = nullptr;
    if (hi - lo > 1) bar = xcd_barrier_post((unsigned*)(F.ctl + CW_BAR), F.MISC + 8, F.wave == 0 && lane_id() == 0);
#if DUP_LO < DUP_HI
    run_phases<0, DUP_HI>(F, bar, lo, hi);
    run_phases<DUP_LO, DUP_HI>(F, bar, lo, hi);
    run_phases<DUP_HI, NPH>(F, bar, lo, hi);
#else
    run_phases<0, NPH>(F, bar, lo, hi);
#endif
}

extern "C" void kernel_launch(void* const* d_in, const int* in_sizes, int n_in, void* d_out, int out_size, void* d_ws, size_t ws_size, hipStream_t stream) {
    static int grid = 0;
    if (grid == 0) {
        if (n_in != 16 || in_sizes[0] != TP * D || (size_t)out_size != O_END || ws_size < WS_END) {
            fprintf(stderr, "kernel_launch: unexpected shapes: n_in %d in0 %d out %d ws %zu (need %zu)\n", n_in, n_in > 0 ? in_sizes[0] : -1, out_size, ws_size, (size_t)WS_END); grid = -1; return; }
        int dev = 0, cus = 0, per_cu = 0;
        if (hipGetDevice(&dev) != hipSuccess || hipDeviceGetAttribute(&cus, hipDeviceAttributeMultiprocessorCount, dev) != hipSuccess) { grid = -1; return; }
        if (hipFuncSetAttribute((const void*)fwd, hipFuncAttributeMaxDynamicSharedMemorySize, LDS_BYTES) != hipSuccess) { fprintf(stderr, "kernel_launch: hipFuncSetAttribute failed\n"); grid = -1; return; }
        if (hipOccupancyMaxActiveBlocksPerMultiprocessor(&per_cu, (const void*)fwd, NTHR, LDS_BYTES) != hipSuccess || per_cu < 1) fprintf(stderr, "kernel_launch: occupancy query says %d\n", per_cu);
        (void)hipGetLastError();
        grid = cus;
    }
    if (grid < 0) return;
    if (hipMemsetAsync((char*)d_ws + WS_CTL, 0, CTL_ZERO_BYTES, stream) != hipSuccess) { fprintf(stderr, "kernel_launch: memset failed\n"); return; }
    Args a{};
    for (int i = 0; i < 16; ++i) a.in[i] = (const float*)d_in[i];
    a.out = (float*)d_out; a.ws = (unsigned char*)d_ws;
#if MK_ONE_LAUNCH
    a.ph_lo = 0; a.ph_hi = NPH;
    hipLaunchKernelGGL(fwd, dim3(grid), dim3(NTHR), LDS_BYTES, stream, a);
#else
    for (int p = 0; p < NPH; ++p) { a.ph_lo = p; a.ph_hi = p + 1; hipLaunchKernelGGL(fwd, dim3(grid), dim3(NTHR), LDS_BYTES, stream, a); }
#endif
    const hipError_t le = hipPeekAtLastError();
    if (le != hipSuccess) fprintf(stderr, "kernel_launch: launch failed: %s\n", hipGetErrorName(le));
}
```

```cpp
#include <hip/hip_runtime.h>
#include <cstdio>
#include <cstdint>
#define GAS __attribute__((address_space(1)))
#define LAS __attribute__((address_space(3)))
namespace pg8 {
#define PG8_LAS __attribute__((address_space(3)))
typedef unsigned short bf16_t;
typedef short bf16x8 __attribute__((ext_vector_type(8)));
typedef float f32x4 __attribute__((ext_vector_type(4)));
typedef unsigned u32x4 __attribute__((ext_vector_type(4)));
constexpr int BM = 256, BK = 64, HALF = 128, HTB = HALF * BK * 2  , STAGE_BYTES = 8 * HTB, NXCD = 8, WGM = 8;

__host__ __device__ __forceinline__ int lds_byte(int r, int c) { const int st = (r >> 4) * 2 + (c >> 5), rr = r & 15, cc = c & 31, ob = rr * 64 + cc * 2; return st * 1024 + (ob ^ (((ob >> 9) & 1) << 5)); }
__host__ __device__ __forceinline__ void stage_rc(int b, int& R, int& C) { const int st = b / 1024, sb = b % 1024, swz = sb ^ (((sb >> 9) & 1) << 5); R = (st >> 1) * 16 + swz / 64; C = (st & 1) * 32 + (swz % 64) / 2; }
__host__ __device__ __forceinline__ int perm32(int rho) { const int n = rho >> 4, i = rho & 15; return 8 * (i >> 2) + 4 * n + (i & 3); }

struct Unit { int pm, pn; };
struct Gemm { const bf16_t* A; const bf16_t* Bt; int M, N, K, lda, ldb; };

struct StaticOrder {
    int nM, nN, nwg, G, c;
    __host__ __device__ void init(int M, int N, int G_, int c_) { nM = M / BM; nN = N / BM; nwg = nM * nN; G = G_; c = c_; }
    __host__ __device__ bool next(int i, Unit& u) const {
        const long L = (long)i * G + c; if (L >= nwg) return false;
        int wgid = (int)L; { const int q = nwg / NXCD, r = nwg % NXCD, xcd = wgid % NXCD, off = wgid / NXCD; wgid = (xcd < r ? xcd * (q + 1) : r * (q + 1) + (xcd - r) * q) + off; }
        const int nig = WGM * nN, gid = wgid / nig, fm = gid * WGM, gsz = (nM - fm) < WGM ? (nM - fm) : WGM;
        u.pm = fm + ((wgid % nig) % gsz); u.pn = (wgid % nig) / gsz; return true;
    }
    __device__ __forceinline__ void a_ready(const Unit&) const {}
    __device__ __forceinline__ void done(const Unit&) const {}
};

__device__ __forceinline__ unsigned cvt_pk_bf16(float lo, float hi) { unsigned r; asm volatile("v_cvt_pk_bf16_f32 %0, %1, %2" : "=v"(r) : "v"(lo), "v"(hi)); return r; }
typedef float f32x2 __attribute__((ext_vector_type(2)));
__device__ __forceinline__ f32x2 gelu_pk(f32x2 v) {
    const f32x2 av = __builtin_elementwise_abs(v), d = av * 0.2316418882f + 1.0f;
    f32x2 t; t.x = __builtin_amdgcn_rcpf(d.x); t.y = __builtin_amdgcn_rcpf(d.y);
    f32x2 q = t * 0.5307027145f + (-0.7265760135f); q = q * t + 0.7107068705f; q = q * t + (-0.142248368f); q = q * t + 0.127414796f; q = q * t;
    const f32x2 s = (v * v) * (-0.72134752044f);
    f32x2 e; e.x = __builtin_amdgcn_exp2f(s.x); e.y = __builtin_amdgcn_exp2f(s.y);
    const f32x2 m = v * (q * e), r = v - m;
    f32x2 o; o.x = v.x < 0.f ? m.x : r.x; o.y = v.y < 0.f ? m.y : r.y; return o;
}

template <int ACT  > struct EpiBf16 {
    static constexpr bool PERM = true, AFTER_DRAIN = false; static_assert(ACT == 0 || ACT == 1, "EpiBf16: ACT is 0 (none) or 1 (gelu_pk)");
    bf16_t* O; int ldc; const float* bias; int split_cols; size_t split_stride; float scale0;
    __device__ __forceinline__ void operator()(const f32x4 (&acc)[2][2][4][2], const Unit& u, int wr, int wc, int fr, int fq) const {
        const int row0 = u.pm * BM + wr * 64 + fr; int colt = u.pn * BM; bf16_t* base = O;
        float sc = 1.f; if (split_cols) { const int t = colt / split_cols; base += (size_t)t * split_stride; colt -= t * split_cols; if (t == 0) sc = scale0; }
        const int col0 = colt + wc * 32 + 8 * fq, bcol0 = u.pn * BM + wc * 32 + 8 * fq;
        f32x4 bv[2][2];
#pragma unroll
        for (int bj = 0; bj < 2; ++bj)
#pragma unroll
            for (int n = 0; n < 2; ++n) bv[bj][n] = bias ? *(const f32x4*)(bias + bcol0 + bj * HALF + 4 * n) : (f32x4){0.f, 0.f, 0.f, 0.f};
#pragma unroll
        for (int ai = 0; ai < 2; ++ai)
#pragma unroll
            for (int m = 0; m < 4; ++m) { bf16_t* rowp = base + (size_t)(row0 + ai * HALF + m * 16) * ldc + col0;
#pragma unroll
                for (int bj = 0; bj < 2; ++bj) { f32x4 v0 = acc[ai][bj][m][0] + bv[bj][0], v1 = acc[ai][bj][m][1] + bv[bj][1];
                    if (ACT == 1) { f32x2 a = gelu_pk((f32x2){v0[0], v0[1]}), b = gelu_pk((f32x2){v0[2], v0[3]}), c = gelu_pk((f32x2){v1[0], v1[1]}), d = gelu_pk((f32x2){v1[2], v1[3]});
                        v0 = (f32x4){a.x, a.y, b.x, b.y}; v1 = (f32x4){c.x, c.y, d.x, d.y}; }
                    v0 = v0 * sc; v1 = v1 * sc; u32x4 w; w.x = cvt_pk_bf16(v0[0], v0[1]); w.y = cvt_pk_bf16(v0[2], v0[3]); w.z = cvt_pk_bf16(v1[0], v1[1]); w.w = cvt_pk_bf16(v1[2], v1[3]);
                    *(u32x4*)(rowp + bj * HALF) = w; } }
    }
};

__device__ __forceinline__ int row_pos(int r) { return r < 65536 ? (r & 8191) : 4096 + (r & 63); }
struct EpiRot {
    static constexpr bool PERM = true, AFTER_DRAIN = false;
    bf16_t* QK; bf16_t* VG; const float* cosT; const float* sinT;
    __device__ __forceinline__ void operator()(const f32x4 (&acc)[2][2][4][2], const Unit& u, int wr, int wc, int fr, int fq) const {
        const int row0 = u.pm * BM + wr * 64 + fr;
        if (u.pn < 8) {
            const float l2g = __builtin_amdgcn_logf(1.0f - __builtin_amdgcn_exp2f(-5.0f - (float)(u.pn & 3))) * ((u.pn >= 4) ? -1.0f : 1.0f);
            const float sc0 = (u.pn >= 4) ? 0.0625f : 1.0f;
            const int i0 = wc * 32 + 8 * fq;
#pragma unroll
            for (int ai = 0; ai < 2; ++ai)
#pragma unroll
                for (int m = 0; m < 4; ++m) {
                    const int row = row0 + ai * HALF + m * 16; const int pos = row_pos(row);
                    const float sc = sc0 * __builtin_amdgcn_exp2f((float)(row & 63) * l2g);
                    const float* cp = cosT + (size_t)pos * 128 + i0; const float* sp = sinT + (size_t)pos * 128 + i0;
                    const f32x4 c0 = *(const f32x4*)cp, c1 = *(const f32x4*)(cp + 4), s0 = *(const f32x4*)sp, s1 = *(const f32x4*)(sp + 4);
                    const f32x4 a0 = acc[ai][0][m][0], a1 = acc[ai][0][m][1], b0 = acc[ai][1][m][0], b1 = acc[ai][1][m][1];
                    const f32x4 o00 = (a0 * c0 - b0 * s0) * sc, o01 = (a1 * c1 - b1 * s1) * sc;
                    const f32x4 o10 = (a0 * s0 + b0 * c0) * sc, o11 = (a1 * s1 + b1 * c1) * sc;
                    bf16_t* rowp = QK + (size_t)row * 2048 + u.pn * BM + wc * 32 + 8 * fq;
                    u32x4 w; w.x = cvt_pk_bf16(o00[0], o00[1]); w.y = cvt_pk_bf16(o00[2], o00[3]); w.z = cvt_pk_bf16(o01[0], o01[1]); w.w = cvt_pk_bf16(o01[2], o01[3]);
                    *(u32x4*)rowp = w;
                    w.x = cvt_pk_bf16(o10[0], o10[1]); w.y = cvt_pk_bf16(o10[2], o10[3]); w.z = cvt_pk_bf16(o11[0], o11[1]); w.w = cvt_pk_bf16(o11[2], o11[3]);
                    *(u32x4*)(rowp + HALF) = w;
                }
        } else {
#pragma unroll
            for (int ai = 0; ai < 2; ++ai)
#pragma unroll
                for (int m = 0; m < 4; ++m) {
                    const int row = row0 + ai * HALF + m * 16;
                    bf16_t* rowp = VG + (size_t)row * 4096 + (u.pn - 8) * BM + wc * 32 + 8 * fq;
#pragma unroll
                    for (int bj = 0; bj < 2; ++bj) { const f32x4 v0 = acc[ai][bj][m][0], v1 = acc[ai][bj][m][1];
                        u32x4 w; w.x = cvt_pk_bf16(v0[0], v0[1]); w.y = cvt_pk_bf16(v0[2], v0[3]); w.z = cvt_pk_bf16(v1[0], v1[1]); w.w = cvt_pk_bf16(v1[2], v1[3]);
                        *(u32x4*)(rowp + bj * HALF) = w; }
                }
        }
    }
};
struct EpiQKV1 {
    static constexpr bool PERM = true, AFTER_DRAIN = false;
    bf16_t* Q1; size_t bstride;
    float* krp; float* vrp; float* krs; float* vrs;
    __device__ __forceinline__ void operator()(const f32x4 (&acc)[2][2][4][2], const Unit& u, int wr, int wc, int fr, int fq) const {
        const int row0 = u.pm * BM + wr * 64 + fr;
        const int t = u.pn >> 2;
        const int colt = (u.pn & 3) * BM + wc * 32 + 8 * fq;
        const float sc = (t == 0) ? 0.125f : 1.0f;
        bf16_t* base = Q1 + (size_t)t * bstride;
#pragma unroll
        for (int ai = 0; ai < 2; ++ai)
#pragma unroll
            for (int m = 0; m < 4; ++m) {
                const int row = row0 + ai * HALF + m * 16;
                bf16_t* rowp = base + (size_t)row * 1024 + colt;
#pragma unroll
                for (int bj = 0; bj < 2; ++bj) { const f32x4 v0 = acc[ai][bj][m][0] * sc, v1 = acc[ai][bj][m][1] * sc;
                    u32x4 w; w.x = cvt_pk_bf16(v0[0], v0[1]); w.y = cvt_pk_bf16(v0[2], v0[3]); w.z = cvt_pk_bf16(v1[0], v1[1]); w.w = cvt_pk_bf16(v1[2], v1[3]);
                    *(u32x4*)(rowp + bj * HALF) = w;
                    }
            }
    }
};
template <class Epi, class Sched, bool ALIGN_EPI = false, bool SP2 = false>
__device__ __forceinline__ void gemm_phase(PG8_LAS unsigned char* lds, const Gemm g, const Sched& S, const Epi& E, const int wid_in) {
    const int lane = (int)__builtin_amdgcn_mbcnt_hi(~0u, __builtin_amdgcn_mbcnt_lo(~0u, 0u)), wid = wid_in, tid = wid * 64 + lane, wr = wid >> 2, wc = wid & 3, fr = lane & 15, fq = lane >> 4;
    const int K = g.K, nt = K / BK;
    unsigned voffA[2], voffB[2];
#pragma unroll
    for (int i = 0; i < 2; ++i) { int R, C; stage_rc(tid * 16 + i * 8192, R, C); const int Rb = Epi::PERM ? ((R & ~31) + perm32(R & 31)) : R;
        voffA[i] = (unsigned)(R * g.lda + C) * 2u; voffB[i] = (unsigned)(Rb * g.ldb + C) * 2u; }
    const size_t kstep = (size_t)(BK * 2);
    const size_t hstepA = (size_t)HALF * g.lda * 2, hstepB = (size_t)HALF * g.ldb * 2;
    const size_t tstepA = 2 * hstepA, tstepB = 2 * hstepB;
    const unsigned ldsw = (unsigned)wid * 1024u;
    const int aoff = lds_byte(wr * 64 + fr, fq * 8), boff = lds_byte(wc * 32 + fr, fq * 8);
#define PG8_SA(b, h) (((b) * 2 + (h)) * HTB)
#define PG8_SB(b, h) ((4 + (b) * 2 + (h)) * HTB)
#define PG8_STAGE(bufoff, gbase, voff) do { _Pragma("unroll") for (int _i = 0; _i < 2; ++_i) \
        __builtin_amdgcn_global_load_lds((const unsigned*)((const char*)(gbase) + (voff)[_i]), (PG8_LAS unsigned*)(lds + (bufoff) + ldsw + _i * 8192), 16, 0, 0); } while (0)
#define PG8_LDA(dst, b, h) do { _Pragma("unroll") for (int m = 0; m < 4; ++m) _Pragma("unroll") for (int k = 0; k < 2; ++k) dst[m][k] = *(const PG8_LAS bf16x8*)(lds + PG8_SA(b, h) + aoff + m * 2048 + k * 1024); } while (0)
#define PG8_LDB(dst, b, h) do { _Pragma("unroll") for (int n = 0; n < 2; ++n) _Pragma("unroll") for (int k = 0; k < 2; ++k) dst[n][k] = *(const PG8_LAS bf16x8*)(lds + PG8_SB(b, h) + boff + n * 2048 + k * 1024); } while (0)
#define PG8_MMA(ai, bj, At, Bt) do { __builtin_amdgcn_s_setprio(1); _Pragma("unroll") for (int m = 0; m < 4; ++m) _Pragma("unroll") for (int n = 0; n < 2; ++n) _Pragma("unroll") for (int k = 0; k < 2; ++k) \
        acc[ai][bj][m][n] = __builtin_amdgcn_mfma_f32_16x16x32_bf16(Bt[n][k], At[m][k], acc[ai][bj][m][n], 0, 0, 0); __builtin_amdgcn_s_setprio(0); } while (0)
#define PG8_WAIT_V(n) asm volatile("s_waitcnt vmcnt(" #n ")" ::: "memory")
#define PG8_WAIT_L(n) asm volatile("s_waitcnt lgkmcnt(" #n ")" ::: "memory")
#define PG8_BAR __builtin_amdgcn_s_barrier()
#define PG8_SCHED __builtin_amdgcn_sched_barrier(0)
    Unit cur, nxt; int ui = 0;
    if (!S.next(0, cur)) return;
    f32x4 acc[2][2][4][2];
#pragma unroll
    for (int a = 0; a < 2; ++a)
#pragma unroll
        for (int b = 0; b < 2; ++b)
#pragma unroll
            for (int m = 0; m < 4; ++m)
#pragma unroll
                for (int n = 0; n < 2; ++n) acc[a][b][m][n] = (f32x4){0.f, 0.f, 0.f, 0.f};
    bf16x8 At[4][2], B0[2][2], B1[2][2];
    const char* cA = (const char*)g.A + (size_t)cur.pm * tstepA; const char* cB = (const char*)g.Bt + (size_t)cur.pn * tstepB;
    S.a_ready(cur);
    if constexpr (SP2) {
        PG8_STAGE(PG8_SB(0, 0), cB, voffB); PG8_STAGE(PG8_SB(0, 1), cB + hstepB, voffB); PG8_STAGE(PG8_SA(0, 0), cA, voffA); PG8_STAGE(PG8_SA(0, 1), cA + hstepA, voffA);
        if (wr == 1) PG8_BAR;
        PG8_WAIT_V(2); PG8_BAR;
        PG8_STAGE(PG8_SB(1, 0), cB + kstep, voffB); PG8_STAGE(PG8_SA(1, 0), cA + kstep, voffA); PG8_STAGE(PG8_SB(1, 1), cB + hstepB + kstep, voffB);
        PG8_WAIT_V(6); PG8_BAR;
    } else {
        PG8_STAGE(PG8_SB(0, 0), cB, voffB); PG8_STAGE(PG8_SA(0, 0), cA, voffA); PG8_STAGE(PG8_SB(0, 1), cB + hstepB, voffB); PG8_STAGE(PG8_SA(0, 1), cA + hstepA, voffA);
        if (wr == 1) PG8_BAR;
        PG8_WAIT_V(4); PG8_BAR;
        PG8_STAGE(PG8_SB(1, 0), cB + kstep, voffB); PG8_STAGE(PG8_SA(1, 0), cA + kstep, voffA); PG8_STAGE(PG8_SB(1, 1), cB + hstepB + kstep, voffB);
        PG8_WAIT_V(6); PG8_BAR;
    }
    for (;;) {
        const bool has_next = S.next(ui + 1, nxt);
        const char* nA = has_next ? (const char*)g.A + (size_t)nxt.pm * tstepA : cA; const char* nB = has_next ? (const char*)g.Bt + (size_t)nxt.pn * tstepB : cB;
        for (int t = 0; t < nt; t += 2) {
            const bool last = (t == nt - 2);
            const char* a1 = cA + (size_t)(t + 1) * kstep;
            const char* a2 = last ? nA : cA + (size_t)(t + 2) * kstep; const char* b2 = last ? nB : cB + (size_t)(t + 2) * kstep;
            const char* a3 = a2 + kstep; const char* b3 = b2 + kstep;
            if (last && has_next) S.a_ready(nxt);
            if constexpr (SP2) {
            PG8_LDB(B0, 0, 0); PG8_LDB(B1, 0, 1); PG8_SCHED; PG8_LDA(At, 0, 0); PG8_STAGE(PG8_SA(1, 1), a1 + hstepA, voffA);
            PG8_WAIT_V(8); PG8_WAIT_L(0); PG8_BAR; PG8_MMA(0, 0, At, B0); PG8_MMA(0, 1, At, B1); PG8_BAR; PG8_SCHED;
            PG8_LDA(At, 0, 1); PG8_STAGE(PG8_SB(0, 0), b2, voffB); PG8_STAGE(PG8_SB(0, 1), b2 + hstepB, voffB); PG8_STAGE(PG8_SA(0, 0), a2, voffA);
            PG8_WAIT_V(8); PG8_WAIT_L(0); PG8_BAR; PG8_MMA(1, 0, At, B0); PG8_MMA(1, 1, At, B1); PG8_BAR; PG8_SCHED;
            PG8_LDB(B0, 1, 0); PG8_LDB(B1, 1, 1); PG8_SCHED; PG8_LDA(At, 1, 0); PG8_STAGE(PG8_SA(0, 1), a2 + hstepA, voffA);
            PG8_WAIT_V(8); PG8_WAIT_L(0); PG8_BAR; PG8_MMA(0, 0, At, B0); PG8_MMA(0, 1, At, B1); PG8_BAR; PG8_SCHED;
            PG8_LDA(At, 1, 1); PG8_STAGE(PG8_SB(1, 0), b3, voffB); PG8_STAGE(PG8_SB(1, 1), b3 + hstepB, voffB); PG8_STAGE(PG8_SA(1, 0), a3, voffA);
            PG8_WAIT_V(8); PG8_WAIT_L(0); PG8_BAR; PG8_MMA(1, 0, At, B0); PG8_MMA(1, 1, At, B1); PG8_BAR; PG8_SCHED;
            } else {
            PG8_LDB(B0, 0, 0); PG8_SCHED; PG8_LDA(At, 0, 0); PG8_STAGE(PG8_SA(1, 1), a1 + hstepA, voffA);
            PG8_WAIT_L(8); PG8_BAR; PG8_WAIT_L(0); PG8_MMA(0, 0, At, B0); PG8_BAR; PG8_SCHED;
            PG8_LDB(B1, 0, 1); PG8_STAGE(PG8_SB(0, 0), b2, voffB);
            PG8_BAR; PG8_WAIT_L(0); PG8_MMA(0, 1, At, B1); PG8_BAR;
            PG8_LDA(At, 0, 1); PG8_STAGE(PG8_SA(0, 0), a2, voffA);
            PG8_BAR; PG8_WAIT_L(0); PG8_MMA(1, 0, At, B0); PG8_BAR; PG8_SCHED;
            PG8_STAGE(PG8_SB(0, 1), b2 + hstepB, voffB);
            PG8_WAIT_V(6); PG8_BAR; PG8_MMA(1, 1, At, B1); PG8_BAR;
            PG8_LDB(B0, 1, 0); PG8_SCHED; PG8_LDA(At, 1, 0); PG8_STAGE(PG8_SA(0, 1), a2 + hstepA, voffA);
            PG8_WAIT_L(8); PG8_BAR; PG8_WAIT_L(0); PG8_MMA(0, 0, At, B0); PG8_BAR; PG8_SCHED;
            PG8_LDB(B1, 1, 1); PG8_STAGE(PG8_SB(1, 0), b3, voffB);
            PG8_BAR; PG8_WAIT_L(0); PG8_MMA(0, 1, At, B1); PG8_BAR;
            PG8_LDA(At, 1, 1); PG8_STAGE(PG8_SA(1, 0), a3, voffA);
            PG8_BAR; PG8_WAIT_L(0); PG8_MMA(1, 0, At, B0); PG8_BAR; PG8_SCHED;
            PG8_STAGE(PG8_SB(1, 1), b3 + hstepB, voffB);
            PG8_WAIT_V(6); PG8_BAR; PG8_MMA(1, 1, At, B1); PG8_BAR;
            }
        }
        if constexpr (ALIGN_EPI) { if (wr == 0) PG8_BAR; }
        if constexpr (!Epi::AFTER_DRAIN) { E(acc, cur, wr, wc, fr, fq); S.done(cur); }
        if (!has_next) break;
#pragma unroll
        for (int a = 0; a < 2; ++a)
#pragma unroll
            for (int b = 0; b < 2; ++b)
#pragma unroll
                for (int m = 0; m < 4; ++m)
#pragma unroll
                    for (int n = 0; n < 2; ++n) acc[a][b][m][n] = (f32x4){0.f, 0.f, 0.f, 0.f};
        cur = nxt; cA = nA; cB = nB; ++ui;
        if constexpr (ALIGN_EPI) { if (wr == 1) PG8_BAR; }
    }
    PG8_WAIT_V(0);
    if constexpr (!ALIGN_EPI) { if (wr == 0) PG8_BAR; }
    PG8_BAR;
    if constexpr (Epi::AFTER_DRAIN) { E.fused(acc, cur, wr, wc, fr, fq, lds, wid, lane); S.done(cur); }
#undef PG8_SA
#undef PG8_SB
#undef PG8_STAGE
#undef PG8_LDA
#undef PG8_LDB
#undef PG8_MMA
#undef PG8_WAIT_V
#undef PG8_WAIT_L
#undef PG8_BAR
#undef PG8_SCHED
}
}
#define XB_TMO      128
#define XB_XCNT(j)  (256  + 64 * (j))
#define XB_XSUB(j)  (1280 + 64 * (j))
#define XB_XGEN(j)  (2304 + 64 * (j))
#define XB_TOP      3328
#define XB_TOPGEN   3392
#define XCD_BAR_WORDS 3456
#define XB_SPIN_CAP (1u << 18)

__device__ __forceinline__ unsigned xb_ld(unsigned* p)              { return __hip_atomic_load(p, __ATOMIC_RELAXED, __HIP_MEMORY_SCOPE_AGENT); }
__device__ __forceinline__ unsigned xb_add(unsigned* p, unsigned v) { return __hip_atomic_fetch_add(p, v, __ATOMIC_RELAXED, __HIP_MEMORY_SCOPE_AGENT); }
__device__ __forceinline__ unsigned xb_xcc_id() { return (unsigned)__builtin_amdgcn_s_getreg((3 << 11) | 20) & 0xFu; }
#define XB_SPIN(cond, bar) do { unsigned _sp = 0; while (cond) { __builtin_amdgcn_s_sleep(1); \
    if ((++_sp & 255u) == 0u) { if (xb_ld(&(bar)[XB_TMO])) break; if (_sp > XB_SPIN_CAP) { atomicAdd(&(bar)[XB_TMO], 1u); break; } } } } while (0)

struct XcdBarrier {
    unsigned* bar; unsigned x;
    volatile LAS unsigned* st;
};

__device__ __forceinline__ XcdBarrier xcd_barrier_post(unsigned* bar, volatile LAS unsigned* st, const bool is_t0) {
    XcdBarrier b; b.bar = bar; b.x = xb_xcc_id(); b.st = st;
    if (is_t0) (void)xb_add(&bar[XB_XCNT(b.x)], 1u);
    return b;
}
__device__ __forceinline__ void xcd_barrier_complete(unsigned* bar, unsigned x, unsigned& nloc, unsigned& nx) {
    const unsigned G = gridDim.x * gridDim.y * gridDim.z;
    unsigned sum, cnt, mine, sp = 0u;
    for (;;) {
        sum = 0u; cnt = 0u; mine = 0u;
#pragma unroll
        for (unsigned j = 0; j < 16; ++j) { const unsigned c = xb_ld(&bar[XB_XCNT(j)]); sum += c; cnt += (c > 0u) ? 1u : 0u; mine = (j == x) ? c : mine; }
        if (sum == G) break;
        __builtin_amdgcn_s_sleep(1);
        if ((++sp & 255u) == 0u) { if (xb_ld(&bar[XB_TMO])) break; if (sp > XB_SPIN_CAP) { atomicAdd(&bar[XB_TMO], 1u); break; } }
    }
    nloc = mine > 0u ? mine : 1u; nx = cnt > 0u ? cnt : 1u;
}

__device__ __forceinline__ void xcd_barrier(const XcdBarrier& b, const bool is_t0) {
    asm volatile("s_waitcnt vmcnt(0)" ::: "memory");
    __syncthreads();
    if (is_t0) {
        unsigned* bar = b.bar;
        __builtin_amdgcn_s_waitcnt(0);
        unsigned nloc = b.st[0], nx = b.st[1];
        if (nloc == 0u) { xcd_barrier_complete(bar, b.x, nloc, nx); b.st[0] = nloc; b.st[1] = nx; }
        const unsigned old = xb_add(&bar[XB_XSUB(b.x)], 1u);
        const unsigned gen = old / nloc;
        if (old + 1u == (gen + 1u) * nloc) {
            __builtin_amdgcn_fence(__ATOMIC_RELEASE, "agent");
            asm volatile("s_waitcnt vmcnt(0)" ::: "memory");
            const unsigned og = xb_add(&bar[XB_TOP], 1u);
            const unsigned tg = og / nx;
            if (og + 1u == (tg + 1u) * nx) xb_add(&bar[XB_TOPGEN], 1u);
            else XB_SPIN(xb_ld(&bar[XB_TOPGEN]) == tg, bar);
            __builtin_amdgcn_fence(__ATOMIC_ACQUIRE, "agent");
            xb_add(&bar[XB_XGEN(b.x)], 1u);
            asm volatile("s_waitcnt vmcnt(0)" ::: "memory");
        } else {
            XB_SPIN(xb_ld(&bar[XB_XGEN(b.x)]) == gen, bar);
            __builtin_amdgcn_fence(__ATOMIC_ACQUIRE, "agent");
            asm volatile("s_waitcnt vmcnt(0)" ::: "memory");
        }
    }
    __syncthreads();
}

__device__ const float ROPE_INV[128] = {1.000000000e+00f, 9.305720329e-01f, 8.659643531e-01f, 8.058421612e-01f, 7.498942614e-01f, 6.978306174e-01f, 6.493816376e-01f, 6.042963862e-01f, 5.623413324e-01f, 5.232990980e-01f, 4.869675338e-01f, 4.531583786e-01f, 4.216965139e-01f, 3.924189806e-01f, 3.651741147e-01f, 3.398208320e-01f, 3.162277639e-01f, 2.942726910e-01f, 2.738419771e-01f, 2.548296750e-01f, 2.371373773e-01f, 2.206734121e-01f, 2.053525001e-01f, 1.910953075e-01f, 1.778279394e-01f, 1.654817164e-01f, 1.539926529e-01f, 1.433012486e-01f, 1.333521307e-01f, 1.240937784e-01f, 1.154782027e-01f, 1.074607819e-01f, 1.000000015e-01f, 9.305720776e-02f, 8.659642935e-02f, 8.058421314e-02f, 7.498941571e-02f, 6.978306174e-02f, 6.493816525e-02f, 6.042964011e-02f, 5.623413250e-02f, 5.232991278e-02f, 4.869675264e-02f, 4.531583562e-02f, 4.216965288e-02f, 3.924189508e-02f, 3.651741147e-02f, 3.398208320e-02f, 3.162277490e-02f, 2.942727134e-02f, 2.738419734e-02f, 2.548296750e-02f, 2.371373773e-02f, 2.206734009e-02f, 2.053525113e-02f, 1.910952851e-02f, 1.778279431e-02f, 1.654816978e-02f, 1.539926510e-02f, 1.433012541e-02f, 1.333521493e-02f, 1.240937784e-02f, 1.154782064e-02f, 1.074607857e-02f, 9.999999776e-03f, 9.305720218e-03f, 8.659643121e-03f, 8.058422245e-03f, 7.498941850e-03f, 6.978305988e-03f, 6.493816152e-03f, 6.042963825e-03f, 5.623413250e-03f, 5.232991185e-03f, 4.869675264e-03f, 4.531583283e-03f, 4.216964822e-03f, 3.924189601e-03f, 3.651741194e-03f, 3.398208413e-03f, 3.162277630e-03f, 2.942727180e-03f, 2.738419687e-03f, 2.548296936e-03f, 2.371373586e-03f, 2.206734149e-03f, 2.053524833e-03f, 1.910952968e-03f, 1.778279431e-03f, 1.654817141e-03f, 1.539926510e-03f, 1.433012541e-03f, 1.333521446e-03f, 1.240937738e-03f, 1.154781901e-03f, 1.074607833e-03f, 1.000000047e-03f, 9.305720450e-04f, 8.659643354e-04f, 8.058421663e-04f, 7.498942432e-04f, 6.978305755e-04f, 6.493816618e-04f, 6.042963942e-04f, 5.623413017e-04f, 5.232990952e-04f, 4.869675322e-04f, 4.531583691e-04f, 4.216965172e-04f, 3.924189659e-04f, 3.651741426e-04f, 3.398208355e-04f, 3.162277571e-04f, 2.942727006e-04f, 2.738419571e-04f, 2.548296761e-04f, 2.371373703e-04f, 2.206734061e-04f, 2.053525095e-04f, 1.910952997e-04f, 1.778279402e-04f, 1.654817170e-04f, 1.539926452e-04f, 1.433012512e-04f, 1.333521504e-04f, 1.240937709e-04f, 1.154782003e-04f, 1.074607862e-04f};
#define CE_(a, b) do { const int hi_ = (a) > (b) ? (a) : (b), lo_ = (a) > (b) ? (b) : (a); (a) = hi_; (b) = lo_; } while (0)
#define SORT16(X) do { CE_(X[0], X[1]); CE_(X[2], X[3]); CE_(X[4], X[5]); CE_(X[6], X[7]); CE_(X[8], X[9]); CE_(X[10], X[11]); CE_(X[12], X[13]); CE_(X[14], X[15]); CE_(X[0], X[2]); CE_(X[1], X[3]); CE_(X[4], X[6]); CE_(X[5], X[7]); CE_(X[8], X[10]); CE_(X[9], X[11]); CE_(X[12], X[14]); CE_(X[13], X[15]); CE_(X[1], X[2]); CE_(X[5], X[6]); CE_(X[9], X[10]); CE_(X[13], X[14]); CE_(X[0], X[4]); CE_(X[1], X[5]); CE_(X[2], X[6]); CE_(X[3], X[7]); CE_(X[8], X[12]); CE_(X[9], X[13]); CE_(X[10], X[14]); CE_(X[11], X[15]); CE_(X[2], X[4]); CE_(X[3], X[5]); CE_(X[10], X[12]); CE_(X[11], X[13]); CE_(X[1], X[2]); CE_(X[3], X[4]); CE_(X[5], X[6]); CE_(X[9], X[10]); CE_(X[11], X[12]); CE_(X[13], X[14]); CE_(X[0], X[8]); CE_(X[1], X[9]); CE_(X[2], X[10]); CE_(X[3], X[11]); CE_(X[4], X[12]); CE_(X[5], X[13]); CE_(X[6], X[14]); CE_(X[7], X[15]); CE_(X[4], X[8]); CE_(X[5], X[9]); CE_(X[6], X[10]); CE_(X[7], X[11]); CE_(X[2], X[4]); CE_(X[3], X[5]); CE_(X[6], X[8]); CE_(X[7], X[9]); CE_(X[10], X[12]); CE_(X[11], X[13]); CE_(X[1], X[2]); CE_(X[3], X[4]); CE_(X[5], X[6]); CE_(X[7], X[8]); CE_(X[9], X[10]); CE_(X[11], X[12]); CE_(X[13], X[14]); } while (0)
#define BITONIC16(X) do { CE_(X[0], X[8]); CE_(X[1], X[9]); CE_(X[2], X[10]); CE_(X[3], X[11]); CE_(X[4], X[12]); CE_(X[5], X[13]); CE_(X[6], X[14]); CE_(X[7], X[15]); CE_(X[0], X[4]); CE_(X[1], X[5]); CE_(X[2], X[6]); CE_(X[3], X[7]); CE_(X[8], X[12]); CE_(X[9], X[13]); CE_(X[10], X[14]); CE_(X[11], X[15]); CE_(X[0], X[2]); CE_(X[1], X[3]); CE_(X[4], X[6]); CE_(X[5], X[7]); CE_(X[8], X[10]); CE_(X[9], X[11]); CE_(X[12], X[14]); CE_(X[13], X[15]); CE_(X[0], X[1]); CE_(X[2], X[3]); CE_(X[4], X[5]); CE_(X[6], X[7]); CE_(X[8], X[9]); CE_(X[10], X[11]); CE_(X[12], X[13]); CE_(X[14], X[15]); } while (0)
#define MERGE_PRUNE(A, B) do { A[0] = (A[0] > B[15]) ? A[0] : B[15]; A[1] = (A[1] > B[14]) ? A[1] : B[14]; A[2] = (A[2] > B[13]) ? A[2] : B[13]; A[3] = (A[3] > B[12]) ? A[3] : B[12]; A[4] = (A[4] > B[11]) ? A[4] : B[11]; A[5] = (A[5] > B[10]) ? A[5] : B[10]; A[6] = (A[6] > B[9]) ? A[6] : B[9]; A[7] = (A[7] > B[8]) ? A[7] : B[8]; A[8] = (A[8] > B[7]) ? A[8] : B[7]; A[9] = (A[9] > B[6]) ? A[9] : B[6]; A[10] = (A[10] > B[5]) ? A[10] : B[5]; A[11] = (A[11] > B[4]) ? A[11] : B[4]; A[12] = (A[12] > B[3]) ? A[12] : B[3]; A[13] = (A[13] > B[2]) ? A[13] : B[2]; A[14] = (A[14] > B[1]) ? A[14] : B[1]; A[15] = (A[15] > B[0]) ? A[15] : B[0]; BITONIC16(A); } while (0)
#ifndef PG8_SP2
#define PG8_SP2 true
#endif
#ifndef PG8_ALIGN
#define PG8_ALIGN true
#endif
constexpr int NWAVES = 8, NTHR = 512;
constexpr int D = 1024, TP = 65536, TS = 1024, T = TP + TS;
constexpr int NPH = 18;
#ifndef MK_ONE_LAUNCH
#define MK_ONE_LAUNCH 1
#endif
constexpr float LN_EPS = 1e-5f, GN_EPS = 1e-6f, ALPHA = 1.41421356237309515f;
constexpr float LOG2E = 1.4426950408889634f, LN2 = 0.6931471805599453f;
constexpr float SB_EXIT = -110.0f;
constexpr size_t O_Y = 0, O_RSP = 68157440, O_RSS = 72351744, O_KRP = 80740352, O_VRP = 147849216, O_KRS = 214958080, O_VRS = 216006656, O_END = 217055232;
constexpr size_t MiB = 1u << 20;
constexpr size_t WS_CTL = 0, CTL_ZERO_BYTES = 1 * MiB;
constexpr size_t WS_WIN = 1 * MiB, WS_WRO = 13 * MiB, WS_WQKV = 17 * MiB, WS_WSO = 23 * MiB, WS_WPQ = 25 * MiB, WS_KEYS = 33 * MiB, WS_COS = 34 * MiB, WS_SIN = 38 * MiB;
constexpr size_t WS_PU = 42 * MiB, WS_PV = 74 * MiB, WS_RS = 106 * MiB  , WS_XB = 170 * MiB, WS_M1 = 300 * MiB, WS_VG = 430 * MiB, WS_IDX = 950 * MiB, WS_GATE = 983 * MiB, WS_END = 1016 * MiB;
constexpr int CW_BAR = 4096;
#ifndef QUANT_IN_RET
#define QUANT_IN_RET 0
#endif
constexpr int LN_TAIL_ROWS0 = 92, LN_TAIL_ROWS1 = 60;
constexpr int RING_BYTES = 155648;
constexpr int LDSCTL_OFF = RING_BYTES, MISC_OFF = LDSCTL_OFF + 320;
constexpr int LDS_BYTES = 163840;

typedef unsigned short bf16;
typedef unsigned v4u __attribute__((ext_vector_type(4)));
typedef unsigned v2u __attribute__((ext_vector_type(2)));
typedef float f32x4 __attribute__((ext_vector_type(4)));
typedef float f32x2 __attribute__((ext_vector_type(2)));
typedef float f32x16 __attribute__((ext_vector_type(16)));
typedef short bf16x8 __attribute__((ext_vector_type(8)));
typedef short s16x4 __attribute__((ext_vector_type(4)));
typedef GAS unsigned gu32;
#define RLX_AGENT __ATOMIC_RELAXED, __HIP_MEMORY_SCOPE_AGENT
#define LDS_WAIT() asm volatile("s_waitcnt lgkmcnt(0)" ::: "memory")
#define VM_WAIT() asm volatile("s_waitcnt vmcnt(0)" ::: "memory")

struct Frame {
    LAS unsigned char* lds;
    volatile LAS unsigned* MISC;
    gu32* ctl;
    int wave, G;
    const float* in[16]; float* out; unsigned char* ws;
};

typedef __bf16 bf16x2_t __attribute__((ext_vector_type(2)));
__device__ __forceinline__ int lane_id() { return (int)__builtin_amdgcn_mbcnt_hi(~0u, __builtin_amdgcn_mbcnt_lo(~0u, 0u)); }
__device__ __forceinline__ unsigned pkbf(float lo, float hi) { const f32x2 v = {lo, hi}; const bf16x2_t b = __builtin_convertvector(v, bf16x2_t); return __builtin_bit_cast(unsigned, b); }
__device__ __forceinline__ float bflo(unsigned u) { return __uint_as_float(u << 16); }
__device__ __forceinline__ float bfhi(unsigned u) { return __uint_as_float(u & 0xffff0000u); }
__device__ __forceinline__ float wave_sum(float v) {
#pragma unroll
    for (int o = 1; o < 64; o <<= 1) v += __shfl_xor(v, o);
    return v;
}
__device__ __forceinline__ f32x4 mfma16(bf16x8 a, bf16x8 b, f32x4 c) { return __builtin_amdgcn_mfma_f32_16x16x32_bf16(a, b, c, 0, 0, 0); }
__device__ __forceinline__ f32x16 mfma32(bf16x8 a, bf16x8 b, f32x16 c) { return __builtin_amdgcn_mfma_f32_32x32x16_bf16(a, b, c, 0, 0, 0); }
typedef short v4i16_t __attribute__((ext_vector_type(4)));
__device__ __forceinline__ s16x4 trrd(LAS const unsigned char* p) { return __builtin_bit_cast(s16x4, __builtin_amdgcn_ds_read_tr16_b64_v4i16((LAS v4i16_t*)p)); }
__device__ __forceinline__ bf16x8 cat8(s16x4 lo, s16x4 hi) { return (bf16x8){lo[0], lo[1], lo[2], lo[3], hi[0], hi[1], hi[2], hi[3]}; }
__device__ __forceinline__ v4u ldg16(const void* ubase, unsigned voff) { return *(const GAS v4u*)((const GAS char*)ubase + voff); }
__device__ __forceinline__ int crow(int r, int hi) { return (r & 3) + 8 * (r >> 2) + 4 * hi; }

#define CW_TAIL(k) (8192 + 64 * (k))
namespace pg8 {
struct TailOrder {
    int nN, G, c;
    __device__ __forceinline__ bool next(int i, Unit& u) const { const int L = i * G + c; if (L >= 4 * nN) return false; u.pm = TP / BM + (L & 3); u.pn = L >> 2; return true; }
    __device__ __forceinline__ void a_ready(const Unit&) const {}
    __device__ __forceinline__ void done(const Unit&) const {}
};
}
__device__ __forceinline__ int tail_wgs(const Frame& F, int nN) { return 4 * nN < F.G ? 4 * nN : F.G; }
__device__ __forceinline__ void tail_publish(Frame& F, int k) {
    asm volatile("s_waitcnt vmcnt(0)" ::: "memory");
    __syncthreads();
    if (F.wave == 0 && lane_id() == 0) {
        __builtin_amdgcn_fence(__ATOMIC_RELEASE, "agent");
        asm volatile("s_waitcnt vmcnt(0)" ::: "memory");
        (void)xb_add((unsigned*)(F.ctl + CW_TAIL(k)), 1u);
    }
}
__device__ __forceinline__ void tail_wait(Frame& F, int k, int n) {
    if (F.wave == 0 && lane_id() == 0) {
        unsigned* bar = (unsigned*)(F.ctl + CW_BAR);
        XB_SPIN(xb_ld((unsigned*)(F.ctl + CW_TAIL(k))) < (unsigned)n, bar);
        __builtin_amdgcn_fence(__ATOMIC_ACQUIRE, "agent");
        asm volatile("s_waitcnt vmcnt(0)" ::: "memory");
    }
    __syncthreads();
}

__device__ __forceinline__ void tail_wait_wave(Frame& F, int k, int n) {
    unsigned* bar = (unsigned*)(F.ctl + CW_BAR); unsigned* p = (unsigned*)(F.ctl + CW_TAIL(k));
    unsigned sp = 0;
    while ((unsigned)__builtin_amdgcn_readfirstlane((int)xb_ld(p)) < (unsigned)n) {
        __builtin_amdgcn_s_sleep(2);
        if ((++sp & 255u) == 0u) { if (__builtin_amdgcn_readfirstlane((int)xb_ld(&bar[XB_TMO])) != 0) break; if (sp > XB_SPIN_CAP) { if (lane_id() == 0) atomicAdd(&bar[XB_TMO], 1u); break; } }
    }
    __builtin_amdgcn_fence(__ATOMIC_ACQUIRE, "agent");
    asm volatile("s_waitcnt vmcnt(0)" ::: "memory");
}

__device__ __forceinline__ void p0_transpose_item(const float* W, int K, int N, bf16* WT, LAS float* scr, int item, int lane) {
    const int nblk = N / 32, kb = item / nblk, nb = item % nblk, k0 = 64 * kb, n0 = 32 * nb;
#pragma unroll 8
    for (int i = 0; i < 32; ++i) { const int kk = 2 * i + (lane >> 5); scr[kk * 33 + (lane & 31)] = W[(size_t)(k0 + kk) * N + n0 + (lane & 31)]; }
    LDS_WAIT(); asm volatile("" ::: "memory");
    const int c = lane & 7;
#pragma unroll
    for (int j = 0; j < 4; ++j) { const int n = (lane >> 3) + 8 * j; const LAS float* s = scr + (8 * c) * 33 + n;
        v4u o; o.x = pkbf(s[0 * 33], s[1 * 33]); o.y = pkbf(s[2 * 33], s[3 * 33]); o.z = pkbf(s[4 * 33], s[5 * 33]); o.w = pkbf(s[6 * 33], s[7 * 33]);
        *(GAS v4u*)(WT + (size_t)(n0 + n) * K + k0 + 8 * c) = o; }
    LDS_WAIT(); asm volatile("" ::: "memory");
}
__device__ __forceinline__ void cvt_bf16_span(const float* src, bf16* dst, size_t n8, size_t gt, size_t ngt) {
    for (size_t i = gt; i < n8; i += ngt) { const f32x4 a = *(const GAS f32x4*)(src + i * 8), b = *(const GAS f32x4*)(src + i * 8 + 4);
        v4u o; o.x = pkbf(a[0], a[1]); o.y = pkbf(a[2], a[3]); o.z = pkbf(b[0], b[1]); o.w = pkbf(b[2], b[3]); *(GAS v4u*)(dst + i * 8) = o; }
}
__device__ __forceinline__ float dpp_max0(float v, const int ctrl_sel) {
    int t;
    switch (ctrl_sel) {
        case 0: t = __builtin_amdgcn_update_dpp(0, __float_as_int(v), 0x111, 0xf, 0xf, false); break;
        case 1: t = __builtin_amdgcn_update_dpp(0, __float_as_int(v), 0x112, 0xf, 0xf, false); break;
        case 2: t = __builtin_amdgcn_update_dpp(0, __float_as_int(v), 0x114, 0xf, 0xf, false); break;
        case 3: t = __builtin_amdgcn_update_dpp(0, __float_as_int(v), 0x118, 0xf, 0xf, false); break;
        case 4: t = __builtin_amdgcn_update_dpp(0, __float_as_int(v), 0x142, 0xa, 0xf, false); break;
        default: t = __builtin_amdgcn_update_dpp(0, __float_as_int(v), 0x143, 0xc, 0xf, false); break;
    }
    return __builtin_fmaxf(v, __int_as_float(t));
}
__device__ __forceinline__ float dpp_add0(float v, const int ctrl_sel) {
    int t;
    switch (ctrl_sel) {
        case 0: t = __builtin_amdgcn_update_dpp(0, __float_as_int(v), 0x111, 0xf, 0xf, false); break;
        case 1: t = __builtin_amdgcn_update_dpp(0, __float_as_int(v), 0x112, 0xf, 0xf, false); break;
        case 2: t = __builtin_amdgcn_update_dpp(0, __float_as_int(v), 0x114, 0xf, 0xf, false); break;
        case 3: t = __builtin_amdgcn_update_dpp(0, __float_as_int(v), 0x118, 0xf, 0xf, false); break;
        case 4: t = __builtin_amdgcn_update_dpp(0, __float_as_int(v), 0x142, 0xa, 0xf, false); break;
        default: t = __builtin_amdgcn_update_dpp(0, __float_as_int(v), 0x143, 0xc, 0xf, false); break;
    }
    return v + __int_as_float(t);
}
__device__ __forceinline__ float wave_sum_dpp(float v) {
    v = dpp_add0(v, 0); v = dpp_add0(v, 1); v = dpp_add0(v, 2); v = dpp_add0(v, 3); v = dpp_add0(v, 4); v = dpp_add0(v, 5);
    return __int_as_float(__builtin_amdgcn_readlane(__float_as_int(v), 63));
}
__device__ __forceinline__ float wave_max_nonneg(float m) {
    m = dpp_max0(m, 0); m = dpp_max0(m, 1); m = dpp_max0(m, 2); m = dpp_max0(m, 3); m = dpp_max0(m, 4); m = dpp_max0(m, 5);
    return __int_as_float(__builtin_amdgcn_readlane(__float_as_int(m), 63));
}
__device__ __forceinline__ void quant_row(const f32x4 (&a)[4], unsigned char* dst, float* rs, int lane) {
    float m = 0.f;
#pragma unroll
    for (int i = 0; i < 4; ++i) m = __builtin_fmaxf(m, __builtin_fmaxf(__builtin_fmaxf(__builtin_fabsf(a[i][0]), __builtin_fabsf(a[i][1])), __builtin_fmaxf(__builtin_fabsf(a[i][2]), __builtin_fabsf(a[i][3]))));
    m = wave_max_nonneg(m);
    const float scale = (m > 1e-30f) ? 6.0f / m : 1.0f, rscale = (m > 1e-30f) ? m * (1.0f / 6.0f) : 1.0f;
    v2u w;
#pragma unroll
    for (int d = 0; d < 2; ++d) { unsigned q = 0u;
        q = __builtin_amdgcn_cvt_scalef32_pk_fp4_f32(q, a[2 * d][0] * scale, a[2 * d][1] * scale, 1.0f, 0);
        q = __builtin_amdgcn_cvt_scalef32_pk_fp4_f32(q, a[2 * d][2] * scale, a[2 * d][3] * scale, 1.0f, 1);
        q = __builtin_amdgcn_cvt_scalef32_pk_fp4_f32(q, a[2 * d + 1][0] * scale, a[2 * d + 1][1] * scale, 1.0f, 2);
        q = __builtin_amdgcn_cvt_scalef32_pk_fp4_f32(q, a[2 * d + 1][2] * scale, a[2 * d + 1][3] * scale, 1.0f, 3);
        w[d] = q; }
    *(GAS v2u*)(dst + 8 * lane) = w;
    if (lane == 0) *rs = rscale;
}
__device__ __forceinline__ void quant_row_c(const f32x4 (&a)[4], unsigned char* dst, float* rs, int lane) {
    float m = 0.f;
#pragma unroll
    for (int i = 0; i < 4; ++i) m = __builtin_fmaxf(m, __builtin_fmaxf(__builtin_fmaxf(__builtin_fabsf(a[i][0]), __builtin_fabsf(a[i][1])), __builtin_fmaxf(__builtin_fabsf(a[i][2]), __builtin_fabsf(a[i][3]))));
    m = wave_max_nonneg(m);
    const float scale = (m > 1e-30f) ? 6.0f / m : 1.0f, rscale = (m > 1e-30f) ? m * (1.0f / 6.0f) : 1.0f;
#pragma unroll
    for (int i = 0; i < 4; ++i) { unsigned q = 0u;
        q = __builtin_amdgcn_cvt_scalef32_pk_fp4_f32(q, a[i][0] * scale, a[i][1] * scale, 1.0f, 0);
        q = __builtin_amdgcn_cvt_scalef32_pk_fp4_f32(q, a[i][2] * scale, a[i][3] * scale, 1.0f, 1);
        *(GAS unsigned short*)(dst + 128 * i + 2 * lane) = (unsigned short)(q & 0xffffu); }
    if (lane == 0) *rs = rscale;
}
__device__ __forceinline__ const float* qrow_src(const Frame& F, int R) { return ((R >> 15) ? F.in[13] : F.in[12]) + (size_t)(R & 32767) * 1024; }
__device__ __forceinline__ unsigned char* qrow_dst(const Frame& F, int R) { return F.ws + ((R >> 15) ? WS_PV : WS_PU) + (size_t)(R & 32767) * 512; }
__device__ __forceinline__ float* qrow_rs(const Frame& F, int R) { return (float*)(F.ws + WS_RS) + (size_t)((R >> 14) & 1) * 32768 + (size_t)(R & 16383) * 2 + (R >> 15); }
__device__ __forceinline__ void sincos_d(double a, double& s, double& c) {
    const double kq = __builtin_rint(a * 0.63661977236758134308);
    const double y = (a - kq * 1.57079632673412561417e+00) - kq * 6.07710050650619224932e-11;
    const double y2 = y * y;
    const double sp = y * (1.0 + y2 * (-1.0 / 6 + y2 * (1.0 / 120 + y2 * (-1.0 / 5040 + y2 * (1.0 / 362880 + y2 * (-1.0 / 39916800 + y2 * (1.0 / 6227020800.0 + y2 * (-1.0 / 1307674368000.0))))))));
    const double cp = 1.0 + y2 * (-0.5 + y2 * (1.0 / 24 + y2 * (-1.0 / 720 + y2 * (1.0 / 40320 + y2 * (-1.0 / 3628800 + y2 * (1.0 / 479001600 + y2 * (-1.0 / 87178291200.0 + y2 * (1.0 / 20922789888000.0))))))));
    const int k = (int)kq & 3;
    s = (k == 0) ? sp : (k == 1) ? cp : (k == 2) ? -sp : -cp;
    c = (k == 0) ? cp : (k == 1) ? -sp : (k == 2) ? -cp : sp;
}
__device__ __forceinline__ void p0_prologue(Frame& F) {
    LAS float* scr = (LAS float*)(F.lds + F.wave * 16384);
    const int gw = blockIdx.x * NWAVES + F.wave, NGW = F.G * NWAVES;
    const float* ret_w_in = F.in[5]; const float* ret_w_o = F.in[6]; const float* sb_w_qkv = F.in[7]; const float* sb_w_o = F.in[8]; const float* peer_w_q = F.in[9];
    constexpr int I_IN = (1024 / 64) * (6144 / 32), I_RO = (2048 / 64) * (1024 / 32), I_QKV = (1024 / 64) * (3072 / 32), I_SO = (1024 / 64) * (1024 / 32), I_PQ = (1024 / 64) * (2048 / 32);
    constexpr int NITEMS = I_IN + I_RO + I_QKV + I_SO + 2 * I_PQ;
    for (int it = gw; it < NITEMS; it += NGW) {
        int r = it;
        if (r < I_IN) { p0_transpose_item(ret_w_in, 1024, 6144, (bf16*)(F.ws + WS_WIN), scr, r, lane_id()); continue; } r -= I_IN;
        if (r < I_RO) { p0_transpose_item(ret_w_o, 2048, 1024, (bf16*)(F.ws + WS_WRO), scr, r, lane_id()); continue; } r -= I_RO;
        if (r < I_QKV) { p0_transpose_item(sb_w_qkv, 1024, 3072, (bf16*)(F.ws + WS_WQKV), scr, r, lane_id()); continue; } r -= I_QKV;
        if (r < I_SO) { p0_transpose_item(sb_w_o, 1024, 1024, (bf16*)(F.ws + WS_WSO), scr, r, lane_id()); continue; } r -= I_SO;
        if (r < I_PQ) { p0_transpose_item(peer_w_q, 1024, 2048, (bf16*)(F.ws + WS_WPQ), scr, r, lane_id()); continue; } r -= I_PQ;
        p0_transpose_item(peer_w_q + (size_t)1024 * 2048, 1024, 2048, (bf16*)(F.ws + WS_WPQ + 4 * MiB), scr, r, lane_id());
    }
    const size_t gt = (size_t)blockIdx.x * NTHR + (F.wave * 64 + lane_id()), ngt = (size_t)F.G * NTHR;
    cvt_bf16_span(F.in[10], (bf16*)(F.ws + WS_KEYS), 131072 / 8, gt, ngt);
    cvt_bf16_span(F.in[11], (bf16*)(F.ws + WS_KEYS + 256 * 1024), 131072 / 8, gt, ngt);
    cvt_bf16_span(F.in[10] + 131072, (bf16*)(F.ws + WS_KEYS + 512 * 1024), 131072 / 8, gt, ngt);
    cvt_bf16_span(F.in[11] + 131072, (bf16*)(F.ws + WS_KEYS + 768 * 1024), 131072 / 8, gt, ngt);
#if !QUANT_IN_RET
    for (int R = gw; R < 65536; R += NGW) { f32x4 qa[4]; const float* qs = qrow_src(F, R) + 4 * lane_id();
#pragma unroll
        for (int i = 0; i < 4; ++i) qa[i] = __builtin_nontemporal_load((const GAS f32x4*)(qs + 256 * i));
        quant_row_c(qa, qrow_dst(F, R), qrow_rs(F, R), lane_id()); }
#endif
    cvt_bf16_span(F.in[0], (bf16*)(F.ws + WS_XB), (size_t)TP * D / 8, gt, ngt);
    cvt_bf16_span(F.in[1], (bf16*)(F.ws + WS_XB) + (size_t)TP * D, (size_t)TS * D / 8, gt, ngt);
    float* cosT = (float*)(F.ws + WS_COS); float* sinT = (float*)(F.ws + WS_SIN);
    for (size_t i = gt; i < (size_t)8192 * 128; i += ngt) {
        const int pos = (int)(i >> 7), fi = (int)(i & 127);
        const float inv = ROPE_INV[fi];
        const float ang = (float)pos * inv;
        double s, c; sincos_d((double)ang, s, c);
        cosT[i] = (float)c; sinT[i] = (float)s;
    }
}

__device__ __forceinline__ void ret_phase(Frame& F) {
    constexpr int QS = 0, KS = 33792, SS = 67584, VS = 101376, AS = 110592;
    LAS unsigned char* lds = F.lds;
    const int lane = lane_id(), tid = F.wave * 64 + lane, w = F.wave, fr = lane & 15, q4 = lane >> 4;
    const bf16* QK = (const bf16*)(F.out + O_KRP);
    bf16* VG = (bf16*)(F.ws + WS_VG);
    const int RPW = (65536 + F.G - 1) / F.G, qr0 = (int)blockIdx.x * RPW, qr1 = (qr0 + RPW < 65536) ? qr0 + RPW : 65536;
    const int RPC = (RPW + 127) / 128 < NWAVES ? (RPW + 127) / 128 : NWAVES;
    int qnext = qr0;
    for (int item = blockIdx.x; item < 768; item += F.G) {
        int bh, es, nchunk; size_t row0; const float* S0; float* Sout;
        if (item < 256) { bh = item & 31; es = item >> 5; nchunk = 128; row0 = (size_t)(bh >> 2) * 8192; S0 = nullptr; Sout = F.out + O_RSP + (size_t)bh * 131072; }
        else { const int it = item - 256; bh = it & 63; es = it >> 6; nchunk = 1; row0 = 65536 + (size_t)(bh >> 2) * 64; S0 = F.in[2] + (size_t)bh * 131072; Sout = F.out + O_RSS + (size_t)bh * 131072; }
        const int h = bh & 3;
        const float l2g = __builtin_amdgcn_logf(1.0f - __builtin_amdgcn_exp2f(-5.0f - (float)h));
        const float gam = __builtin_amdgcn_exp2f(l2g), gam64 = __builtin_amdgcn_exp2f(64.0f * l2g), rgam = __builtin_amdgcn_exp2f(-l2g);
        f32x4 S[2][4];
#pragma unroll
        for (int dl = 0; dl < 2; ++dl)
#pragma unroll
            for (int et = 0; et < 4; ++et) {
                f32x4 v = (f32x4){0.f, 0.f, 0.f, 0.f};
                if (S0) {
#pragma unroll
                    for (int j = 0; j < 4; ++j) v[j] = gam * S0[(size_t)(32 * w + 16 * dl + 4 * q4 + j) * 512 + es * 64 + et * 16 + fr];
                }
                S[dl][et] = v;
                v2u pk; pk.x = pkbf(v[0], v[1]); pk.y = pkbf(v[2], v[3]);
                *(LAS v2u*)(lds + SS + (et * 16 + fr) * 528 + (32 * w + 16 * dl + 4 * q4) * 2) = pk;
            }
        v4u pqA[4], pkA[4], pvA;
        const bf16* qbase = QK + row0 * 2048 + h * 256;
        bf16* vbase = VG + row0 * 4096 + h * 512 + es * 64;
#define RET_LOAD(c) do { _Pragma("unroll") for (int i_ = 0; i_ < 4; ++i_) { const int p_ = tid + 512 * i_; const bf16* s_ = qbase + (size_t)((c) * 64 + (p_ >> 5)) * 2048 + (p_ & 31) * 8; \
            pq[i_] = *(const GAS v4u*)s_; pk4[i_] = *(const GAS v4u*)(s_ + 1024); } \
            pv = *(const GAS v4u*)(vbase + (size_t)((c) * 64 + (tid >> 3)) * 4096 + (tid & 7) * 8); } while (0)
        { v4u (&pq)[4] = pqA; v4u (&pk4)[4] = pkA; v4u& pv = pvA; RET_LOAD(0); }
        auto chunk = [&](const int c, v4u (&pq)[4], v4u (&pk4)[4], v4u& pv) __attribute__((always_inline)) {
            __syncthreads();
#pragma unroll
            for (int i = 0; i < 4; ++i) { const int p = tid + 512 * i; const int off = (p >> 5) * 528 + (p & 31) * 16;
                *(LAS v4u*)(lds + QS + off) = pq[i]; *(LAS v4u*)(lds + KS + off) = pk4[i]; }
            *(LAS v4u*)(lds + VS + (tid >> 3) * 144 + (tid & 7) * 16) = pv;
            if (c + 1 < nchunk) RET_LOAD(c + 1);
            f32x4 qa[4]; int qR = -1;
            if (QUANT_IN_RET && nchunk > 1) { const int jw = (w - RPC * c) & 7; if (jw < RPC && qnext + jw < qr1) qR = qnext + jw; qnext += RPC; }
            if (qR >= 0) { const float* qs = qrow_src(F, qR) + 16 * lane;
#pragma unroll
                for (int i = 0; i < 4; ++i) qa[i] = __builtin_nontemporal_load((const f32x4*)(qs + 4 * i)); }
            __syncthreads();
            const int nt4 = w >> 1;
            bf16x8 qf[8];
#pragma unroll
            for (int ks = 0; ks < 8; ++ks) qf[ks] = *(const LAS bf16x8*)(lds + QS + (nt4 * 16 + fr) * 528 + (32 * ks + 8 * q4) * 2);
#pragma unroll
            for (int tt = 0; tt < 2; ++tt) { const int mt = 2 * (w & 1) + tt;
                f32x4 at = (f32x4){0.f, 0.f, 0.f, 0.f};
                if (mt <= nt4) {
#pragma unroll
                    for (int ks = 0; ks < 8; ++ks) { const bf16x8 ka = *(const LAS bf16x8*)(lds + KS + (mt * 16 + fr) * 528 + (32 * ks + 8 * q4) * 2); at = mfma16(ka, qf[ks], at); }
                }
                const int n = nt4 * 16 + fr; float v[4];
#pragma unroll
                for (int j = 0; j < 4; ++j) { const int m = mt * 16 + 4 * q4 + j; v[j] = (n >= m) ? at[j] : 0.f; }
                v2u pk; pk.x = pkbf(v[0], v[1]); pk.y = pkbf(v[2], v[3]);
                *(LAS v2u*)(lds + AS + n * 144 + (mt * 16 + 4 * q4) * 2) = pk; }
            f32x4 o[2] = {(f32x4){0.f, 0.f, 0.f, 0.f}, (f32x4){0.f, 0.f, 0.f, 0.f}};
#pragma unroll
            for (int ks = 0; ks < 8; ++ks) {
#pragma unroll
                for (int tt = 0; tt < 2; ++tt) { const int et = 2 * (w & 1) + tt;
                    const bf16x8 sb = *(const LAS bf16x8*)(lds + SS + (et * 16 + fr) * 528 + (32 * ks + 8 * q4) * 2);
                    o[tt] = mfma16(sb, qf[ks], o[tt]); }
            }
            __syncthreads();
#pragma unroll
            for (int ks = 0; ks < 2; ++ks) {
                if (ks == 1 && nt4 < 2) continue;
                const bf16x8 aa = *(const LAS bf16x8*)(lds + AS + (nt4 * 16 + fr) * 144 + (32 * ks + 8 * q4) * 2);
                const int m0 = 32 * ks + 8 * q4 + (fr >> 2);
#pragma unroll
                for (int tt = 0; tt < 2; ++tt) { const int et = 2 * (w & 1) + tt;
                    const s16x4 lo = trrd(lds + VS + m0 * 144 + et * 32 + 8 * (fr & 3)), hi = trrd(lds + VS + (m0 + 4) * 144 + et * 32 + 8 * (fr & 3));
                    o[tt] = mfma16(cat8(lo, hi), aa, o[tt]); }
            }
#pragma unroll
            for (int tt = 0; tt < 2; ++tt) { const int e0 = (2 * (w & 1) + tt) * 16 + 4 * q4, n = nt4 * 16 + fr;
                v2u pk; pk.x = pkbf(o[tt][0], o[tt][1]); pk.y = pkbf(o[tt][2], o[tt][3]);
                *(GAS v2u*)(vbase + (size_t)(c * 64 + n) * 4096 + e0) = pk; }
#pragma unroll
            for (int ks = 0; ks < 2; ++ks) {
                const int m0 = 32 * ks + 8 * q4 + (fr >> 2);
                bf16x8 ka[2], vb[4];
#pragma unroll
                for (int dl = 0; dl < 2; ++dl) { const int dt = 2 * w + dl;
                    ka[dl] = cat8(trrd(lds + KS + m0 * 528 + dt * 32 + 8 * (fr & 3)), trrd(lds + KS + (m0 + 4) * 528 + dt * 32 + 8 * (fr & 3))); }
#pragma unroll
                for (int et = 0; et < 4; ++et) vb[et] = cat8(trrd(lds + VS + m0 * 144 + et * 32 + 8 * (fr & 3)), trrd(lds + VS + (m0 + 4) * 144 + et * 32 + 8 * (fr & 3)));
#pragma unroll
                for (int dl = 0; dl < 2; ++dl)
#pragma unroll
                    for (int et = 0; et < 4; ++et) S[dl][et] = mfma16(ka[dl], vb[et], S[dl][et]);
            }
#pragma unroll
            for (int dl = 0; dl < 2; ++dl)
#pragma unroll
                for (int et = 0; et < 4; ++et) { S[dl][et] *= gam64; v2u pk; pk.x = pkbf(S[dl][et][0], S[dl][et][1]); pk.y = pkbf(S[dl][et][2], S[dl][et][3]);
                    *(LAS v2u*)(lds + SS + (et * 16 + fr) * 528 + (32 * w + 16 * dl + 4 * q4) * 2) = pk; }
            if (qR >= 0) quant_row(qa, qrow_dst(F, qR), qrow_rs(F, qR), lane);
        };
        for (int c = 0; c < nchunk; ++c) chunk(c, pqA, pkA, pvA);
#undef RET_LOAD
#pragma unroll
        for (int dl = 0; dl < 2; ++dl)
#pragma unroll
            for (int et = 0; et < 4; ++et)
#pragma unroll
                for (int j = 0; j < 4; ++j) Sout[(size_t)(32 * w + 16 * dl + 4 * q4 + j) * 512 + es * 64 + et * 16 + fr] = S[dl][et][j] * rgam;
        __syncthreads();
    }
    if (qnext < qr0) qnext = qr0;
    if (QUANT_IN_RET) for (int R = qnext + w; R < qr1; R += NWAVES) { f32x4 qa[4]; const float* qs = qrow_src(F, R) + 16 * lane;
#pragma unroll
        for (int i = 0; i < 4; ++i) qa[i] = *(const GAS f32x4*)(qs + 4 * i);
        quant_row(qa, qrow_dst(F, R), qrow_rs(F, R), lane); }
}

__device__ __forceinline__ void gn_gate_phase(Frame& F) {
    bf16* VG = (bf16*)(F.ws + WS_VG);
    const int gw = blockIdx.x * NWAVES + F.wave, NGW = F.G * NWAVES, lane = lane_id();
    for (int t0 = gw; t0 < T; t0 += 2 * NGW) {
        const bool two = t0 + NGW < T;
        v4u ov[2][4], gv[2][4];
#pragma unroll
        for (int u = 0; u < 2; ++u) if (u == 0 || two) { const bf16* orow = VG + (size_t)(t0 + u * NGW) * 4096 + lane * 8;
#pragma unroll
            for (int i = 0; i < 4; ++i) { ov[u][i] = __builtin_nontemporal_load((const v4u*)(orow + 512 * i)); gv[u][i] = __builtin_nontemporal_load((const v4u*)(orow + 2048 + 512 * i)); } }
#pragma unroll
        for (int u = 0; u < 2; ++u) if (u == 0 || two) {
            bf16* orow = VG + (size_t)(t0 + u * NGW) * 4096 + lane * 8;
#pragma unroll
            for (int i = 0; i < 4; ++i) {
                float o[8];
#pragma unroll
                for (int k = 0; k < 4; ++k) { o[2 * k] = bflo(ov[u][i][k]); o[2 * k + 1] = bfhi(ov[u][i][k]); }
                float s = ((o[0] + o[1]) + (o[2] + o[3])) + ((o[4] + o[5]) + (o[6] + o[7]));
                const float mu = wave_sum_dpp(s) * (1.0f / 512.0f);
                float q = 0.f;
#pragma unroll
                for (int k = 0; k < 8; ++k) { o[k] -= mu; q += o[k] * o[k]; }
                const float rstd = __builtin_amdgcn_rsqf(wave_sum_dpp(q) * (1.0f / 512.0f) + GN_EPS);
                v4u w;
#pragma unroll
                for (int k = 0; k < 4; ++k) {
                    const float g0 = bflo(gv[u][i][k]), g1 = bfhi(gv[u][i][k]);
                    const float s0 = g0 * __builtin_amdgcn_rcpf(1.0f + __builtin_amdgcn_exp2f(-g0 * LOG2E)), s1 = g1 * __builtin_amdgcn_rcpf(1.0f + __builtin_amdgcn_exp2f(-g1 * LOG2E));
                    w[k] = pkbf(s0 * o[2 * k] * rstd, s1 * o[2 * k + 1] * rstd);
                }
                *(GAS v4u*)(orow + 512 * i) = w;
            }
        }
    }
}

__device__ __forceinline__ void ln_rows2(Frame& F, int layer, const f32x4 (&gg)[4], const f32x4 (&bb)[4], int ta, int tb, bool two, int lane) {
    const bf16* M1 = (const bf16*)(F.ws + WS_M1); bf16* XB = (bf16*)(F.ws + WS_XB);
    f32x4 xv[2][4]; v2u mv[2][4];
#pragma unroll
    for (int u = 0; u < 2; ++u) if (u == 0 || two) { const int t = u ? tb : ta;
        if (layer == 0) { const float* xrow = (t < TP ? F.in[0] + (size_t)t * D : F.in[1] + (size_t)(t - TP) * D);
#pragma unroll
            for (int j = 0; j < 4; ++j) xv[u][j] = __builtin_nontemporal_load((const f32x4*)(xrow + 4 * lane + 256 * j)); }
        else {
#pragma unroll
            for (int j = 0; j < 4; ++j) { const v2u xb = *(const GAS v2u*)(XB + (size_t)t * D + 4 * lane + 256 * j); xv[u][j] = (f32x4){bflo(xb.x), bfhi(xb.x), bflo(xb.y), bfhi(xb.y)}; } }
#pragma unroll
        for (int j = 0; j < 4; ++j) mv[u][j] = __builtin_nontemporal_load((const v2u*)(M1 + (size_t)t * D + 4 * lane + 256 * j)); }
#pragma unroll
    for (int u = 0; u < 2; ++u) if (u == 0 || two) { const int t = u ? tb : ta;
        f32x4 v[4]; float s = 0.f;
#pragma unroll
        for (int j = 0; j < 4; ++j) { v[j] = xv[u][j] * ALPHA + (f32x4){bflo(mv[u][j].x), bfhi(mv[u][j].x), bflo(mv[u][j].y), bfhi(mv[u][j].y)}; s += (v[j][0] + v[j][1]) + (v[j][2] + v[j][3]); }
        const float mean = wave_sum_dpp(s) * (1.0f / D); float s2 = 0.f;
#pragma unroll
        for (int j = 0; j < 4; ++j) { v[j] = v[j] - mean; s2 += (v[j][0] * v[j][0] + v[j][1] * v[j][1]) + (v[j][2] * v[j][2] + v[j][3] * v[j][3]); }
        const float rstd = __builtin_amdgcn_rsqf(wave_sum_dpp(s2) * (1.0f / D) + LN_EPS);
#pragma unroll
        for (int j = 0; j < 4; ++j) { const f32x4 y = v[j] * rstd * gg[j] + bb[j];
            v2u o; o.x = pkbf(y[0], y[1]); o.y = pkbf(y[2], y[3]); *(GAS v2u*)(XB + (size_t)t * D + 4 * lane + 256 * j) = o; }
    }
}
__device__ __forceinline__ void ln_phase(Frame& F, int layer, int seam, int drows) {
    const float* gam = F.in[14] + (size_t)(layer * 2 + 0) * D; const float* bet = F.in[15] + (size_t)(layer * 2 + 0) * D;
    const int lane = lane_id(), c = (int)blockIdx.x;
    f32x4 gg[4], bb[4];
#pragma unroll
    for (int j = 0; j < 4; ++j) { gg[j] = *(const GAS f32x4*)(gam + 4 * lane + 256 * j); bb[j] = *(const GAS f32x4*)(bet + 4 * lane + 256 * j); }
    const int ntw = tail_wgs(F, 4);
    const int d = (F.G >= 64) ? drows : 0;
    const int qn = (TP + ntw * d + F.G - 1) / F.G, qt = qn - d;
    int r0 = (c < ntw) ? c * qt : ntw * qt + (c - ntw) * qn, r1 = r0 + ((c < ntw) ? qt : qn);
    r0 = r0 < TP ? r0 : TP; r1 = r1 < TP ? r1 : TP;
    for (int t = r0 + F.wave; t < r1; t += 2 * NWAVES) ln_rows2(F, layer, gg, bb, t, t + NWAVES, t + NWAVES < r1, lane);
    tail_wait(F, seam, ntw);
    for (int t = TP + F.wave * F.G + c; t < T; t += NWAVES * F.G) ln_rows2(F, layer, gg, bb, t, t, false, lane);
}

__device__ __forceinline__ int f2key(float s) { const int u = __float_as_int(s); return u ^ ((u >> 31) & 0x7fffffff); }
__device__ __forceinline__ float key2f(int k) { return __int_as_float(k ^ ((k >> 31) & 0x7fffffff)); }
__device__ __forceinline__ int med3i(int a, int b, int c) { int r; asm("v_med3_i32 %0, %1, %2, %3" : "=v"(r) : "v"(a), "v"(b), "v"(c)); return r; }
__device__ __forceinline__ int maxi(int a, int b) { return a > b ? a : b; }
#define KEY_NEG_INF ((int)0x80000000)
#define TOPK_INSERT(L, x) do { _Pragma("unroll") for (int i_ = 15; i_ >= 1; --i_) L[i_] = med3i(L[i_ - 1], L[i_], (x)); L[0] = maxi(L[0], (x)); } while (0)
#define TK_DMA(rsrc_, reg_, dv_, rowstride_, sbase_) do { _Pragma("unroll") for (int i_ = 0; i_ < 8; ++i_) \
        __builtin_amdgcn_raw_ptr_buffer_load_lds((rsrc_), (LAS void*)((reg_) + i_ * 1024), 16, (dv_)[i_ & 1], (sbase_) + 8 * (i_ & 3) * (rowstride_) + 128 * (i_ >> 2), 0, 0); } while (0)
#define TK_FRAGS(dst_, rega_) do { const unsigned a0_ = (rega_) + rd[0], a1_ = (rega_) + rd[1], a2_ = (rega_) + rd[2], a3_ = (rega_) + rd[3]; v4u f_[8]; \
        asm volatile("s_waitcnt vmcnt(0)\n\tds_read_b128 %0, %8\n\tds_read_b128 %1, %9\n\tds_read_b128 %2, %10\n\tds_read_b128 %3, %11\n\t" \
                     "ds_read_b128 %4, %8 offset:4096\n\tds_read_b128 %5, %9 offset:4096\n\tds_read_b128 %6, %10 offset:4096\n\tds_read_b128 %7, %11 offset:4096\n\ts_waitcnt lgkmcnt(0)" \
                     : "=&v"(f_[0]), "=&v"(f_[1]), "=&v"(f_[2]), "=&v"(f_[3]), "=&v"(f_[4]), "=&v"(f_[5]), "=&v"(f_[6]), "=&v"(f_[7]) : "v"(a0_), "v"(a1_), "v"(a2_), "v"(a3_) : "memory"); \
        _Pragma("unroll") for (int ks = 0; ks < 8; ++ks) dst_[ks] = __builtin_bit_cast(bf16x8, f_[ks]); } while (0)
__device__ __forceinline__ void topk_pass(const __amdgpu_buffer_rsrc_t rsrcQ, const __amdgpu_buffer_rsrc_t rsrcK, int t0, int h, int lane, LAS unsigned char* wl, int (&La)[16], int (&Lb)[16]) {
    const int r = lane & 31, h2 = lane >> 5;
    const int h2x4 = 4 * h2;
    const unsigned qreg_a = (unsigned)(size_t)wl, kreg_a = qreg_a + 8448u;
    unsigned rd[4];
#pragma unroll
    for (int q = 0; q < 4; ++q) rd[q] = (unsigned)(r * 128 + 16 * ((2 * q + h2) ^ ((r >> 1) & 7)));
    int dvK[2], dvQ[2];
#pragma unroll
    for (int b = 0; b < 2; ++b) { const int ch = 16 * ((lane & 7) ^ ((lane >> 4) + 4 * b)); dvK[b] = (lane >> 3) * 256 + ch; dvQ[b] = (lane >> 3) * 4096 + ch; }
#pragma unroll
    for (int half = 0; half < 2; ++half) {
        bf16x8 qf[8];
        int zs = 0; asm volatile("" : "+s"(zs));
        const int qs = t0 * 4096 + h * 512 + half * 256 + zs;
        const int kbs = half * 262144 + h * 32768 + zs;
        if (half == 0) { TK_DMA(rsrcQ, wl, dvQ, 4096, qs); TK_DMA(rsrcK, wl + 8448, dvK, 256, kbs); }
        bf16x8 kf[8];
        TK_FRAGS(qf, qreg_a);
        TK_FRAGS(kf, kreg_a);
        if (half == 0) TK_DMA(rsrcQ, wl, dvQ, 4096, qs + 256);
        int L[16];
#pragma unroll
        for (int tile = 0; tile < 4; ++tile) {
            if (tile < 3) TK_DMA(rsrcK, wl + 8448, dvK, 256, kbs + (tile + 1) * 8192);
            else if (half == 0) TK_DMA(rsrcK, wl + 8448, dvK, 256, kbs + 262144);
            f32x16 acc;
#pragma unroll
            for (int i = 0; i < 16; ++i) acc[i] = 0.f;
#pragma unroll
            for (int ks = 0; ks < 8; ++ks) acc = mfma32(kf[ks], qf[ks], acc);
            __builtin_amdgcn_sched_barrier(0);
            int Kt[16];
#pragma unroll
            for (int i = 0; i < 16; ++i) Kt[i] = ((f2key(acc[i]) & ~127) | (127 - (32 * tile + (i & 3) + 8 * (i >> 2)))) - h2x4;
            SORT16(Kt);
            if (tile == 0) {
#pragma unroll
                for (int i = 0; i < 16; ++i) L[i] = Kt[i];
            } else MERGE_PRUNE(L, Kt);
            __builtin_amdgcn_sched_barrier(0);
            if (tile < 3) TK_FRAGS(kf, kreg_a);
        }
        int A[16], B[16];
#pragma unroll
        for (int i = 0; i < 16; ++i) { auto rr = __builtin_amdgcn_permlane32_swap((unsigned)L[i], (unsigned)L[i], false, false); A[i] = (int)rr[0]; B[i] = (int)rr[1]; }
        MERGE_PRUNE(A, B);
#pragma unroll
        for (int i = 0; i < 16; ++i) { if (half == 0) La[i] = A[i]; else Lb[i] = A[i]; }
        __builtin_amdgcn_sched_barrier(0);
    }
}
__device__ __forceinline__ void topk_phase(Frame& F, int layer, int seam) {
    const bf16* QP = (const bf16*)(F.ws + WS_VG);
    const bf16* KEYS = (const bf16*)(F.ws + WS_KEYS + (size_t)layer * 512 * 1024);
    int* IDX = (int*)(F.ws + WS_IDX); float* GATE = (float*)(F.ws + WS_GATE);
    const int lane = lane_id(), h = F.wave;
    LAS unsigned char* wl = F.lds + h * 19456;
    LAS unsigned* tab = (LAS unsigned*)wl + lane * 33;
    const __amdgpu_buffer_rsrc_t rsrcQ = __builtin_amdgcn_make_buffer_rsrc((void*)QP, 0, T * 4096, 0x00020000);
    const __amdgpu_buffer_rsrc_t rsrcK = __builtin_amdgcn_make_buffer_rsrc((void*)KEYS, 0, 512 * 1024, 0x00020000);
    constexpr int NBP = TP / 32, NBS = TS / 32;
    const int cwg = (int)blockIdx.x, ntw = tail_wgs(F, 8);
    const int npair = cwg < NBP ? (NBP - cwg + 2 * F.G - 1) / (2 * F.G) : 0;
    const int j0 = (cwg - ntw + F.G) % F.G, nsamp = j0 < NBS ? (NBS - j0 + F.G - 1) / F.G : 0;
    for (int it = 0; it < npair + nsamp; ++it) {
        int bA, bB; bool two;
        if (it < npair) { bA = cwg + it * 2 * F.G; bB = bA + F.G; two = bB < NBP; }
        else { if (it == npair) tail_wait(F, seam, ntw); bA = NBP + j0 + (it - npair) * F.G; bB = bA; two = false; }
        int La[16], Lb[16];
        topk_pass(rsrcQ, rsrcK, 32 * bA, h, lane, wl, La, Lb);
        if (two) { int La2[16], Lb2[16];
            topk_pass(rsrcQ, rsrcK, 32 * bB, h, lane, wl, La2, Lb2);
#pragma unroll
            for (int i = 0; i < 16; ++i) { La[i] = (lane < 32) ? La[i] : La2[i]; Lb[i] = (lane < 32) ? Lb[i] : Lb2[i]; } }
        const int t = (lane < 32) ? 32 * bA + lane : 32 * bB + (lane - 32);
        float va[16], vb[16];
#pragma unroll
        for (int i = 0; i < 16; ++i) { va[i] = key2f(La[i] & ~127); vb[i] = key2f(Lb[i] & ~127); }
        int C[16];
#pragma unroll
        for (int j = 0; j < 16; ++j) C[j] = (f2key(va[0] + vb[j]) & ~255) | (255 - j);
#pragma unroll
        for (int i = 1; i < 16; ++i)
#pragma unroll
            for (int j = 0; j < 16; ++j)
                if ((i + 1) * (j + 1) <= 16) { const int x = (f2key(va[i] + vb[j]) & ~255) | (255 - (i * 16 + j)); TOPK_INSERT(C, x); }
#pragma unroll
        for (int i = 0; i < 16; ++i) { tab[i] = 127u - (unsigned)(La[i] & 127); tab[16 + i] = 127u - (unsigned)(Lb[i] & 127); }
        LDS_WAIT(); asm volatile("" ::: "memory");
        int ex[16]; float sc[16];
#pragma unroll
        for (int k = 0; k < 16; ++k) { const unsigned cidx = 255u - (unsigned)(C[k] & 255); ex[k] = (int)(tab[cidx >> 4] * 128u + tab[16 + (cidx & 15u)]); sc[k] = key2f(C[k] & ~255); }
        float ssum = 0.f;
        const float smax = sc[0];
#pragma unroll
        for (int k = 0; k < 16; ++k) { sc[k] = __builtin_amdgcn_exp2f((sc[k] - smax) * LOG2E); ssum += sc[k]; }
        const float rinv = 1.0f / ssum;
        if (lane < 32 || two) {
            int* ip = IDX + (size_t)t * 128 + h * 16; float* gp = GATE + (size_t)t * 128 + h * 16;
#pragma unroll
            for (int k = 0; k < 4; ++k) { *(GAS v4u*)(ip + 4 * k) = (v4u){(unsigned)ex[4 * k], (unsigned)ex[4 * k + 1], (unsigned)ex[4 * k + 2], (unsigned)ex[4 * k + 3]};
                *(GAS f32x4*)(gp + 4 * k) = (f32x4){sc[4 * k] * rinv, sc[4 * k + 1] * rinv, sc[4 * k + 2] * rinv, sc[4 * k + 3] * rinv}; }
        }
        LDS_WAIT(); asm volatile("" ::: "memory");
    }
}

typedef int v8i_t __attribute__((ext_vector_type(8)));
__device__ __forceinline__ float gelu1(float v) { const f32x2 g = pg8::gelu_pk((f32x2){v, v}); return g.x; }
#define FP4_ACC(W, D_, WK) do { f32x2 f_; \
        f_ = __builtin_amdgcn_cvt_scalef32_pk_f32_fp4((W), 1.0f, 0); acc[8 * (D_) + 0] += (WK) * f_.x; acc[8 * (D_) + 1] += (WK) * f_.y; \
        f_ = __builtin_amdgcn_cvt_scalef32_pk_f32_fp4((W), 1.0f, 1); acc[8 * (D_) + 2] += (WK) * f_.x; acc[8 * (D_) + 3] += (WK) * f_.y; \
        f_ = __builtin_amdgcn_cvt_scalef32_pk_f32_fp4((W), 1.0f, 2); acc[8 * (D_) + 4] += (WK) * f_.x; acc[8 * (D_) + 5] += (WK) * f_.y; \
        f_ = __builtin_amdgcn_cvt_scalef32_pk_f32_fp4((W), 1.0f, 3); acc[8 * (D_) + 6] += (WK) * f_.x; acc[8 * (D_) + 7] += (WK) * f_.y; } while (0)
#define GATHER_LOADU(kb_) do { const int el_ = __shfl(((kb_) < 4) ? idv0 : idv1, ((kb_) & 3) * 16 + fr); const int vo_ = el_ * 512 + q4 * 16; \
        _Pragma("unroll") for (int j = 0; j < 8; ++j) uA[j] = __builtin_amdgcn_raw_buffer_load_b128(rsrcU, vo_, 64 * j, 0); } while (0)
#define GATHER_LOADV(VH, kb_, hf_) do { const int idv_ = ((kb_) < 4) ? idv0 : idv1; const int kbase_ = ((kb_) & 3) * 16 + 8 * (hf_); \
        _Pragma("unroll") for (int kk = 0; kk < 8; ++kk) { const int e_ = __builtin_amdgcn_readlane(idv_, kbase_ + kk); VH[kk] = __builtin_amdgcn_raw_buffer_load_b64(rsrcV, lane8, e_ * 512, 0); } } while (0)
#define GATHER_LOADU2(UB, kb_) do { const int el_ = __shfl(((kb_) < 4) ? idv0 : idv1, ((kb_) & 3) * 16 + fr); const int vo_ = el_ * 512 + q4 * 16; \
        _Pragma("unroll") for (int j = 0; j < 8; ++j) UB[j] = __builtin_amdgcn_raw_buffer_load_b128(rsrcU, vo_, 64 * j, 0); } while (0)
__device__ __forceinline__ void stage_x_fp4(const unsigned (&xw)[8], LAS unsigned char* xs_, int lane, float& xinv, float& xinv2) {
    float m = 0.f;
#pragma unroll
    for (int k = 0; k < 8; ++k) m = __builtin_fmaxf(m, __builtin_fmaxf(__builtin_fabsf(bflo(xw[k])), __builtin_fabsf(bfhi(xw[k]))));
    m = wave_max_nonneg(m);
    const float xsc = (m > 1e-30f) ? 6.0f / m : 1.0f; xinv = (m > 1e-30f) ? m * (1.0f / 6.0f) : 1.0f;
    float xr[16]; v2u q; float m2 = 0.f;
#pragma unroll
    for (int d = 0; d < 2; ++d) { unsigned w_ = 0u;
        w_ = __builtin_amdgcn_cvt_scalef32_pk_fp4_f32(w_, bflo(xw[4 * d]) * xsc, bfhi(xw[4 * d]) * xsc, 1.0f, 0);
        w_ = __builtin_amdgcn_cvt_scalef32_pk_fp4_f32(w_, bflo(xw[4 * d + 1]) * xsc, bfhi(xw[4 * d + 1]) * xsc, 1.0f, 1);
        w_ = __builtin_amdgcn_cvt_scalef32_pk_fp4_f32(w_, bflo(xw[4 * d + 2]) * xsc, bfhi(xw[4 * d + 2]) * xsc, 1.0f, 2);
        w_ = __builtin_amdgcn_cvt_scalef32_pk_fp4_f32(w_, bflo(xw[4 * d + 3]) * xsc, bfhi(xw[4 * d + 3]) * xsc, 1.0f, 3);
        q[d] = w_;
        f32x2 f;
        f = __builtin_amdgcn_cvt_scalef32_pk_f32_fp4(w_, 1.0f, 0); xr[8 * d + 0] = bflo(xw[4 * d]) - f.x * xinv;     xr[8 * d + 1] = bfhi(xw[4 * d]) - f.y * xinv;
        f = __builtin_amdgcn_cvt_scalef32_pk_f32_fp4(w_, 1.0f, 1); xr[8 * d + 2] = bflo(xw[4 * d + 1]) - f.x * xinv; xr[8 * d + 3] = bfhi(xw[4 * d + 1]) - f.y * xinv;
        f = __builtin_amdgcn_cvt_scalef32_pk_f32_fp4(w_, 1.0f, 2); xr[8 * d + 4] = bflo(xw[4 * d + 2]) - f.x * xinv; xr[8 * d + 5] = bfhi(xw[4 * d + 2]) - f.y * xinv;
        f = __builtin_amdgcn_cvt_scalef32_pk_f32_fp4(w_, 1.0f, 3); xr[8 * d + 6] = bflo(xw[4 * d + 3]) - f.x * xinv; xr[8 * d + 7] = bfhi(xw[4 * d + 3]) - f.y * xinv; }
    *(LAS v2u*)(xs_ + 8 * lane) = q;
#pragma unroll
    for (int i = 0; i < 16; ++i) m2 = __builtin_fmaxf(m2, __builtin_fabsf(xr[i]));
    m2 = wave_max_nonneg(m2);
    const float xsc2 = (m2 > 1e-30f) ? 6.0f / m2 : 1.0f; xinv2 = (m2 > 1e-30f) ? m2 * (1.0f / 6.0f) : 0.0f;
#pragma unroll
    for (int d = 0; d < 2; ++d) { unsigned w_ = 0u;
        w_ = __builtin_amdgcn_cvt_scalef32_pk_fp4_f32(w_, xr[8 * d + 0] * xsc2, xr[8 * d + 1] * xsc2, 1.0f, 0);
        w_ = __builtin_amdgcn_cvt_scalef32_pk_fp4_f32(w_, xr[8 * d + 2] * xsc2, xr[8 * d + 3] * xsc2, 1.0f, 1);
        w_ = __builtin_amdgcn_cvt_scalef32_pk_fp4_f32(w_, xr[8 * d + 4] * xsc2, xr[8 * d + 5] * xsc2, 1.0f, 2);
        w_ = __builtin_amdgcn_cvt_scalef32_pk_fp4_f32(w_, xr[8 * d + 6] * xsc2, xr[8 * d + 7] * xsc2, 1.0f, 3);
        q[d] = w_; }
    *(LAS v2u*)(xs_ + 512 + 8 * lane) = q;
}
__device__ __forceinline__ void lds_w64(unsigned a, v2u v);
__device__ __forceinline__ void stage_x_fp4_asm(const unsigned (&xw)[8], unsigned xs_, int lane, float& xinv, float& xinv2) {
    float m = 0.f;
#pragma unroll
    for (int k = 0; k < 8; ++k) m = __builtin_fmaxf(m, __builtin_fmaxf(__builtin_fabsf(bflo(xw[k])), __builtin_fabsf(bfhi(xw[k]))));
    m = wave_max_nonneg(m);
    const float xsc = (m > 1e-30f) ? 6.0f / m : 1.0f; xinv = (m > 1e-30f) ? m * (1.0f / 6.0f) : 1.0f;
    float xr[16]; v2u q; float m2 = 0.f;
#pragma unroll
    for (int d = 0; d < 2; ++d) { unsigned w_ = 0u;
        w_ = __builtin_amdgcn_cvt_scalef32_pk_fp4_f32(w_, bflo(xw[4 * d]) * xsc, bfhi(xw[4 * d]) * xsc, 1.0f, 0);
        w_ = __builtin_amdgcn_cvt_scalef32_pk_fp4_f32(w_, bflo(xw[4 * d + 1]) * xsc, bfhi(xw[4 * d + 1]) * xsc, 1.0f, 1);
        w_ = __builtin_amdgcn_cvt_scalef32_pk_fp4_f32(w_, bflo(xw[4 * d + 2]) * xsc, bfhi(xw[4 * d + 2]) * xsc, 1.0f, 2);
        w_ = __builtin_amdgcn_cvt_scalef32_pk_fp4_f32(w_, bflo(xw[4 * d + 3]) * xsc, bfhi(xw[4 * d + 3]) * xsc, 1.0f, 3);
        q[d] = w_;
        f32x2 f;
        f = __builtin_amdgcn_cvt_scalef32_pk_f32_fp4(w_, 1.0f, 0); xr[8 * d + 0] = bflo(xw[4 * d]) - f.x * xinv;     xr[8 * d + 1] = bfhi(xw[4 * d]) - f.y * xinv;
        f = __builtin_amdgcn_cvt_scalef32_pk_f32_fp4(w_, 1.0f, 1); xr[8 * d + 2] = bflo(xw[4 * d + 1]) - f.x * xinv; xr[8 * d + 3] = bfhi(xw[4 * d + 1]) - f.y * xinv;
        f = __builtin_amdgcn_cvt_scalef32_pk_f32_fp4(w_, 1.0f, 2); xr[8 * d + 4] = bflo(xw[4 * d + 2]) - f.x * xinv; xr[8 * d + 5] = bfhi(xw[4 * d + 2]) - f.y * xinv;
        f = __builtin_amdgcn_cvt_scalef32_pk_f32_fp4(w_, 1.0f, 3); xr[8 * d + 6] = bflo(xw[4 * d + 3]) - f.x * xinv; xr[8 * d + 7] = bfhi(xw[4 * d + 3]) - f.y * xinv; }
    lds_w64(xs_ + 8u * (unsigned)lane, q);
#pragma unroll
    for (int i = 0; i < 16; ++i) m2 = __builtin_fmaxf(m2, __builtin_fabsf(xr[i]));
    m2 = wave_max_nonneg(m2);
    const float xsc2 = (m2 > 1e-30f) ? 6.0f / m2 : 1.0f; xinv2 = (m2 > 1e-30f) ? m2 * (1.0f / 6.0f) : 0.0f;
#pragma unroll
    for (int d = 0; d < 2; ++d) { unsigned w_ = 0u;
        w_ = __builtin_amdgcn_cvt_scalef32_pk_fp4_f32(w_, xr[8 * d + 0] * xsc2, xr[8 * d + 1] * xsc2, 1.0f, 0);
        w_ = __builtin_amdgcn_cvt_scalef32_pk_fp4_f32(w_, xr[8 * d + 2] * xsc2, xr[8 * d + 3] * xsc2, 1.0f, 1);
        w_ = __builtin_amdgcn_cvt_scalef32_pk_fp4_f32(w_, xr[8 * d + 4] * xsc2, xr[8 * d + 5] * xsc2, 1.0f, 2);
        w_ = __builtin_amdgcn_cvt_scalef32_pk_fp4_f32(w_, xr[8 * d + 6] * xsc2, xr[8 * d + 7] * xsc2, 1.0f, 3);
        q[d] = w_; }
    lds_w64(xs_ + 512u + 8u * (unsigned)lane, q);
}
__device__ __forceinline__ void lds_w64(unsigned a, v2u v) { asm volatile("ds_write_b64 %0, %1" :: "v"(a), "v"(v) : "memory"); }
__device__ __forceinline__ void lds_w128(unsigned a, f32x4 v) { asm volatile("ds_write_b128 %0, %1" :: "v"(a), "v"(v) : "memory"); }
__device__ __forceinline__ float lds_r32_wait(unsigned a) { float r; asm volatile("s_waitcnt lgkmcnt(0)\n\tds_read_b32 %0, %1\n\ts_waitcnt lgkmcnt(0)" : "=v"(r) : "v"(a) : "memory"); return r; }
__device__ __forceinline__ float dpp_ror8(float x) { return __int_as_float(__builtin_amdgcn_update_dpp(0, __float_as_int(x), 0x128, 0xf, 0xf, true)); }
__device__ __forceinline__ void gather_u_phase(Frame& F, int layer) {
    const unsigned char* PU = F.ws + WS_PU + (size_t)layer * 16384 * 512;
    const float* RSU = (const float*)(F.ws + WS_RS) + (size_t)layer * 32768;
    const int* IDX = (const int*)(F.ws + WS_IDX); float* GATE = (float*)(F.ws + WS_GATE);
    const bf16* XB = (const bf16*)(F.ws + WS_XB);
    const int lane = lane_id(), fr = lane & 15, q4 = lane >> 4;
    const int gw = blockIdx.x * NWAVES + F.wave, NGW = F.G * NWAVES;
    LAS unsigned char* wl = F.lds + F.wave * 19456;
    const unsigned wl_a = (unsigned)(size_t)wl;
    const unsigned xs_a = wl_a + 16384, hb_a = wl_a + 18432;
    const __amdgpu_buffer_rsrc_t rsrcU = __builtin_amdgcn_make_buffer_rsrc((void*)PU, 0, 16384 * 512, 0x00020000);
    const __amdgpu_buffer_rsrc_t rsrcS = __builtin_amdgcn_make_buffer_rsrc((void*)RSU, 0, 2 * 65536, 0x00020000);
    int t = gw;
    if (t >= T) return;
    const int dma_c = (((lane & 7) ^ (lane >> 3)) & 7) * 16;
    const int rr = fr & 7;
    const unsigned rdA0 = (unsigned)((fr >> 3) * 4096 + rr * 128 + ((q4 ^ rr) & 7) * 16), rdA1 = (unsigned)((fr >> 3) * 4096 + rr * 128 + (((4 + q4) ^ rr) & 7) * 16);
    const unsigned rdX = xs_a + 16 * q4;
#define GU_DMA(buf_, i0_, i1_, kb_) do { const int iv_ = ((kb_) < 4) ? (i0_) : (i1_); \
        _Pragma("unroll") for (int h_ = 0; h_ < 2; ++h_) { const int vo_ = __shfl(iv_, ((kb_) & 3) * 16 + 8 * h_ + (lane >> 3)) * 512 + dma_c; \
            _Pragma("unroll") for (int m_ = 0; m_ < 4; ++m_) __builtin_amdgcn_raw_ptr_buffer_load_lds(rsrcU, (LAS void*)(wl + (buf_) * 8192 + (h_ * 4 + m_) * 1024), 16, vo_, 128 * m_, 0, 0); } } while (0)
#define GU_READA(buf_) do { const unsigned a0_ = wl_a + (buf_) * 8192 + rdA0, a1_ = wl_a + (buf_) * 8192 + rdA1; \
        asm volatile("ds_read_b128 %0, %8\n\tds_read_b128 %1, %9\n\tds_read_b128 %2, %8 offset:1024\n\tds_read_b128 %3, %9 offset:1024\n\t" \
                     "ds_read_b128 %4, %8 offset:2048\n\tds_read_b128 %5, %9 offset:2048\n\tds_read_b128 %6, %8 offset:3072\n\tds_read_b128 %7, %9 offset:3072\n\ts_waitcnt lgkmcnt(0)" \
                     : "=&v"(ua[0]), "=&v"(ua[1]), "=&v"(ua[2]), "=&v"(ua[3]), "=&v"(ua[4]), "=&v"(ua[5]), "=&v"(ua[6]), "=&v"(ua[7]) : "v"(a0_), "v"(a1_) : "memory"); } while (0)
#define GU_LOADB(xa_) do { const unsigned b_ = (xa_) + 16 * q4 + ((fr & 8) ? 512u : 0u);     \
        asm volatile("ds_read_b128 %0, %8\n\tds_read_b128 %1, %8 offset:64\n\tds_read_b128 %2, %8 offset:128\n\tds_read_b128 %3, %8 offset:192\n\t" \
                     "ds_read_b128 %4, %8 offset:256\n\tds_read_b128 %5, %8 offset:320\n\tds_read_b128 %6, %8 offset:384\n\tds_read_b128 %7, %8 offset:448\n\ts_waitcnt lgkmcnt(0)" \
                     : "=&v"(xb0[0]), "=&v"(xb0[1]), "=&v"(xb0[2]), "=&v"(xb0[3]), "=&v"(xb0[4]), "=&v"(xb0[5]), "=&v"(xb0[6]), "=&v"(xb0[7]) : "v"(b_) : "memory"); } while (0)
#define GU_BATCH(buf_, kb_, NEXT_DMA) do { \
        asm volatile("s_waitcnt vmcnt(8)" ::: "memory"); \
        v4u ua[8]; GU_READA(buf_); \
        NEXT_DMA; \
        f32x4 dacc = (f32x4){0.f, 0.f, 0.f, 0.f}; \
        _Pragma("unroll") for (int j = 0; j < 8; ++j) { \
            const v8i_t A_ = (v8i_t){(int)ua[j].x, (int)ua[j].y, (int)ua[j].z, (int)ua[j].w, 0, 0, 0, 0}; \
            const v8i_t B_ = (v8i_t){(int)xb0[j].x, (int)xb0[j].y, (int)xb0[j].z, (int)xb0[j].w, 0, 0, 0, 0}; \
            dacc = __builtin_amdgcn_mfma_scale_f32_16x16x128_f8f6f4(A_, B_, dacc, 4, 4, 0, 127, 0, 127); } \
        { const float sc_ = (fr & 8) ? xinv2 : xinv;     \
          _Pragma("unroll") for (int i = 0; i < 4; ++i) { const float h_ = dacc[i] * sc_; dacc[i] = h_ + dpp_ror8(h_); } } \
        if (fr == 0) lds_w128(hb_a + (unsigned)((((kb_) & 3) * 16 + 4 * q4) * 4), dacc);     \
        } while (0)
#define GU_HALF(gt_, ru_, rv_, half_) do { const float h_ = lds_r32_wait(hb_a + 4u * (unsigned)lane); \
        wrow[64 * (half_) + lane] = (gt_) * gelu1(h_ * (ru_)) * (rv_); } while (0)
    int idv0, idv1; float gtv0, gtv1, rsu0, rsu1, rsv0, rsv1, xinv, xinv2;
    int cur = 0;
    v4u xb0[8];
    { const unsigned l32 = (unsigned)lane * 32u, l4 = (unsigned)lane * 4u;
      unsigned xw[8];
      { const v4u a = ldg16(XB + (size_t)t * D, l32), b = ldg16(XB + (size_t)t * D + 8, l32);
#pragma unroll
        for (int k = 0; k < 4; ++k) { xw[k] = a[k]; xw[4 + k] = b[k]; } }
      idv0 = *(const GAS int*)((const GAS char*)(IDX + (size_t)t * 128) + l4); idv1 = *(const GAS int*)((const GAS char*)(IDX + (size_t)t * 128 + 64) + l4);
      gtv0 = *(const GAS float*)((const GAS char*)(GATE + (size_t)t * 128) + l4); gtv1 = *(const GAS float*)((const GAS char*)(GATE + (size_t)t * 128 + 64) + l4);
      { const v2u s0_ = __builtin_amdgcn_raw_buffer_load_b64(rsrcS, idv0 * 8, 0, 0), s1_ = __builtin_amdgcn_raw_buffer_load_b64(rsrcS, idv1 * 8, 0, 0);
        rsu0 = __uint_as_float(s0_.x); rsv0 = __uint_as_float(s0_.y); rsu1 = __uint_as_float(s1_.x); rsv1 = __uint_as_float(s1_.y); }
      stage_x_fp4_asm(xw, xs_a, lane, xinv, xinv2);
      asm volatile("s_waitcnt vmcnt(0)" ::: "memory");
      GU_DMA(0, idv0, idv1, 0); GU_DMA(1, idv0, idv1, 1);
      GU_LOADB(xs_a); }
    for (; t < T; t += NGW) {
        unsigned l32 = (unsigned)lane * 32u, l4 = (unsigned)lane * 4u;
        asm volatile("" : "+v"(l32), "+v"(l4));
        const int tn = (t + NGW < T) ? t + NGW : t;
        float* wrow = GATE + (size_t)t * 128;
        unsigned xwn[8]; int idn0, idn1; float gtn0, gtn1, rsun0, rsun1, rsvn0, rsvn1;
#define GU_PRE_NEXT do { const v4u a = ldg16(XB + (size_t)tn * D, l32), b = ldg16(XB + (size_t)tn * D + 8, l32); \
            _Pragma("unroll") for (int k = 0; k < 4; ++k) { xwn[k] = a[k]; xwn[4 + k] = b[k]; } \
            idn0 = *(const GAS int*)((const GAS char*)(IDX + (size_t)tn * 128) + l4); idn1 = *(const GAS int*)((const GAS char*)(IDX + (size_t)tn * 128 + 64) + l4); \
            gtn0 = *(const GAS float*)((const GAS char*)(GATE + (size_t)tn * 128) + l4); gtn1 = *(const GAS float*)((const GAS char*)(GATE + (size_t)tn * 128 + 64) + l4); } while (0)
#define GU_PRE_RS do { const v2u s0_ = __builtin_amdgcn_raw_buffer_load_b64(rsrcS, idn0 * 8, 0, 0), s1_ = __builtin_amdgcn_raw_buffer_load_b64(rsrcS, idn1 * 8, 0, 0); \
            rsun0 = __uint_as_float(s0_.x); rsvn0 = __uint_as_float(s0_.y); rsun1 = __uint_as_float(s1_.x); rsvn1 = __uint_as_float(s1_.y); } while (0)
        GU_BATCH(0, 0, GU_PRE_NEXT; GU_DMA(0, idv0, idv1, 2));
        GU_BATCH(1, 1, GU_DMA(1, idv0, idv1, 3));
        GU_BATCH(0, 2, GU_DMA(0, idv0, idv1, 4));
        GU_BATCH(1, 3, GU_DMA(1, idv0, idv1, 5));
        GU_BATCH(0, 4, GU_HALF(gtv0, rsu0, rsv0, 0); GU_DMA(0, idv0, idv1, 6));
        GU_BATCH(1, 5, GU_PRE_RS; GU_DMA(1, idv0, idv1, 7));
        float xinvn, xinv2n;
        stage_x_fp4_asm(xwn, xs_a + (unsigned)((cur ^ 1) * 1024), lane, xinvn, xinv2n);
        GU_BATCH(0, 6, GU_DMA(0, idn0, idn1, 0));
        GU_BATCH(1, 7, GU_DMA(1, idn0, idn1, 1));
        GU_HALF(gtv1, rsu1, rsv1, 1);
#undef GU_PRE_NEXT
#undef GU_PRE_RS
        cur ^= 1;
        GU_LOADB(xs_a + (unsigned)(cur * 1024));
        idv0 = idn0; idv1 = idn1; gtv0 = gtn0; gtv1 = gtn1; rsu0 = rsun0; rsu1 = rsun1; rsv0 = rsvn0; rsv1 = rsvn1; xinv = xinvn; xinv2 = xinv2n;
    }
    asm volatile("s_waitcnt vmcnt(0)" ::: "memory");
#undef GU_DMA
#undef GU_READA
#undef GU_LOADB
#undef GU_BATCH
#undef GU_HALF
}
__device__ __forceinline__ float swz16(float x) { return __int_as_float(__builtin_amdgcn_ds_swizzle(__float_as_int(x), 0x401F)); }
__device__ __forceinline__ void gather_v_phase(Frame& F, int layer) {
    const unsigned char* PV = F.ws + WS_PV + (size_t)layer * 16384 * 512;
    const int* IDX = (const int*)(F.ws + WS_IDX); const float* GATE = (const float*)(F.ws + WS_GATE);
    bf16* XB = (bf16*)(F.ws + WS_XB); float* Y = F.out + O_Y;
    const float* gam = F.in[14] + (size_t)(layer * 2 + 1) * D; const float* bet = F.in[15] + (size_t)(layer * 2 + 1) * D;
    const int lane = lane_id(), np = lane & 31, hh = lane >> 5, np15 = np & 15, rowsel = np >> 4;
    const int gw = blockIdx.x * NWAVES + F.wave, NGW = F.G * NWAVES;
    const __amdgpu_buffer_rsrc_t rsrcV = __builtin_amdgcn_make_buffer_rsrc((void*)PV, 0, 16384 * 512, 0x00020000);
    int t = gw;
    if (t >= T) return;
    const int lane_off = 32 * np15 + 16 * hh;
    const int bp = 4 * rowsel;
    const int col0 = 64 * np15 + 4 * hh;
    int A[2][4];
    { const int m = np, par = m & 1, byt = (m & 7) >> 1, d0 = m >> 3;
      const float fa = par ? 0.f : 1.f, fb = par ? 1.f : 0.f;
      const unsigned v0 = __builtin_amdgcn_cvt_scalef32_pk_fp4_f32(0u, fa, fb, 1.0f, 0), v1 = __builtin_amdgcn_cvt_scalef32_pk_fp4_f32(0u, fa, fb, 1.0f, 1);
      const unsigned v2 = __builtin_amdgcn_cvt_scalef32_pk_fp4_f32(0u, fa, fb, 1.0f, 2), v3 = __builtin_amdgcn_cvt_scalef32_pk_fp4_f32(0u, fa, fb, 1.0f, 3);
      const unsigned val = (byt == 0) ? v0 : (byt == 1) ? v1 : (byt == 2) ? v2 : v3;
#pragma unroll
      for (int s_ = 0; s_ < 2; ++s_)
#pragma unroll
          for (int d = 0; d < 4; ++d) A[s_][d] = (hh == s_ && d == d0) ? (int)val : 0; }
    LAS f32x4* gbl = (LAS f32x4*)(F.lds + F.wave * 16384) + lane;
#pragma unroll
    for (int s_ = 0; s_ < 8; ++s_) { gbl[64 * s_] = *(const GAS f32x4*)(gam + col0 + 8 * s_); gbl[64 * (8 + s_)] = *(const GAS f32x4*)(bet + col0 + 8 * s_); }
    int idv0, idv1; float wv0, wv1;
    { const unsigned l4 = (unsigned)lane * 4u;
      idv0 = *(const GAS int*)((const GAS char*)(IDX + (size_t)t * 128) + l4); idv1 = *(const GAS int*)((const GAS char*)(IDX + (size_t)t * 128 + 64) + l4);
      wv0 = *(const GAS float*)((const GAS char*)(GATE + (size_t)t * 128) + l4); wv1 = *(const GAS float*)((const GAS char*)(GATE + (size_t)t * 128 + 64) + l4); }
    v4u vb[8]; float wl[8];
#define V2_ISSUE(u_, iv_, wv_, jj_) do { const int ba_ = bp + 8 * (jj_); const int e_ = __builtin_amdgcn_ds_bpermute(ba_, (iv_)); \
        wl[u_] = __int_as_float(__builtin_amdgcn_ds_bpermute(ba_, __float_as_int(wv_))); \
        vb[u_] = __builtin_amdgcn_raw_buffer_load_b128(rsrcV, e_ * 512 + lane_off, 0, 0); } while (0)
#define V2_STEP(DC, DP, u_, HAS_PREV) do { const v8i_t B_ = (v8i_t){(int)vb[u_].x, (int)vb[u_].y, (int)vb[u_].z, (int)vb[u_].w, 0, 0, 0, 0}; const float wc_ = wl[u_]; \
        _Pragma("unroll") for (int s_ = 0; s_ < 2; ++s_) { const v8i_t A_ = (v8i_t){A[s_][0], A[s_][1], A[s_][2], A[s_][3], 0, 0, 0, 0}; \
            DC[s_] = __builtin_amdgcn_mfma_scale_f32_32x32x64_f8f6f4(A_, B_, zero16, 4, 4, 0, 127, 0, 127); \
            if (HAS_PREV) { _Pragma("unroll") for (int j_ = 0; j_ < 4; ++j_) acc[4 * s_ + j_] += (f32x4){DP[s_][4 * j_], DP[s_][4 * j_ + 1], DP[s_][4 * j_ + 2], DP[s_][4 * j_ + 3]} * wp; } } \
        wp = wc_; } while (0)
    f32x16 zero16;
#pragma unroll
    for (int i = 0; i < 16; ++i) zero16[i] = 0.f;
#pragma unroll
    for (int u = 0; u < 8; ++u) V2_ISSUE(u, idv0, wv0, u);
    for (; t < T; t += NGW) {
        unsigned l4 = (unsigned)lane * 4u;
        asm volatile("" : "+v"(l4));
        const int tn = (t + NGW < T) ? t + NGW : t;
        const int idn0 = *(const GAS int*)((const GAS char*)(IDX + (size_t)tn * 128) + l4), idn1 = *(const GAS int*)((const GAS char*)(IDX + (size_t)tn * 128 + 64) + l4);
        const float wn0 = *(const GAS float*)((const GAS char*)(GATE + (size_t)tn * 128) + l4), wn1 = *(const GAS float*)((const GAS char*)(GATE + (size_t)tn * 128 + 64) + l4);
        f32x4 acc[8]; f32x16 dA[2], dB[2]; float wp = 0.f;
#pragma unroll
        for (int s_ = 0; s_ < 8; ++s_) acc[s_] = (f32x4){0.f, 0.f, 0.f, 0.f};
#define V2_GROUP(g_, NIV, NWV, NJB) do { \
        V2_STEP(dA, dB, 0, (g_) > 0); V2_ISSUE(0, NIV, NWV, (NJB) + 0); V2_STEP(dB, dA, 1, true); V2_ISSUE(1, NIV, NWV, (NJB) + 1); \
        V2_STEP(dA, dB, 2, true); V2_ISSUE(2, NIV, NWV, (NJB) + 2); V2_STEP(dB, dA, 3, true); V2_ISSUE(3, NIV, NWV, (NJB) + 3); \
        V2_STEP(dA, dB, 4, true); V2_ISSUE(4, NIV, NWV, (NJB) + 4); V2_STEP(dB, dA, 5, true); V2_ISSUE(5, NIV, NWV, (NJB) + 5); \
        V2_STEP(dA, dB, 6, true); V2_ISSUE(6, NIV, NWV, (NJB) + 6); V2_STEP(dB, dA, 7, true); V2_ISSUE(7, NIV, NWV, (NJB) + 7); } while (0)
        V2_GROUP(0, idv0, wv0, 8);  V2_GROUP(1, idv0, wv0, 16); V2_GROUP(2, idv0, wv0, 24); V2_GROUP(3, idv1, wv1, 0);
        V2_GROUP(4, idv1, wv1, 8);  V2_GROUP(5, idv1, wv1, 16); V2_GROUP(6, idv1, wv1, 24); V2_GROUP(7, idn0, wn0, 0);
#undef V2_GROUP
#pragma unroll
        for (int s_ = 0; s_ < 2; ++s_)
#pragma unroll
            for (int j_ = 0; j_ < 4; ++j_) acc[4 * s_ + j_] += (f32x4){dB[s_][4 * j_], dB[s_][4 * j_ + 1], dB[s_][4 * j_ + 2], dB[s_][4 * j_ + 3]} * wp;
        const bf16* xrow = XB + (size_t)t * D + col0;
        float ssum = 0.f;
#pragma unroll
        for (int s_ = 0; s_ < 8; ++s_) { const v2u xb = *(const GAS v2u*)(xrow + 8 * s_);
            const f32x4 xr = (f32x4){bflo(xb.x), bfhi(xb.x), bflo(xb.y), bfhi(xb.y)};
#pragma unroll
            for (int i = 0; i < 4; ++i) { acc[s_][i] = acc[s_][i] + swz16(acc[s_][i]) + ALPHA * xr[i]; ssum += acc[s_][i]; } }
        const float mean = wave_sum(ssum) * (0.5f / D); float s2 = 0.f;
#pragma unroll
        for (int s_ = 0; s_ < 8; ++s_)
#pragma unroll
            for (int i = 0; i < 4; ++i) { acc[s_][i] -= mean; s2 += acc[s_][i] * acc[s_][i]; }
        const float rstd = __builtin_amdgcn_rsqf(wave_sum(s2) * (0.5f / D) + LN_EPS);
        if (rowsel == 0) {
#pragma unroll
            for (int s_ = 0; s_ < 8; ++s_) { const f32x4 g4 = gbl[64 * s_], b4 = gbl[64 * (8 + s_)];
                const f32x4 y = acc[s_] * rstd * g4 + b4;
                if (layer == 1) __builtin_nontemporal_store(y, (f32x4*)(Y + (size_t)t * D + col0 + 8 * s_));
                else { v2u o; o.x = pkbf(y[0], y[1]); o.y = pkbf(y[2], y[3]); *(GAS v2u*)(XB + (size_t)t * D + col0 + 8 * s_) = o; } }
        }
        idv0 = idn0; idv1 = idn1; wv0 = wn0; wv1 = wn1;
    }
#undef V2_ISSUE
#undef V2_STEP
}
template <bool MASKED> __device__ __forceinline__ void sb_tile(f32x16& p, float& c, f32x16 (&o)[2], LAS const unsigned char* vs, int kv0, int ql, int lane) {
    const int h2 = lane >> 5, fr = lane & 15;
    float rm[16];
#pragma unroll
    for (int i = 0; i < 16; ++i) { const float z = p[i];
        const float t = __builtin_amdgcn_exp2f(-z * LOG2E);
        float be = __builtin_amdgcn_rcpf(1.0f + t);
        float r1 = 1.0f - be;
        if (MASKED) { const bool v = (kv0 + crow(i, h2) < ql); be = v ? be : 0.f; r1 = v ? r1 : 1.0f; }
        p[i] = be; rm[i] = r1; }
    float pp[4], hiv[4];
#pragma unroll
    for (int g = 0; g < 4; ++g) { const float gs = (rm[4 * g] * rm[4 * g + 1]) * (rm[4 * g + 2] * rm[4 * g + 3]);
        auto rr = __builtin_amdgcn_permlane32_swap(__float_as_uint(gs), __float_as_uint(gs), false, false);
        const float lo = __uint_as_float(rr[0]), hi = __uint_as_float(rr[1]); pp[g] = lo * hi; hiv[g] = hi; }
    float sp4[4]; sp4[3] = 1.0f;
#pragma unroll
    for (int g = 2; g >= 0; --g) sp4[g] = sp4[g + 1] * pp[g + 1];
    const float total = sp4[0] * pp[0];
    const float E = __builtin_amdgcn_exp2f(c * LOG2E);
#pragma unroll
    for (int g = 0; g < 4; ++g) { float run = E * sp4[g] * (h2 ? 1.0f : hiv[g]);
#pragma unroll
        for (int e = 3; e >= 0; --e) { const int ix = 4 * g + e; const float wgt = p[ix] * run; run *= rm[ix]; p[ix] = wgt; } }
    if (__builtin_expect(__any(total < 7.9e-31f), 0)) {
        float sl = 0.f;
#pragma unroll
        for (int i = 0; i < 16; ++i) sl += __builtin_amdgcn_logf(rm[i]);
        auto rr = __builtin_amdgcn_permlane32_swap(__float_as_uint(sl), __float_as_uint(sl), false, false);
        c += LN2 * (__uint_as_float(rr[0]) + __uint_as_float(rr[1]));
    } else c += LN2 * __builtin_amdgcn_logf(total);
    v2u tv[8];
    { const unsigned va = (unsigned)(size_t)vs + (unsigned)((4 * h2 + (fr >> 2)) * 128 + 32 * ((lane >> 4) & 1) + 8 * (fr & 3));
      asm volatile("ds_read_b64_tr_b16 %0, %8\n\tds_read_b64_tr_b16 %1, %8 offset:1024\n\tds_read_b64_tr_b16 %2, %8 offset:64\n\tds_read_b64_tr_b16 %3, %8 offset:1088\n\t"
                   "ds_read_b64_tr_b16 %4, %8 offset:2048\n\tds_read_b64_tr_b16 %5, %8 offset:3072\n\tds_read_b64_tr_b16 %6, %8 offset:2112\n\tds_read_b64_tr_b16 %7, %8 offset:3136\n\ts_waitcnt lgkmcnt(0)"
                   : "=&v"(tv[0]), "=&v"(tv[1]), "=&v"(tv[2]), "=&v"(tv[3]), "=&v"(tv[4]), "=&v"(tv[5]), "=&v"(tv[6]), "=&v"(tv[7]) : "v"(va) : "memory"); }
#pragma unroll
    for (int ss = 0; ss < 2; ++ss) {
        v4u pa; pa.x = pkbf(p[8 * ss], p[8 * ss + 1]); pa.y = pkbf(p[8 * ss + 2], p[8 * ss + 3]); pa.z = pkbf(p[8 * ss + 4], p[8 * ss + 5]); pa.w = pkbf(p[8 * ss + 6], p[8 * ss + 7]);
#pragma unroll
        for (int db = 0; db < 2; ++db) { const v2u lo = tv[4 * ss + 2 * db], hi = tv[4 * ss + 2 * db + 1];
            const v4u vv = (v4u){lo.x, lo.y, hi.x, hi.y};
            o[db] = mfma32(__builtin_bit_cast(bf16x8, pa), __builtin_bit_cast(bf16x8, vv), o[db]); } }
}
__device__ __forceinline__ void attn_phase(Frame& F) {
    bf16* Q1 = (bf16*)(F.ws + WS_VG); const bf16* K1 = Q1 + (size_t)T * D; const bf16* V1 = Q1 + (size_t)2 * T * D;
    const float* CK = F.in[3]; const float* CV = F.in[4];
    const int lane = lane_id(), r = lane & 31, h2 = lane >> 5;
    LAS unsigned char* vs0 = F.lds + F.wave * 8192;
    const int gw = blockIdx.x * NWAVES + F.wave, NGW = F.G * NWAVES;
    const unsigned offq = (unsigned)(r * 2048 + h2 * 16);
    const unsigned offv = (unsigned)((lane >> 3) * 2048 + (lane & 7) * 16);
    const unsigned offo = (unsigned)(h2 * 4 * 2048 + r * 2);
    const unsigned offck = (unsigned)(r * 256 + h2 * 32);
    const unsigned offcv = (unsigned)((lane >> 4) * 256 + (lane & 15) * 16);
    const int ntw = tail_wgs(F, 12);
    const int nP = gw < 32768 ? (32768 - gw + NGW - 1) / NGW : 0;
    const int v0 = (gw - ntw * NWAVES + NGW) % NGW, nS = v0 < 512 ? (512 - v0 + NGW - 1) / NGW : 0;
    for (int it = 0; it < nP + nS; ++it) {
        if (it == nP) tail_wait_wave(F, 4, ntw);
        const int u = it < nP ? gw + it * NGW : 32768 + v0 + (it - nP) * NGW;
        int hd, qblk; size_t seq0; const float* ck = nullptr; const float* cv = nullptr;
        if (u < 32768) { const int bh = u >> 8; qblk = u & 255; hd = bh & 15; seq0 = (size_t)(bh >> 4) * 8192; }
        else { const int v = u - 32768; const int bh = v >> 1; qblk = v & 1; hd = bh & 15; seq0 = 65536 + (size_t)(bh >> 4) * 64; ck = CK + (size_t)bh * 4096 * 64; cv = CV + (size_t)bh * 4096 * 64; }
        const bf16* qp = Q1 + (seq0 + 32 * qblk) * D + hd * 64;
        bf16x8 qf[4];
#pragma unroll
        for (int ks = 0; ks < 4; ++ks) qf[ks] = __builtin_bit_cast(bf16x8, ldg16(qp + 16 * ks, offq));
        f32x16 o[2];
#pragma unroll
        for (int i = 0; i < 16; ++i) { o[0][i] = 0.f; o[1][i] = 0.f; }
        float c = 0.f; const int ql = 32 * qblk + r;
        bool live = true;
        bf16x8 kf[4]; int vb = 0;
#define SB_FETCH(tk_, buf_) do { const bf16* kt_ = K1 + (seq0 + 32 * (tk_)) * D + hd * 64; const bf16* vt_ = V1 + (seq0 + 32 * (tk_)) * D + hd * 64; \
            _Pragma("unroll") for (int ks = 0; ks < 4; ++ks) kf[ks] = __builtin_bit_cast(bf16x8, ldg16(kt_ + 16 * ks, offq)); \
            _Pragma("unroll") for (int i = 0; i < 4; ++i) __builtin_amdgcn_global_load_lds((const unsigned*)((const char*)(vt_ + (size_t)(8 * i) * D) + offv), (LAS unsigned*)(vs0 + (buf_) * 4096 + i * 1024), 16, 0, 0); } while (0)
        SB_FETCH(qblk, 0);
#pragma unroll 1
        for (int tk = qblk; tk >= 0; --tk) {
            f32x16 p;
#pragma unroll
            for (int i = 0; i < 16; ++i) p[i] = 0.f;
            asm volatile("s_waitcnt vmcnt(0)" ::: "memory");
#pragma unroll
            for (int ks = 0; ks < 4; ++ks) p = mfma32(kf[ks], qf[ks], p);
            asm volatile("" ::: "memory");
            if (tk > 0) SB_FETCH(tk - 1, vb ^ 1);
            asm volatile("" ::: "memory");
            if (tk == qblk) sb_tile<true>(p, c, o, vs0 + vb * 4096, 32 * tk, ql, lane); else sb_tile<false>(p, c, o, vs0 + vb * 4096, 32 * tk, ql, lane);
            LDS_WAIT(); asm volatile("" ::: "memory");
            vb ^= 1;
            if (__all(c < SB_EXIT)) { live = false; break; }
        }
#undef SB_FETCH
        asm volatile("s_waitcnt vmcnt(0)" ::: "memory");
        if (ck && live) {
#pragma unroll 1
            for (int tc = 127; tc >= 0; --tc) {
                const float* kt = ck + (size_t)tc * 32 * 64; const float* vt = cv + (size_t)tc * 32 * 64;
#pragma unroll
                for (int ch = 0; ch < 2; ++ch) {
                    v4u a[4];
#pragma unroll
                    for (int i = 0; i < 4; ++i) a[i] = ldg16(vt + (size_t)(4 * (4 * ch + i)) * 64, offcv);
#pragma unroll
                    for (int i = 0; i < 4; ++i) { const int pz = lane + 64 * (4 * ch + i); v2u w2; w2.x = pkbf(__uint_as_float(a[i].x), __uint_as_float(a[i].y)); w2.y = pkbf(__uint_as_float(a[i].z), __uint_as_float(a[i].w));
                        *(LAS v2u*)(vs0 + (pz >> 4) * 128 + (pz & 15) * 8) = w2; }
                    asm volatile("" ::: "memory");
                }
                f32x16 p;
#pragma unroll
                for (int i = 0; i < 16; ++i) p[i] = 0.f;
#pragma unroll
                for (int kh = 0; kh < 2; ++kh) {
                    v4u a[2][2];
#pragma unroll
                    for (int k2 = 0; k2 < 2; ++k2) { const float* kr = kt + 16 * (2 * kh + k2); a[k2][0] = ldg16(kr, offck); a[k2][1] = ldg16(kr + 4, offck); }
#pragma unroll
                    for (int k2 = 0; k2 < 2; ++k2) { v4u kk; kk.x = pkbf(__uint_as_float(a[k2][0].x), __uint_as_float(a[k2][0].y)); kk.y = pkbf(__uint_as_float(a[k2][0].z), __uint_as_float(a[k2][0].w));
                        kk.z = pkbf(__uint_as_float(a[k2][1].x), __uint_as_float(a[k2][1].y)); kk.w = pkbf(__uint_as_float(a[k2][1].z), __uint_as_float(a[k2][1].w));
                        p = mfma32(__builtin_bit_cast(bf16x8, kk), qf[2 * kh + k2], p); }
                    asm volatile("" ::: "memory");
                }
                LDS_WAIT(); asm volatile("" ::: "memory");
                sb_tile<false>(p, c, o, vs0, 0, 0, lane);
                LDS_WAIT(); asm volatile("" ::: "memory");
                if (__all(c < SB_EXIT)) break;
            }
        }
        {
            const size_t rloc = (u < 32768) ? ((size_t)((u >> 8) >> 4) * 16 + hd) * 8192 + 32 * qblk : ((size_t)(((u - 32768) >> 1) >> 4) * 16 + hd) * 64 + 32 * qblk;
            float* kdst = F.out + (u < 32768 ? O_KRP : O_KRS) + rloc * 64 + lane * 4;
            float* vdst = kdst + (u < 32768 ? (O_VRP - O_KRP) : (O_VRS - O_KRS));
            const unsigned offkv = (unsigned)((lane >> 4) * 2048 + (lane & 15) * 8);
            const bf16* ksrc = K1 + (seq0 + 32 * qblk) * D + hd * 64; const bf16* vsrc = ksrc + (size_t)T * D;
            v2u kr[8], vr8[8];
#pragma unroll
            for (int i = 0; i < 8; ++i) { kr[i] = *(const GAS v2u*)((const GAS char*)(ksrc + (size_t)(4 * i) * D) + offkv); vr8[i] = *(const GAS v2u*)((const GAS char*)(vsrc + (size_t)(4 * i) * D) + offkv); }
#pragma unroll
            for (int i = 0; i < 8; ++i) {
                __builtin_nontemporal_store((f32x4){bflo(kr[i].x), bfhi(kr[i].x), bflo(kr[i].y), bfhi(kr[i].y)}, (f32x4*)(kdst + 256 * i));
                __builtin_nontemporal_store((f32x4){bflo(vr8[i].x), bfhi(vr8[i].x), bflo(vr8[i].y), bfhi(vr8[i].y)}, (f32x4*)(vdst + 256 * i)); }
        }
        bf16* op = Q1 + (seq0 + 32 * qblk) * D + hd * 64;
#pragma unroll
        for (int db = 0; db < 2; ++db)
#pragma unroll
            for (int i = 0; i < 16; ++i) *(GAS bf16*)((GAS char*)(op + (size_t)((i & 3) + 8 * (i >> 2)) * D + 32 * db) + offo) = (bf16)(pkbf(o[db][i], 0.f) & 0xffffu);
    }
}

struct Args { const float* in[16]; float* out; unsigned char* ws; int ph_lo, ph_hi; };
#ifndef DUP_LO
#define DUP_LO 16
#endif
#ifndef DUP_HI
#define DUP_HI 16
#endif
template <int PLO, int PHI> __device__ __forceinline__ void run_phases(Frame& F, const XcdBarrier& bar, int lo, int hi) {
#ifndef ONLY_PHASE
#define ONLY_PHASE -1
#endif
#define IN(k) ((ONLY_PHASE < 0 || ONLY_PHASE == (k)) && PLO <= (k) && (k) < PHI && lo <= (k) && (k) < hi)
#define SEAM(k) do { if ((k) + 1 < hi) xcd_barrier(bar, F.wave == 0 && lane_id() == 0); } while (0)
    bf16* XB = (bf16*)(F.ws + WS_XB); bf16* M1 = (bf16*)(F.ws + WS_M1); bf16* VG = (bf16*)(F.ws + WS_VG);
    if (IN(0)) { p0_prologue(F); SEAM(0); }
    if (IN(1)) {
        pg8::Gemm g{XB, (const bf16*)(F.ws + WS_WIN), T, 6144, 1024, 1024, 1024}; pg8::StaticOrder S; S.init(T, 6144, F.G, (int)blockIdx.x);
        pg8::EpiRot E{(bf16*)(F.out + O_KRP), VG, (const float*)(F.ws + WS_COS), (const float*)(F.ws + WS_SIN)};
        pg8::gemm_phase<pg8::EpiRot, pg8::StaticOrder, PG8_ALIGN, PG8_SP2>(F.lds, g, S, E, F.wave); SEAM(1);
    }
    if (IN(2)) { ret_phase(F); SEAM(2); }
    if (IN(3)) { gn_gate_phase(F); SEAM(3); }
    if (IN(4)) {
        pg8::Gemm g{VG, (const bf16*)(F.ws + WS_WRO), TP, 1024, 2048, 4096, 2048}; pg8::StaticOrder S; S.init(TP, 1024, F.G, (int)blockIdx.x);
        pg8::EpiBf16<0> E{M1, 1024, nullptr, 0, 0, 1.f};
        pg8::gemm_phase<pg8::EpiBf16<0>, pg8::StaticOrder, PG8_ALIGN, PG8_SP2>(F.lds, g, S, E, F.wave); SEAM(4);
    }
    if (IN(5)) {
        if ((int)blockIdx.x < tail_wgs(F, 4)) {
            pg8::Gemm g{VG, (const bf16*)(F.ws + WS_WRO), T, 1024, 2048, 4096, 2048}; pg8::TailOrder S{4, F.G, (int)blockIdx.x};
            pg8::EpiBf16<0> E{M1, 1024, nullptr, 0, 0, 1.f};
            pg8::gemm_phase<pg8::EpiBf16<0>, pg8::TailOrder, PG8_ALIGN, PG8_SP2>(F.lds, g, S, E, F.wave); tail_publish(F, 0);
        }
        ln_phase(F, 0, 0, LN_TAIL_ROWS0); SEAM(5);
    }
#define PEER_PHASES(layer, pb) do { \
        if (IN(pb)) { \
            pg8::Gemm g{XB, (const bf16*)(F.ws + WS_WPQ + (size_t)(layer) * 4 * MiB), TP, 2048, 1024, 1024, 1024}; pg8::StaticOrder S; S.init(TP, 2048, F.G, (int)blockIdx.x); \
            pg8::EpiBf16<0> E{VG, 2048, nullptr, 0, 0, 1.f}; \
            pg8::gemm_phase<pg8::EpiBf16<0>, pg8::StaticOrder, PG8_ALIGN, PG8_SP2>(F.lds, g, S, E, F.wave); SEAM(pb); \
        } \
        if (IN((pb) + 1)) { \
            if ((int)blockIdx.x < tail_wgs(F, 8)) {                       \
                pg8::Gemm g{XB, (const bf16*)(F.ws + WS_WPQ + (size_t)(layer) * 4 * MiB), T, 2048, 1024, 1024, 1024}; pg8::TailOrder S{8, F.G, (int)blockIdx.x}; \
                pg8::EpiBf16<0> E{VG, 2048, nullptr, 0, 0, 1.f}; \
                pg8::gemm_phase<pg8::EpiBf16<0>, pg8::TailOrder, PG8_ALIGN, PG8_SP2>(F.lds, g, S, E, F.wave); tail_publish(F, 2 + (layer)); \
            } \
            topk_phase(F, (layer), 2 + (layer)); SEAM((pb) + 1); } \
        if (IN((pb) + 2)) { gather_u_phase(F, (layer)); SEAM((pb) + 2); } \
        if (IN((pb) + 3)) { gather_v_phase(F, (layer)); SEAM((pb) + 3); } } while (0)
    PEER_PHASES(0, 6);
    if (IN(10)) {
        pg8::Gemm g{XB, (const bf16*)(F.ws + WS_WQKV), TP, 3072, 1024, 1024, 1024}; pg8::StaticOrder S; S.init(TP, 3072, F.G, (int)blockIdx.x);
        pg8::EpiQKV1 E{VG, (size_t)T * D, F.out + O_KRP, F.out + O_VRP, F.out + O_KRS, F.out + O_VRS};
        pg8::gemm_phase<pg8::EpiQKV1, pg8::StaticOrder, PG8_ALIGN, PG8_SP2>(F.lds, g, S, E, F.wave); SEAM(10);
    }
    if (IN(11)) {
        if ((int)blockIdx.x < tail_wgs(F, 12)) {
            pg8::Gemm g{XB, (const bf16*)(F.ws + WS_WQKV), T, 3072, 1024, 1024, 1024}; pg8::TailOrder S{12, F.G, (int)blockIdx.x};
            pg8::EpiQKV1 E{VG, (size_t)T * D, F.out + O_KRP, F.out + O_VRP, F.out + O_KRS, F.out + O_VRS};
            pg8::gemm_phase<pg8::EpiQKV1, pg8::TailOrder, PG8_ALIGN, PG8_SP2>(F.lds, g, S, E, F.wave); tail_publish(F, 4);
        }
        attn_phase(F); SEAM(11);
    }
    if (IN(12)) {
        pg8::Gemm g{VG, (const bf16*)(F.ws + WS_WSO), TP, 1024, 1024, 1024, 1024}; pg8::StaticOrder S; S.init(TP, 1024, F.G, (int)blockIdx.x);
        pg8::EpiBf16<0> E{M1, 1024, nullptr, 0, 0, 1.f};
        pg8::gemm_phase<pg8::EpiBf16<0>, pg8::StaticOrder, PG8_ALIGN, PG8_SP2>(F.lds, g, S, E, F.wave); SEAM(12);
    }
    if (IN(13)) {
        if ((int)blockIdx.x < tail_wgs(F, 4)) {
            pg8::Gemm g{VG, (const bf16*)(F.ws + WS_WSO), T, 1024, 1024, 1024, 1024}; pg8::TailOrder S{4, F.G, (int)blockIdx.x};
            pg8::EpiBf16<0> E{M1, 1024, nullptr, 0, 0, 1.f};
            pg8::gemm_phase<pg8::EpiBf16<0>, pg8::TailOrder, PG8_ALIGN, PG8_SP2>(F.lds, g, S, E, F.wave); tail_publish(F, 1);
        }
        ln_phase(F, 1, 1, LN_TAIL_ROWS1); SEAM(13);
    }
    PEER_PHASES(1, 14);
#undef PEER_PHASES
#undef IN
#undef SEAM
}
__global__ void __launch_bounds__(NTHR, 2) fwd(Args args) {
    extern __shared__ __attribute__((aligned(16))) unsigned char lds[];
    Frame F;
    F.lds = (LAS unsigned char*)lds; F.MISC = (volatile LAS unsigned*)(F.lds + MISC_OFF);
    F.wave = __builtin_amdgcn_readfirstlane((int)threadIdx.x >> 6); F.G = gridDim.x;
#pragma unroll
    for (int i = 0; i < 16; ++i) F.in[i] = args.in[i];
    F.out = args.out; F.ws = args.ws; F.ctl = (gu32*)(args.ws + WS_CTL);
    for (int u = F.wave * 64 + lane_id(); u < (LDS_BYTES - LDSCTL_OFF) / 4; u += NTHR) ((LAS unsigned*)(F.lds + LDSCTL_OFF))[u] = 0u;
    __syncthreads();
    const int lo = args.ph_lo, hi = args.ph_hi;
    XcdBarrier bar; bar.bar = (unsigned*)(F.ctl + CW_BAR); bar.x = 0; bar.st = nullptr;
    if (hi - lo > 1) bar = xcd_barrier_post((unsigned*)(F.ctl + CW_BAR), F.MISC + 8, F.wave == 0 && lane_id() == 0);
#if DUP_LO < DUP_HI
    run_phases<0, DUP_HI>(F, bar, lo, hi);
    run_phases<DUP_LO, DUP_HI>(F, bar, lo, hi);
    run_phases<DUP_HI, NPH>(F, bar, lo, hi);
#else
    run_phases<0, NPH>(F, bar, lo, hi);
#endif
}

extern "C" void kernel_launch(void* const* d_in, const int* in_sizes, int n_in, void* d_out, int out_size, void* d_ws, size_t ws_size, hipStream_t stream) {
    static int grid = 0;
    if (grid == 0) {
        if (n_in != 16 || in_sizes[0] != TP * D || (size_t)out_size != O_END || ws_size < WS_END) {
            fprintf(stderr, "kernel_launch: unexpected shapes: n_in %d in0 %d out %d ws %zu (need %zu)\n", n_in, n_in > 0 ? in_sizes[0] : -1, out_size, ws_size, (size_t)WS_END); grid = -1; return; }
        int dev = 0, cus = 0, per_cu = 0;
        if (hipGetDevice(&dev) != hipSuccess || hipDeviceGetAttribute(&cus, hipDeviceAttributeMultiprocessorCount, dev) != hipSuccess) { grid = -1; return; }
        if (hipFuncSetAttribute((const void*)fwd, hipFuncAttributeMaxDynamicSharedMemorySize, LDS_BYTES) != hipSuccess) { fprintf(stderr, "kernel_launch: hipFuncSetAttribute failed\n"); grid = -1; return; }
        if (hipOccupancyMaxActiveBlocksPerMultiprocessor(&per_cu, (const void*)fwd, NTHR, LDS_BYTES) != hipSuccess || per_cu < 1) fprintf(stderr, "kernel_launch: occupancy query says %d\n", per_cu);
        (void)hipGetLastError();
        grid = cus;
    }
    if (grid < 0) return;
    if (hipMemsetAsync((char*)d_ws + WS_CTL, 0, CTL_ZERO_BYTES, stream) != hipSuccess) { fprintf(stderr, "kernel_launch: memset failed\n"); return; }
    Args a{};
    for (int i = 0; i < 16; ++i) a.in[i] = (const float*)d_in[i];
    a.out = (float*)d_out; a.ws = (unsigned char*)d_ws;
#if MK_ONE_LAUNCH
    a.ph_lo = 0; a.ph_hi = NPH;
    hipLaunchKernelGGL(fwd, dim3(grid), dim3(NTHR), LDS_BYTES, stream, a);
#else
    for (int p = 0; p < NPH; ++p) { a.ph_lo = p; a.ph_hi = p + 1; hipLaunchKernelGGL(fwd, dim3(grid), dim3(NTHR), LDS_BYTES, stream, a); }
#endif
    const hipError_t le = hipPeekAtLastError();
    if (le != hipSuccess) fprintf(stderr, "kernel_launch: launch failed: %s\n", hipGetErrorName(le));
}
```

```cpp
#include <hip/hip_runtime.h>
#include <cstdio>
#include <cstdint>
#define GAS __attribute__((address_space(1)))
#define LAS __attribute__((address_space(3)))
namespace pg8 {
#define PG8_LAS __attribute__((address_space(3)))
typedef unsigned short bf16_t;
typedef short bf16x8 __attribute__((ext_vector_type(8)));
typedef float f32x4 __attribute__((ext_vector_type(4)));
typedef unsigned u32x4 __attribute__((ext_vector_type(4)));
constexpr int BM = 256, BK = 64, HALF = 128, HTB = HALF * BK * 2  , STAGE_BYTES = 8 * HTB, NXCD = 8, WGM = 8;

__host__ __device__ __forceinline__ int lds_byte(int r, int c) { const int st = (r >> 4) * 2 + (c >> 5), rr = r & 15, cc = c & 31, ob = rr * 64 + cc * 2; return st * 1024 + (ob ^ (((ob >> 9) & 1) << 5)); }
__host__ __device__ __forceinline__ void stage_rc(int b, int& R, int& C) { const int st = b / 1024, sb = b % 1024, swz = sb ^ (((sb >> 9) & 1) << 5); R = (st >> 1) * 16 + swz / 64; C = (st & 1) * 32 + (swz % 64) / 2; }
__host__ __device__ __forceinline__ int perm32(int rho) { const int n = rho >> 4, i = rho & 15; return 8 * (i >> 2) + 4 * n + (i & 3); }

struct Unit { int pm, pn; };
struct Gemm { const bf16_t* A; const bf16_t* Bt; int M, N, K, lda, ldb; };

struct StaticOrder {
    int nM, nN, nwg, G, c;
    __host__ __device__ void init(int M, int N, int G_, int c_) { nM = M / BM; nN = N / BM; nwg = nM * nN; G = G_; c = c_; }
    __host__ __device__ bool next(int i, Unit& u) const {
        const long L = (long)i * G + c; if (L >= nwg) return false;
        int wgid = (int)L; { const int q = nwg / NXCD, r = nwg % NXCD, xcd = wgid % NXCD, off = wgid / NXCD; wgid = (xcd < r ? xcd * (q + 1) : r * (q + 1) + (xcd - r) * q) + off; }
        const int nig = WGM * nN, gid = wgid / nig, fm = gid * WGM, gsz = (nM - fm) < WGM ? (nM - fm) : WGM;
        u.pm = fm + ((wgid % nig) % gsz); u.pn = (wgid % nig) / gsz; return true;
    }
    __device__ __forceinline__ void a_ready(const Unit&) const {}
    __device__ __forceinline__ void done(const Unit&) const {}
};

__device__ __forceinline__ unsigned cvt_pk_bf16(float lo, float hi) { unsigned r; asm volatile("v_cvt_pk_bf16_f32 %0, %1, %2" : "=v"(r) : "v"(lo), "v"(hi)); return r; }
typedef float f32x2 __attribute__((ext_vector_type(2)));
__device__ __forceinline__ f32x2 gelu_pk(f32x2 v) {
    const f32x2 av = __builtin_elementwise_abs(v), d = av * 0.2316418882f + 1.0f;
    f32x2 t; t.x = __builtin_amdgcn_rcpf(d.x); t.y = __builtin_amdgcn_rcpf(d.y);
    f32x2 q = t * 0.5307027145f + (-0.7265760135f); q = q * t + 0.7107068705f; q = q * t + (-0.142248368f); q = q * t + 0.127414796f; q = q * t;
    const f32x2 s = (v * v) * (-0.72134752044f);
    f32x2 e; e.x = __builtin_amdgcn_exp2f(s.x); e.y = __builtin_amdgcn_exp2f(s.y);
    const f32x2 m = v * (q * e), r = v - m;
    f32x2 o; o.x = v.x < 0.f ? m.x : r.x; o.y = v.y < 0.f ? m.y : r.y; return o;
}

template <int ACT  > struct EpiBf16 {
    static constexpr bool PERM = true, AFTER_DRAIN = false; static_assert(ACT == 0 || ACT == 1, "EpiBf16: ACT is 0 (none) or 1 (gelu_pk)");
    bf16_t* O; int ldc; const float* bias; int split_cols; size_t split_stride; float scale0;
    __device__ __forceinline__ void operator()(const f32x4 (&acc)[2][2][4][2], const Unit& u, int wr, int wc, int fr, int fq) const {
        const int row0 = u.pm * BM + wr * 64 + fr; int colt = u.pn * BM; bf16_t* base = O;
        float sc = 1.f; if (split_cols) { const int t = colt / split_cols; base += (size_t)t * split_stride; colt -= t * split_cols; if (t == 0) sc = scale0; }
        const int col0 = colt + wc * 32 + 8 * fq, bcol0 = u.pn * BM + wc * 32 + 8 * fq;
        f32x4 bv[2][2];
#pragma unroll
        for (int bj = 0; bj < 2; ++bj)
#pragma unroll
            for (int n = 0; n < 2; ++n) bv[bj][n] = bias ? *(const f32x4*)(bias + bcol0 + bj * HALF + 4 * n) : (f32x4){0.f, 0.f, 0.f, 0.f};
#pragma unroll
        for (int ai = 0; ai < 2; ++ai)
#pragma unroll
            for (int m = 0; m < 4; ++m) { bf16_t* rowp = base + (size_t)(row0 + ai * HALF + m * 16) * ldc + col0;
#pragma unroll
                for (int bj = 0; bj < 2; ++bj) { f32x4 v0 = acc[ai][bj][m][0] + bv[bj][0], v1 = acc[ai][bj][m][1] + bv[bj][1];
                    if (ACT == 1) { f32x2 a = gelu_pk((f32x2){v0[0], v0[1]}), b = gelu_pk((f32x2){v0[2], v0[3]}), c = gelu_pk((f32x2){v1[0], v1[1]}), d = gelu_pk((f32x2){v1[2], v1[3]});
                        v0 = (f32x4){a.x, a.y, b.x, b.y}; v1 = (f32x4){c.x, c.y, d.x, d.y}; }
                    v0 = v0 * sc; v1 = v1 * sc; u32x4 w; w.x = cvt_pk_bf16(v0[0], v0[1]); w.y = cvt_pk_bf16(v0[2], v0[3]); w.z = cvt_pk_bf16(v1[0], v1[1]); w.w = cvt_pk_bf16(v1[2], v1[3]);
                    *(u32x4*)(rowp + bj * HALF) = w; } }
    }
};

__device__ __forceinline__ int row_pos(int r) { return r < 65536 ? (r & 8191) : 4096 + (r & 63); }
struct EpiRot {
    static constexpr bool PERM = true, AFTER_DRAIN = false;
    bf16_t* QK; bf16_t* VG; const float* cosT; const float* sinT;
    __device__ __forceinline__ void operator()(const f32x4 (&acc)[2][2][4][2], const Unit& u, int wr, int wc, int fr, int fq) const {
        const int row0 = u.pm * BM + wr * 64 + fr;
        if (u.pn < 8) {
            const float l2g = __builtin_amdgcn_logf(1.0f - __builtin_amdgcn_exp2f(-5.0f - (float)(u.pn & 3))) * ((u.pn >= 4) ? -1.0f : 1.0f);
            const float sc0 = (u.pn >= 4) ? 0.0625f : 1.0f;
            const int i0 = wc * 32 + 8 * fq;
#pragma unroll
            for (int ai = 0; ai < 2; ++ai)
#pragma unroll
                for (int m = 0; m < 4; ++m) {
                    const int row = row0 + ai * HALF + m * 16; const int pos = row_pos(row);
                    const float sc = sc0 * __builtin_amdgcn_exp2f((float)(row & 63) * l2g);
                    const float* cp = cosT + (size_t)pos * 128 + i0; const float* sp = sinT + (size_t)pos * 128 + i0;
                    const f32x4 c0 = *(const f32x4*)cp, c1 = *(const f32x4*)(cp + 4), s0 = *(const f32x4*)sp, s1 = *(const f32x4*)(sp + 4);
                    const f32x4 a0 = acc[ai][0][m][0], a1 = acc[ai][0][m][1], b0 = acc[ai][1][m][0], b1 = acc[ai][1][m][1];
                    const f32x4 o00 = (a0 * c0 - b0 * s0) * sc, o01 = (a1 * c1 - b1 * s1) * sc;
                    const f32x4 o10 = (a0 * s0 + b0 * c0) * sc, o11 = (a1 * s1 + b1 * c1) * sc;
                    bf16_t* rowp = QK + (size_t)row * 2048 + u.pn * BM + wc * 32 + 8 * fq;
                    u32x4 w; w.x = cvt_pk_bf16(o00[0], o00[1]); w.y = cvt_pk_bf16(o00[2], o00[3]); w.z = cvt_pk_bf16(o01[0], o01[1]); w.w = cvt_pk_bf16(o01[2], o01[3]);
                    *(u32x4*)rowp = w;
                    w.x = cvt_pk_bf16(o10[0], o10[1]); w.y = cvt_pk_bf16(o10[2], o10[3]); w.z = cvt_pk_bf16(o11[0], o11[1]); w.w = cvt_pk_bf16(o11[2], o11[3]);
                    *(u32x4*)(rowp + HALF) = w;
                }
        } else {
#pragma unroll
            for (int ai = 0; ai < 2; ++ai)
#pragma unroll
                for (int m = 0; m < 4; ++m) {
                    const int row = row0 + ai * HALF + m * 16;
                    bf16_t* rowp = VG + (size_t)row * 4096 + (u.pn - 8) * BM + wc * 32 + 8 * fq;
#pragma unroll
                    for (int bj = 0; bj < 2; ++bj) { const f32x4 v0 = acc[ai][bj][m][0], v1 = acc[ai][bj][m][1];
                        u32x4 w; w.x = cvt_pk_bf16(v0[0], v0[1]); w.y = cvt_pk_bf16(v0[2], v0[3]); w.z = cvt_pk_bf16(v1[0], v1[1]); w.w = cvt_pk_bf16(v1[2], v1[3]);
                        *(u32x4*)(rowp + bj * HALF) = w; }
                }
        }
    }
};
struct EpiQKV1 {
    static constexpr bool PERM = true, AFTER_DRAIN = false;
    bf16_t* Q1; size_t bstride;
    float* krp; float* vrp; float* krs; float* vrs;
    __device__ __forceinline__ void operator()(const f32x4 (&acc)[2][2][4][2], const Unit& u, int wr, int wc, int fr, int fq) const {
        const int row0 = u.pm * BM + wr * 64 + fr;
        const int t = u.pn >> 2;
        const int colt = (u.pn & 3) * BM + wc * 32 + 8 * fq;
        const float sc = (t == 0) ? 0.125f : 1.0f;
        bf16_t* base = Q1 + (size_t)t * bstride;
#pragma unroll
        for (int ai = 0; ai < 2; ++ai)
#pragma unroll
            for (int m = 0; m < 4; ++m) {
                const int row = row0 + ai * HALF + m * 16;
                bf16_t* rowp = base + (size_t)row * 1024 + colt;
#pragma unroll
                for (int bj = 0; bj < 2; ++bj) { const f32x4 v0 = acc[ai][bj][m][0] * sc, v1 = acc[ai][bj][m][1] * sc;
                    u32x4 w; w.x = cvt_pk_bf16(v0[0], v0[1]); w.y = cvt_pk_bf16(v0[2], v0[3]); w.z = cvt_pk_bf16(v1[0], v1[1]); w.w = cvt_pk_bf16(v1[2], v1[3]);
                    *(u32x4*)(rowp + bj * HALF) = w;
                    }
            }
    }
};
template <class Epi, class Sched, bool ALIGN_EPI = false, bool SP2 = false>
__device__ __forceinline__ void gemm_phase(PG8_LAS unsigned char* lds, const Gemm g, const Sched& S, const Epi& E, const int wid_in) {
    const int lane = (int)__builtin_amdgcn_mbcnt_hi(~0u, __builtin_amdgcn_mbcnt_lo(~0u, 0u)), wid = wid_in, tid = wid * 64 + lane, wr = wid >> 2, wc = wid & 3, fr = lane & 15, fq = lane >> 4;
    const int K = g.K, nt = K / BK;
    unsigned voffA[2], voffB[2];
#pragma unroll
    for (int i = 0; i < 2; ++i) { int R, C; stage_rc(tid * 16 + i * 8192, R, C); const int Rb = Epi::PERM ? ((R & ~31) + perm32(R & 31)) : R;
        voffA[i] = (unsigned)(R * g.lda + C) * 2u; voffB[i] = (unsigned)(Rb * g.ldb + C) * 2u; }
    const size_t kstep = (size_t)(BK * 2);
    const size_t hstepA = (size_t)HALF * g.lda * 2, hstepB = (size_t)HALF * g.ldb * 2;
    const size_t tstepA = 2 * hstepA, tstepB = 2 * hstepB;
    const unsigned ldsw = (unsigned)wid * 1024u;
    const int aoff = lds_byte(wr * 64 + fr, fq * 8), boff = lds_byte(wc * 32 + fr, fq * 8);
#define PG8_SA(b, h) (((b) * 2 + (h)) * HTB)
#define PG8_SB(b, h) ((4 + (b) * 2 + (h)) * HTB)
#define PG8_STAGE(bufoff, gbase, voff) do { _Pragma("unroll") for (int _i = 0; _i < 2; ++_i) \
        __builtin_amdgcn_global_load_lds((const unsigned*)((const char*)(gbase) + (voff)[_i]), (PG8_LAS unsigned*)(lds + (bufoff) + ldsw + _i * 8192), 16, 0, 0); } while (0)
#define PG8_LDA(dst, b, h) do { _Pragma("unroll") for (int m = 0; m < 4; ++m) _Pragma("unroll") for (int k = 0; k < 2; ++k) dst[m][k] = *(const PG8_LAS bf16x8*)(lds + PG8_SA(b, h) + aoff + m * 2048 + k * 1024); } while (0)
#define PG8_LDB(dst, b, h) do { _Pragma("unroll") for (int n = 0; n < 2; ++n) _Pragma("unroll") for (int k = 0; k < 2; ++k) dst[n][k] = *(const PG8_LAS bf16x8*)(lds + PG8_SB(b, h) + boff + n * 2048 + k * 1024); } while (0)
#define PG8_MMA(ai, bj, At, Bt) do { __builtin_amdgcn_s_setprio(1); _Pragma("unroll") for (int m = 0; m < 4; ++m) _Pragma("unroll") for (int n = 0; n < 2; ++n) _Pragma("unroll") for (int k = 0; k < 2; ++k) \
        acc[ai][bj][m][n] = __builtin_amdgcn_mfma_f32_16x16x32_bf16(Bt[n][k], At[m][k], acc[ai][bj][m][n], 0, 0, 0); __builtin_amdgcn_s_setprio(0); } while (0)
#define PG8_WAIT_V(n) asm volatile("s_waitcnt vmcnt(" #n ")" ::: "memory")
#define PG8_WAIT_L(n) asm volatile("s_waitcnt lgkmcnt(" #n ")" ::: "memory")
#define PG8_BAR __builtin_amdgcn_s_barrier()
#define PG8_SCHED __builtin_amdgcn_sched_barrier(0)
    Unit cur, nxt; int ui = 0;
    if (!S.next(0, cur)) return;
    f32x4 acc[2][2][4][2];
#pragma unroll
    for (int a = 0; a < 2; ++a)
#pragma unroll
        for (int b = 0; b < 2; ++b)
#pragma unroll
            for (int m = 0; m < 4; ++m)
#pragma unroll
                for (int n = 0; n < 2; ++n) acc[a][b][m][n] = (f32x4){0.f, 0.f, 0.f, 0.f};
    bf16x8 At[4][2], B0[2][2], B1[2][2];
    const char* cA = (const char*)g.A + (size_t)cur.pm * tstepA; const char* cB = (const char*)g.Bt + (size_t)cur.pn * tstepB;
    S.a_ready(cur);
    if constexpr (SP2) {
        PG8_STAGE(PG8_SB(0, 0), cB, voffB); PG8_STAGE(PG8_SB(0, 1), cB + hstepB, voffB); PG8_STAGE(PG8_SA(0, 0), cA, voffA); PG8_STAGE(PG8_SA(0, 1), cA + hstepA, voffA);
        if (wr == 1) PG8_BAR;
        PG8_WAIT_V(2); PG8_BAR;
        PG8_STAGE(PG8_SB(1, 0), cB + kstep, voffB); PG8_STAGE(PG8_SA(1, 0), cA + kstep, voffA); PG8_STAGE(PG8_SB(1, 1), cB + hstepB + kstep, voffB);
        PG8_WAIT_V(6); PG8_BAR;
    } else {
        PG8_STAGE(PG8_SB(0, 0), cB, voffB); PG8_STAGE(PG8_SA(0, 0), cA, voffA); PG8_STAGE(PG8_SB(0, 1), cB + hstepB, voffB); PG8_STAGE(PG8_SA(0, 1), cA + hstepA, voffA);
        if (wr == 1) PG8_BAR;
        PG8_WAIT_V(4); PG8_BAR;
        PG8_STAGE(PG8_SB(1, 0), cB + kstep, voffB); PG8_STAGE(PG8_SA(1, 0), cA + kstep, voffA); PG8_STAGE(PG8_SB(1, 1), cB + hstepB + kstep, voffB);
        PG8_WAIT_V(6); PG8_BAR;
    }
    for (;;) {
        const bool has_next = S.next(ui + 1, nxt);
        const char* nA = has_next ? (const char*)g.A + (size_t)nxt.pm * tstepA : cA; const char* nB = has_next ? (const char*)g.Bt + (size_t)nxt.pn * tstepB : cB;
        for (int t = 0; t < nt; t += 2) {
            const bool last = (t == nt - 2);
            const char* a1 = cA + (size_t)(t + 1) * kstep;
            const char* a2 = last ? nA : cA + (size_t)(t + 2) * kstep; const char* b2 = last ? nB : cB + (size_t)(t + 2) * kstep;
            const char* a3 = a2 + kstep; const char* b3 = b2 + kstep;
            if (last && has_next) S.a_ready(nxt);
            if constexpr (SP2) {
            PG8_LDB(B0, 0, 0); PG8_LDB(B1, 0, 1); PG8_SCHED; PG8_LDA(At, 0, 0); PG8_STAGE(PG8_SA(1, 1), a1 + hstepA, voffA);
            PG8_WAIT_V(8); PG8_WAIT_L(0); PG8_BAR; PG8_MMA(0, 0, At, B0); PG8_MMA(0, 1, At, B1); PG8_BAR; PG8_SCHED;
            PG8_LDA(At, 0, 1); PG8_STAGE(PG8_SB(0, 0), b2, voffB); PG8_STAGE(PG8_SB(0, 1), b2 + hstepB, voffB); PG8_STAGE(PG8_SA(0, 0), a2, voffA);
            PG8_WAIT_V(8); PG8_WAIT_L(0); PG8_BAR; PG8_MMA(1, 0, At, B0); PG8_MMA(1, 1, At, B1); PG8_BAR; PG8_SCHED;
            PG8_LDB(B0, 1, 0); PG8_LDB(B1, 1, 1); PG8_SCHED; PG8_LDA(At, 1, 0); PG8_STAGE(PG8_SA(0, 1), a2 + hstepA, voffA);
            PG8_WAIT_V(8); PG8_WAIT_L(0); PG8_BAR; PG8_MMA(0, 0, At, B0); PG8_MMA(0, 1, At, B1); PG8_BAR; PG8_SCHED;
            PG8_LDA(At, 1, 1); PG8_STAGE(PG8_SB(1, 0), b3, voffB); PG8_STAGE(PG8_SB(1, 1), b3 + hstepB, voffB); PG8_STAGE(PG8_SA(1, 0), a3, voffA);
            PG8_WAIT_V(8); PG8_WAIT_L(0); PG8_BAR; PG8_MMA(1, 0, At, B0); PG8_MMA(1, 1, At, B1); PG8_BAR; PG8_SCHED;
            } else {
            PG8_LDB(B0, 0, 0); PG8_SCHED; PG8_LDA(At, 0, 0); PG8_STAGE(PG8_SA(1, 1), a1 + hstepA, voffA);
            PG8_WAIT_L(8); PG8_BAR; PG8_WAIT_L(0); PG8_MMA(0, 0, At, B0); PG8_BAR; PG8_SCHED;
            PG8_LDB(B1, 0, 1); PG8_STAGE(PG8_SB(0, 0), b2, voffB);
            PG8_BAR; PG8_WAIT_L(0); PG8_MMA(0, 1, At, B1); PG8_BAR;
            PG8_LDA(At, 0, 1); PG8_STAGE(PG8_SA(0, 0), a2, voffA);
            PG8_BAR; PG8_WAIT_L(0); PG8_MMA(1, 0, At, B0); PG8_BAR; PG8_SCHED;
            PG8_STAGE(PG8_SB(0, 1), b2 + hstepB, voffB);
            PG8_WAIT_V(6); PG8_BAR; PG8_MMA(1, 1, At, B1); PG8_BAR;
            PG8_LDB(B0, 1, 0); PG8_SCHED; PG8_LDA(At, 1, 0); PG8_STAGE(PG8_SA(0, 1), a2 + hstepA, voffA);
            PG8_WAIT_L(8); PG8_BAR; PG8_WAIT_L(0); PG8_MMA(0, 0, At, B0); PG8_BAR; PG8_SCHED;
            PG8_LDB(B1, 1, 1); PG8_STAGE(PG8_SB(1, 0), b3, voffB);
            PG8_BAR; PG8_WAIT_L(0); PG8_MMA(0, 1, At, B1); PG8_BAR;
            PG8_LDA(At, 1, 1); PG8_STAGE(PG8_SA(1, 0), a3, voffA);
            PG8_BAR; PG8_WAIT_L(0); PG8_MMA(1, 0, At, B0); PG8_BAR; PG8_SCHED;
            PG8_STAGE(PG8_SB(1, 1), b3 + hstepB, voffB);
            PG8_WAIT_V(6); PG8_BAR; PG8_MMA(1, 1, At, B1); PG8_BAR;
            }
        }
        if constexpr (ALIGN_EPI) { if (wr == 0) PG8_BAR; }
        if constexpr (!Epi::AFTER_DRAIN) { E(acc, cur, wr, wc, fr, fq); S.done(cur); }
        if (!has_next) break;
#pragma unroll
        for (int a = 0; a < 2; ++a)
#pragma unroll
            for (int b = 0; b < 2; ++b)
#pragma unroll
                for (int m = 0; m < 4; ++m)
#pragma unroll
                    for (int n = 0; n < 2; ++n) acc[a][b][m][n] = (f32x4){0.f, 0.f, 0.f, 0.f};
        cur = nxt; cA = nA; cB = nB; ++ui;
        if constexpr (ALIGN_EPI) { if (wr == 1) PG8_BAR; }
    }
    PG8_WAIT_V(0);
    if constexpr (!ALIGN_EPI) { if (wr == 0) PG8_BAR; }
    PG8_BAR;
    if constexpr (Epi::AFTER_DRAIN) { E.fused(acc, cur, wr, wc, fr, fq, lds, wid, lane); S.done(cur); }
#undef PG8_SA
#undef PG8_SB
#undef PG8_STAGE
#undef PG8_LDA
#undef PG8_LDB
#undef PG8_MMA
#undef PG8_WAIT_V
#undef PG8_WAIT_L
#undef PG8_BAR
#undef PG8_SCHED
}
}
#define XB_TMO      128
#define XB_XCNT(j)  (256  + 64 * (j))
#define XB_XSUB(j)  (1280 + 64 * (j))
#define XB_XGEN(j)  (2304 + 64 * (j))
#define XB_TOP      3328
#define XB_TOPGEN   3392
#define XCD_BAR_WORDS 3456
#define XB_SPIN_CAP (1u << 18)

__device__ __forceinline__ unsigned xb_ld(unsigned* p)              { return __hip_atomic_load(p, __ATOMIC_RELAXED, __HIP_MEMORY_SCOPE_AGENT); }
__device__ __forceinline__ unsigned xb_add(unsigned* p, unsigned v) { return __hip_atomic_fetch_add(p, v, __ATOMIC_RELAXED, __HIP_MEMORY_SCOPE_AGENT); }
__device__ __forceinline__ unsigned xb_xcc_id() { return (unsigned)__builtin_amdgcn_s_getreg((3 << 11) | 20) & 0xFu; }
#define XB_SPIN(cond, bar) do { unsigned _sp = 0; while (cond) { __builtin_amdgcn_s_sleep(1); \
    if ((++_sp & 255u) == 0u) { if (xb_ld(&(bar)[XB_TMO])) break; if (_sp > XB_SPIN_CAP) { atomicAdd(&(bar)[XB_TMO], 1u); break; } } } } while (0)

struct XcdBarrier {
    unsigned* bar; unsigned x;
    volatile LAS unsigned* st;
};

__device__ __forceinline__ XcdBarrier xcd_barrier_post(unsigned* bar, volatile LAS unsigned* st, const bool is_t0) {
    XcdBarrier b; b.bar = bar; b.x = xb_xcc_id(); b.st = st;
    if (is_t0) (void)xb_add(&bar[XB_XCNT(b.x)], 1u);
    return b;
}
__device__ __forceinline__ void xcd_barrier_complete(unsigned* bar, unsigned x, unsigned& nloc, unsigned& nx) {
    const unsigned G = gridDim.x * gridDim.y * gridDim.z;
    unsigned sum, cnt, mine, sp = 0u;
    for (;;) {
        sum = 0u; cnt = 0u; mine = 0u;
#pragma unroll
        for (unsigned j = 0; j < 16; ++j) { const unsigned c = xb_ld(&bar[XB_XCNT(j)]); sum += c; cnt += (c > 0u) ? 1u : 0u; mine = (j == x) ? c : mine; }
        if (sum == G) break;
        __builtin_amdgcn_s_sleep(1);
        if ((++sp & 255u) == 0u) { if (xb_ld(&bar[XB_TMO])) break; if (sp > XB_SPIN_CAP) { atomicAdd(&bar[XB_TMO], 1u); break; } }
    }
    nloc = mine > 0u ? mine : 1u; nx = cnt > 0u ? cnt : 1u;
}

__device__ __forceinline__ void xcd_barrier(const XcdBarrier& b, const bool is_t0) {
    asm volatile("s_waitcnt vmcnt(0)" ::: "memory");
    __syncthreads();
    if (is_t0) {
        unsigned* bar = b.bar;
        __builtin_amdgcn_s_waitcnt(0);
        unsigned nloc = b.st[0], nx = b.st[1];
        if (nloc == 0u) { xcd_barrier_complete(bar, b.x, nloc, nx); b.st[0] = nloc; b.st[1] = nx; }
        const unsigned old = xb_add(&bar[XB_XSUB(b.x)], 1u);
        const unsigned gen = old / nloc;
        if (old + 1u == (gen + 1u) * nloc) {
            __builtin_amdgcn_fence(__ATOMIC_RELEASE, "agent");
            asm volatile("s_waitcnt vmcnt(0)" ::: "memory");
            const unsigned og = xb_add(&bar[XB_TOP], 1u);
            const unsigned tg = og / nx;
            if (og + 1u == (tg + 1u) * nx) xb_add(&bar[XB_TOPGEN], 1u);
            else XB_SPIN(xb_ld(&bar[XB_TOPGEN]) == tg, bar);
            __builtin_amdgcn_fence(__ATOMIC_ACQUIRE, "agent");
            xb_add(&bar[XB_XGEN(b.x)], 1u);
            asm volatile("s_waitcnt vmcnt(0)" ::: "memory");
        } else {
            XB_SPIN(xb_ld(&bar[XB_XGEN(b.x)]) == gen, bar);
            __builtin_amdgcn_fence(__ATOMIC_ACQUIRE, "agent");
            asm volatile("s_waitcnt vmcnt(0)" ::: "memory");
        }
    }
    __syncthreads();
}

__device__ const float ROPE_INV[128] = {1.000000000e+00f, 9.305720329e-01f, 8.659643531e-01f, 8.058421612e-01f, 7.498942614e-01f, 6.978306174e-01f, 6.493816376e-01f, 6.042963862e-01f, 5.623413324e-01f, 5.232990980e-01f, 4.869675338e-01f, 4.531583786e-01f, 4.216965139e-01f, 3.924189806e-01f, 3.651741147e-01f, 3.398208320e-01f, 3.162277639e-01f, 2.942726910e-01f, 2.738419771e-01f, 2.548296750e-01f, 2.371373773e-01f, 2.206734121e-01f, 2.053525001e-01f, 1.910953075e-01f, 1.778279394e-01f, 1.654817164e-01f, 1.539926529e-01f, 1.433012486e-01f, 1.333521307e-01f, 1.240937784e-01f, 1.154782027e-01f, 1.074607819e-01f, 1.000000015e-01f, 9.305720776e-02f, 8.659642935e-02f, 8.058421314e-02f, 7.498941571e-02f, 6.978306174e-02f, 6.493816525e-02f, 6.042964011e-02f, 5.623413250e-02f, 5.232991278e-02f, 4.869675264e-02f, 4.531583562e-02f, 4.216965288e-02f, 3.924189508e-02f, 3.651741147e-02f, 3.398208320e-02f, 3.162277490e-02f, 2.942727134e-02f, 2.738419734e-02f, 2.548296750e-02f, 2.371373773e-02f, 2.206734009e-02f, 2.053525113e-02f, 1.910952851e-02f, 1.778279431e-02f, 1.654816978e-02f, 1.539926510e-02f, 1.433012541e-02f, 1.333521493e-02f, 1.240937784e-02f, 1.154782064e-02f, 1.074607857e-02f, 9.999999776e-03f, 9.305720218e-03f, 8.659643121e-03f, 8.058422245e-03f, 7.498941850e-03f, 6.978305988e-03f, 6.493816152e-03f, 6.042963825e-03f, 5.623413250e-03f, 5.232991185e-03f, 4.869675264e-03f, 4.531583283e-03f, 4.216964822e-03f, 3.924189601e-03f, 3.651741194e-03f, 3.398208413e-03f, 3.162277630e-03f, 2.942727180e-03f, 2.738419687e-03f, 2.548296936e-03f, 2.371373586e-03f, 2.206734149e-03f, 2.053524833e-03f, 1.910952968e-03f, 1.778279431e-03f, 1.654817141e-03f, 1.539926510e-03f, 1.433012541e-03f, 1.333521446e-03f, 1.240937738e-03f, 1.154781901e-03f, 1.074607833e-03f, 1.000000047e-03f, 9.305720450e-04f, 8.659643354e-04f, 8.058421663e-04f, 7.498942432e-04f, 6.978305755e-04f, 6.493816618e-04f, 6.042963942e-04f, 5.623413017e-04f, 5.232990952e-04f, 4.869675322e-04f, 4.531583691e-04f, 4.216965172e-04f, 3.924189659e-04f, 3.651741426e-04f, 3.398208355e-04f, 3.162277571e-04f, 2.942727006e-04f, 2.738419571e-04f, 2.548296761e-04f, 2.371373703e-04f, 2.206734061e-04f, 2.053525095e-04f, 1.910952997e-04f, 1.778279402e-04f, 1.654817170e-04f, 1.539926452e-04f, 1.433012512e-04f, 1.333521504e-04f, 1.240937709e-04f, 1.154782003e-04f, 1.074607862e-04f};
#define CE_(a, b) do { const int hi_ = (a) > (b) ? (a) : (b), lo_ = (a) > (b) ? (b) : (a); (a) = hi_; (b) = lo_; } while (0)
#define SORT16(X) do { CE_(X[0], X[1]); CE_(X[2], X[3]); CE_(X[4], X[5]); CE_(X[6], X[7]); CE_(X[8], X[9]); CE_(X[10], X[11]); CE_(X[12], X[13]); CE_(X[14], X[15]); CE_(X[0], X[2]); CE_(X[1], X[3]); CE_(X[4], X[6]); CE_(X[5], X[7]); CE_(X[8], X[10]); CE_(X[9], X[11]); CE_(X[12], X[14]); CE_(X[13], X[15]); CE_(X[1], X[2]); CE_(X[5], X[6]); CE_(X[9], X[10]); CE_(X[13], X[14]); CE_(X[0], X[4]); CE_(X[1], X[5]); CE_(X[2], X[6]); CE_(X[3], X[7]); CE_(X[8], X[12]); CE_(X[9], X[13]); CE_(X[10], X[14]); CE_(X[11], X[15]); CE_(X[2], X[4]); CE_(X[3], X[5]); CE_(X[10], X[12]); CE_(X[11], X[13]); CE_(X[1], X[2]); CE_(X[3], X[4]); CE_(X[5], X[6]); CE_(X[9], X[10]); CE_(X[11], X[12]); CE_(X[13], X[14]); CE_(X[0], X[8]); CE_(X[1], X[9]); CE_(X[2], X[10]); CE_(X[3], X[11]); CE_(X[4], X[12]); CE_(X[5], X[13]); CE_(X[6], X[14]); CE_(X[7], X[15]); CE_(X[4], X[8]); CE_(X[5], X[9]); CE_(X[6], X[10]); CE_(X[7], X[11]); CE_(X[2], X[4]); CE_(X[3], X[5]); CE_(X[6], X[8]); CE_(X[7], X[9]); CE_(X[10], X[12]); CE_(X[11], X[13]); CE_(X[1], X[2]); CE_(X[3], X[4]); CE_(X[5], X[6]); CE_(X[7], X[8]); CE_(X[9], X[10]); CE_(X[11], X[12]); CE_(X[13], X[14]); } while (0)
#define BITONIC16(X) do { CE_(X[0], X[8]); CE_(X[1], X[9]); CE_(X[2], X[10]); CE_(X[3], X[11]); CE_(X[4], X[12]); CE_(X[5], X[13]); CE_(X[6], X[14]); CE_(X[7], X[15]); CE_(X[0], X[4]); CE_(X[1], X[5]); CE_(X[2], X[6]); CE_(X[3], X[7]); CE_(X[8], X[12]); CE_(X[9], X[13]); CE_(X[10], X[14]); CE_(X[11], X[15]); CE_(X[0], X[2]); CE_(X[1], X[3]); CE_(X[4], X[6]); CE_(X[5], X[7]); CE_(X[8], X[10]); CE_(X[9], X[11]); CE_(X[12], X[14]); CE_(X[13], X[15]); CE_(X[0], X[1]); CE_(X[2], X[3]); CE_(X[4], X[5]); CE_(X[6], X[7]); CE_(X[8], X[9]); CE_(X[10], X[11]); CE_(X[12], X[13]); CE_(X[14], X[15]); } while (0)
#define MERGE_PRUNE(A, B) do { A[0] = (A[0] > B[15]) ? A[0] : B[15]; A[1] = (A[1] > B[14]) ? A[1] : B[14]; A[2] = (A[2] > B[13]) ? A[2] : B[13]; A[3] = (A[3] > B[12]) ? A[3] : B[12]; A[4] = (A[4] > B[11]) ? A[4] : B[11]; A[5] = (A[5] > B[10]) ? A[5] : B[10]; A[6] = (A[6] > B[9]) ? A[6] : B[9]; A[7] = (A[7] > B[8]) ? A[7] : B[8]; A[8] = (A[8] > B[7]) ? A[8] : B[7]; A[9] = (A[9] > B[6]) ? A[9] : B[6]; A[10] = (A[10] > B[5]) ? A[10] : B[5]; A[11] = (A[11] > B[4]) ? A[11] : B[4]; A[12] = (A[12] > B[3]) ? A[12] : B[3]; A[13] = (A[13] > B[2]) ? A[13] : B[2]; A[14] = (A[14] > B[1]) ? A[14] : B[1]; A[15] = (A[15] > B[0]) ? A[15] : B[0]; BITONIC16(A); } while (0)
#ifndef PG8_SP2
#define PG8_SP2 true
#endif
#ifndef PG8_ALIGN
#define PG8_ALIGN true
#endif
constexpr int NWAVES = 8, NTHR = 512;
constexpr int D = 1024, TP = 65536, TS = 1024, T = TP + TS;
constexpr int NPH = 18;
#ifndef MK_ONE_LAUNCH
#define MK_ONE_LAUNCH 1
#endif
constexpr float LN_EPS = 1e-5f, GN_EPS = 1e-6f, ALPHA = 1.41421356237309515f;
constexpr float LOG2E = 1.4426950408889634f, LN2 = 0.6931471805599453f;
constexpr float SB_EXIT = -110.0f;
constexpr size_t O_Y = 0, O_RSP = 68157440, O_RSS = 72351744, O_KRP = 80740352, O_VRP = 147849216, O_KRS = 214958080, O_VRS = 216006656, O_END = 217055232;
constexpr size_t MiB = 1u << 20;
constexpr size_t WS_CTL = 0, CTL_ZERO_BYTES = 1 * MiB;
constexpr size_t WS_WIN = 1 * MiB, WS_WRO = 13 * MiB, WS_WQKV = 17 * MiB, WS_WSO = 23 * MiB, WS_WPQ = 25 * MiB, WS_KEYS = 33 * MiB, WS_COS = 34 * MiB, WS_SIN = 38 * MiB;
constexpr size_t WS_PU = 42 * MiB, WS_PV = 74 * MiB, WS_RS = 106 * MiB  , WS_XB = 170 * MiB, WS_M1 = 300 * MiB, WS_VG = 430 * MiB, WS_IDX = 950 * MiB, WS_GATE = 983 * MiB, WS_END = 1016 * MiB;
constexpr int CW_BAR = 4096;
#ifndef QUANT_IN_RET
#define QUANT_IN_RET 0
#endif
constexpr int LN_TAIL_ROWS0 = 92, LN_TAIL_ROWS1 = 60;
constexpr int RING_BYTES = 155648;
constexpr int LDSCTL_OFF = RING_BYTES, MISC_OFF = LDSCTL_OFF + 320;
constexpr int LDS_BYTES = 163840;

typedef unsigned short bf16;
typedef unsigned v4u __attribute__((ext_vector_type(4)));
typedef unsigned v2u __attribute__((ext_vector_type(2)));
typedef float f32x4 __attribute__((ext_vector_type(4)));
typedef float f32x2 __attribute__((ext_vector_type(2)));
typedef float f32x16 __attribute__((ext_vector_type(16)));
typedef short bf16x8 __attribute__((ext_vector_type(8)));
typedef short s16x4 __attribute__((ext_vector_type(4)));
typedef GAS unsigned gu32;
#define RLX_AGENT __ATOMIC_RELAXED, __HIP_MEMORY_SCOPE_AGENT
#define LDS_WAIT() asm volatile("s_waitcnt lgkmcnt(0)" ::: "memory")
#define VM_WAIT() asm volatile("s_waitcnt vmcnt(0)" ::: "memory")

struct Frame {
    LAS unsigned char* lds;
    volatile LAS unsigned* MISC;
    gu32* ctl;
    int wave, G;
    const float* in[16]; float* out; unsigned char* ws;
};

typedef __bf16 bf16x2_t __attribute__((ext_vector_type(2)));
__device__ __forceinline__ int lane_id() { return (int)__builtin_amdgcn_mbcnt_hi(~0u, __builtin_amdgcn_mbcnt_lo(~0u, 0u)); }
__device__ __forceinline__ unsigned pkbf(float lo, float hi) { const f32x2 v = {lo, hi}; const bf16x2_t b = __builtin_convertvector(v, bf16x2_t); return __builtin_bit_cast(unsigned, b); }
__device__ __forceinline__ float bflo(unsigned u) { return __uint_as_float(u << 16); }
__device__ __forceinline__ float bfhi(unsigned u) { return __uint_as_float(u & 0xffff0000u); }
__device__ __forceinline__ float wave_sum(float v) {
#pragma unroll
    for (int o = 1; o < 64; o <<= 1) v += __shfl_xor(v, o);
    return v;
}
__device__ __forceinline__ f32x4 mfma16(bf16x8 a, bf16x8 b, f32x4 c) { return __builtin_amdgcn_mfma_f32_16x16x32_bf16(a, b, c, 0, 0, 0); }
__device__ __forceinline__ f32x16 mfma32(bf16x8 a, bf16x8 b, f32x16 c) { return __builtin_amdgcn_mfma_f32_32x32x16_bf16(a, b, c, 0, 0, 0); }
typedef short v4i16_t __attribute__((ext_vector_type(4)));
__device__ __forceinline__ s16x4 trrd(LAS const unsigned char* p) { return __builtin_bit_cast(s16x4, __builtin_amdgcn_ds_read_tr16_b64_v4i16((LAS v4i16_t*)p)); }
__device__ __forceinline__ bf16x8 cat8(s16x4 lo, s16x4 hi) { return (bf16x8){lo[0], lo[1], lo[2], lo[3], hi[0], hi[1], hi[2], hi[3]}; }
__device__ __forceinline__ v4u ldg16(const void* ubase, unsigned voff) { return *(const GAS v4u*)((const GAS char*)ubase + voff); }
__device__ __forceinline__ int crow(int r, int hi) { return (r & 3) + 8 * (r >> 2) + 4 * hi; }

#define CW_TAIL(k) (8192 + 64 * (k))
namespace pg8 {
struct TailOrder {
    int nN, G, c;
    __device__ __forceinline__ bool next(int i, Unit& u) const { const int L = i * G + c; if (L >= 4 * nN) return false; u.pm = TP / BM + (L & 3); u.pn = L >> 2; return true; }
    __device__ __forceinline__ void a_ready(const Unit&) const {}
    __device__ __forceinline__ void done(const Unit&) const {}
};
}
__device__ __forceinline__ int tail_wgs(const Frame& F, int nN) { return 4 * nN < F.G ? 4 * nN : F.G; }
__device__ __forceinline__ void tail_publish(Frame& F, int k) {
    asm volatile("s_waitcnt vmcnt(0)" ::: "memory");
    __syncthreads();
    if (F.wave == 0 && lane_id() == 0) {
        __builtin_amdgcn_fence(__ATOMIC_RELEASE, "agent");
        asm volatile("s_waitcnt vmcnt(0)" ::: "memory");
        (void)xb_add((unsigned*)(F.ctl + CW_TAIL(k)), 1u);
    }
}
__device__ __forceinline__ void tail_wait(Frame& F, int k, int n) {
    if (F.wave == 0 && lane_id() == 0) {
        unsigned* bar = (unsigned*)(F.ctl + CW_BAR);
        XB_SPIN(xb_ld((unsigned*)(F.ctl + CW_TAIL(k))) < (unsigned)n, bar);
        __builtin_amdgcn_fence(__ATOMIC_ACQUIRE, "agent");
        asm volatile("s_waitcnt vmcnt(0)" ::: "memory");
    }
    __syncthreads();
}

__device__ __forceinline__ void tail_wait_wave(Frame& F, int k, int n) {
    unsigned* bar = (unsigned*)(F.ctl + CW_BAR); unsigned* p = (unsigned*)(F.ctl + CW_TAIL(k));
    unsigned sp = 0;
    while ((unsigned)__builtin_amdgcn_readfirstlane((int)xb_ld(p)) < (unsigned)n) {
        __builtin_amdgcn_s_sleep(2);
        if ((++sp & 255u) == 0u) { if (__builtin_amdgcn_readfirstlane((int)xb_ld(&bar[XB_TMO])) != 0) break; if (sp > XB_SPIN_CAP) { if (lane_id() == 0) atomicAdd(&bar[XB_TMO], 1u); break; } }
    }
    __builtin_amdgcn_fence(__ATOMIC_ACQUIRE, "agent");
    asm volatile("s_waitcnt vmcnt(0)" ::: "memory");
}

__device__ __forceinline__ void p0_transpose_item(const float* W, int K, int N, bf16* WT, LAS float* scr, int item, int lane) {
    const int nblk = N / 32, kb = item / nblk, nb = item % nblk, k0 = 64 * kb, n0 = 32 * nb;
#pragma unroll 8
    for (int i = 0; i < 32; ++i) { const int kk = 2 * i + (lane >> 5); scr[kk * 33 + (lane & 31)] = W[(size_t)(k0 + kk) * N + n0 + (lane & 31)]; }
    LDS_WAIT(); asm volatile("" ::: "memory");
    const int c = lane & 7;
#pragma unroll
    for (int j = 0; j < 4; ++j) { const int n = (lane >> 3) + 8 * j; const LAS float* s = scr + (8 * c) * 33 + n;
        v4u o; o.x = pkbf(s[0 * 33], s[1 * 33]); o.y = pkbf(s[2 * 33], s[3 * 33]); o.z = pkbf(s[4 * 33], s[5 * 33]); o.w = pkbf(s[6 * 33], s[7 * 33]);
        *(GAS v4u*)(WT + (size_t)(n0 + n) * K + k0 + 8 * c) = o; }
    LDS_WAIT(); asm volatile("" ::: "memory");
}
__device__ __forceinline__ void cvt_bf16_span(const float* src, bf16* dst, size_t n8, size_t gt, size_t ngt) {
    for (size_t i = gt; i < n8; i += ngt) { const f32x4 a = *(const GAS f32x4*)(src + i * 8), b = *(const GAS f32x4*)(src + i * 8 + 4);
        v4u o; o.x = pkbf(a[0], a[1]); o.y = pkbf(a[2], a[3]); o.z = pkbf(b[0], b[1]); o.w = pkbf(b[2], b[3]); *(GAS v4u*)(dst + i * 8) = o; }
}
__device__ __forceinline__ float dpp_max0(float v, const int ctrl_sel) {
    int t;
    switch (ctrl_sel) {
        case 0: t = __builtin_amdgcn_update_dpp(0, __float_as_int(v), 0x111, 0xf, 0xf, false); break;
        case 1: t = __builtin_amdgcn_update_dpp(0, __float_as_int(v), 0x112, 0xf, 0xf, false); break;
        case 2: t = __builtin_amdgcn_update_dpp(0, __float_as_int(v), 0x114, 0xf, 0xf, false); break;
        case 3: t = __builtin_amdgcn_update_dpp(0, __float_as_int(v), 0x118, 0xf, 0xf, false); break;
        case 4: t = __builtin_amdgcn_update_dpp(0, __float_as_int(v), 0x142, 0xa, 0xf, false); break;
        default: t = __builtin_amdgcn_update_dpp(0, __float_as_int(v), 0x143, 0xc, 0xf, false); break;
    }
    return __builtin_fmaxf(v, __int_as_float(t));
}
__device__ __forceinline__ float dpp_add0(float v, const int ctrl_sel) {
    int t;
    switch (ctrl_sel) {
        case 0: t = __builtin_amdgcn_update_dpp(0, __float_as_int(v), 0x111, 0xf, 0xf, false); break;
        case 1: t = __builtin_amdgcn_update_dpp(0, __float_as_int(v), 0x112, 0xf, 0xf, false); break;
        case 2: t = __builtin_amdgcn_update_dpp(0, __float_as_int(v), 0x114, 0xf, 0xf, false); break;
        case 3: t = __builtin_amdgcn_update_dpp(0, __float_as_int(v), 0x118, 0xf, 0xf, false); break;
        case 4: t = __builtin_amdgcn_update_dpp(0, __float_as_int(v), 0x142, 0xa, 0xf, false); break;
        default: t = __builtin_amdgcn_update_dpp(0, __float_as_int(v), 0x143, 0xc, 0xf, false); break;
    }
    return v + __int_as_float(t);
}
__device__ __forceinline__ float wave_sum_dpp(float v) {
    v = dpp_add0(v, 0); v = dpp_add0(v, 1); v = dpp_add0(v, 2); v = dpp_add0(v, 3); v = dpp_add0(v, 4); v = dpp_add0(v, 5);
    return __int_as_float(__builtin_amdgcn_readlane(__float_as_int(v), 63));
}
__device__ __forceinline__ float wave_max_nonneg(float m) {
    m = dpp_max0(m, 0); m = dpp_max0(m, 1); m = dpp_max0(m, 2); m = dpp_max0(m, 3); m = dpp_max0(m, 4); m = dpp_max0(m, 5);
    return __int_as_float(__builtin_amdgcn_readlane(__float_as_int(m), 63));
}
__device__ __forceinline__ void quant_row(const f32x4 (&a)[4], unsigned char* dst, float* rs, int lane) {
    float m = 0.f;
#pragma unroll
    for (int i = 0; i < 4; ++i) m = __builtin_fmaxf(m, __builtin_fmaxf(__builtin_fmaxf(__builtin_fabsf(a[i][0]), __builtin_fabsf(a[i][1])), __builtin_fmaxf(__builtin_fabsf(a[i][2]), __builtin_fabsf(a[i][3]))));
    m = wave_max_nonneg(m);
    const float scale = (m > 1e-30f) ? 6.0f / m : 1.0f, rscale = (m > 1e-30f) ? m * (1.0f / 6.0f) : 1.0f;
    v2u w;
#pragma unroll
    for (int d = 0; d < 2; ++d) { unsigned q = 0u;
        q = __builtin_amdgcn_cvt_scalef32_pk_fp4_f32(q, a[2 * d][0] * scale, a[2 * d][1] * scale, 1.0f, 0);
        q = __builtin_amdgcn_cvt_scalef32_pk_fp4_f32(q, a[2 * d][2] * scale, a[2 * d][3] * scale, 1.0f, 1);
        q = __builtin_amdgcn_cvt_scalef32_pk_fp4_f32(q, a[2 * d + 1][0] * scale, a[2 * d + 1][1] * scale, 1.0f, 2);
        q = __builtin_amdgcn_cvt_scalef32_pk_fp4_f32(q, a[2 * d + 1][2] * scale, a[2 * d + 1][3] * scale, 1.0f, 3);
        w[d] = q; }
    *(GAS v2u*)(dst + 8 * lane) = w;
    if (lane == 0) *rs = rscale;
}
__device__ __forceinline__ void quant_row_c(const f32x4 (&a)[4], unsigned char* dst, float* rs, int lane) {
    float m = 0.f;
#pragma unroll
    for (int i = 0; i < 4; ++i) m = __builtin_fmaxf(m, __builtin_fmaxf(__builtin_fmaxf(__builtin_fabsf(a[i][0]), __builtin_fabsf(a[i][1])), __builtin_fmaxf(__builtin_fabsf(a[i][2]), __builtin_fabsf(a[i][3]))));
    m = wave_max_nonneg(m);
    const float scale = (m > 1e-30f) ? 6.0f / m : 1.0f, rscale = (m > 1e-30f) ? m * (1.0f / 6.0f) : 1.0f;
#pragma unroll
    for (int i = 0; i < 4; ++i) { unsigned q = 0u;
        q = __builtin_amdgcn_cvt_scalef32_pk_fp4_f32(q, a[i][0] * scale, a[i][1] * scale, 1.0f, 0);
        q = __builtin_amdgcn_cvt_scalef32_pk_fp4_f32(q, a[i][2] * scale, a[i][3] * scale, 1.0f, 1);
        *(GAS unsigned short*)(dst + 128 * i + 2 * lane) = (unsigned short)(q & 0xffffu); }
    if (lane == 0) *rs = rscale;
}
__device__ __forceinline__ const float* qrow_src(const Frame& F, int R) { return ((R >> 15) ? F.in[13] : F.in[12]) + (size_t)(R & 32767) * 1024; }
__device__ __forceinline__ unsigned char* qrow_dst(const Frame& F, int R) { return F.ws + ((R >> 15) ? WS_PV : WS_PU) + (size_t)(R & 32767) * 512; }
__device__ __forceinline__ float* qrow_rs(const Frame& F, int R) { return (float*)(F.ws + WS_RS) + (size_t)((R >> 14) & 1) * 32768 + (size_t)(R & 16383) * 2 + (R >> 15); }
__device__ __forceinline__ void sincos_d(double a, double& s, double& c) {
    const double kq = __builtin_rint(a * 0.63661977236758134308);
    const double y = (a - kq * 1.57079632673412561417e+00) - kq * 6.07710050650619224932e-11;
    const double y2 = y * y;
    const double sp = y * (1.0 + y2 * (-1.0 / 6 + y2 * (1.0 / 120 + y2 * (-1.0 / 5040 + y2 * (1.0 / 362880 + y2 * (-1.0 / 39916800 + y2 * (1.0 / 6227020800.0 + y2 * (-1.0 / 1307674368000.0))))))));
    const double cp = 1.0 + y2 * (-0.5 + y2 * (1.0 / 24 + y2 * (-1.0 / 720 + y2 * (1.0 / 40320 + y2 * (-1.0 / 3628800 + y2 * (1.0 / 479001600 + y2 * (-1.0 / 87178291200.0 + y2 * (1.0 / 20922789888000.0))))))));
    const int k = (int)kq & 3;
    s = (k == 0) ? sp : (k == 1) ? cp : (k == 2) ? -sp : -cp;
    c = (k == 0) ? cp : (k == 1) ? -sp : (k == 2) ? -cp : sp;
}
__device__ __forceinline__ void p0_prologue(Frame& F) {
    LAS float* scr = (LAS float*)(F.lds + F.wave * 16384);
    const int gw = blockIdx.x * NWAVES + F.wave, NGW = F.G * NWAVES;
    const float* ret_w_in = F.in[5]; const float* ret_w_o = F.in[6]; const float* sb_w_qkv = F.in[7]; const float* sb_w_o = F.in[8]; const float* peer_w_q = F.in[9];
    constexpr int I_IN = (1024 / 64) * (6144 / 32), I_RO = (2048 / 64) * (1024 / 32), I_QKV = (1024 / 64) * (3072 / 32), I_SO = (1024 / 64) * (1024 / 32), I_PQ = (1024 / 64) * (2048 / 32);
    constexpr int NITEMS = I_IN + I_RO + I_QKV + I_SO + 2 * I_PQ;
    for (int it = gw; it < NITEMS; it += NGW) {
        int r = it;
        if (r < I_IN) { p0_transpose_item(ret_w_in, 1024, 6144, (bf16*)(F.ws + WS_WIN), scr, r, lane_id()); continue; } r -= I_IN;
        if (r < I_RO) { p0_transpose_item(ret_w_o, 2048, 1024, (bf16*)(F.ws + WS_WRO), scr, r, lane_id()); continue; } r -= I_RO;
        if (r < I_QKV) { p0_transpose_item(sb_w_qkv, 1024, 3072, (bf16*)(F.ws + WS_WQKV), scr, r, lane_id()); continue; } r -= I_QKV;
        if (r < I_SO) { p0_transpose_item(sb_w_o, 1024, 1024, (bf16*)(F.ws + WS_WSO), scr, r, lane_id()); continue; } r -= I_SO;
        if (r < I_PQ) { p0_transpose_item(peer_w_q, 1024, 2048, (bf16*)(F.ws + WS_WPQ), scr, r, lane_id()); continue; } r -= I_PQ;
        p0_transpose_item(peer_w_q + (size_t)1024 * 2048, 1024, 2048, (bf16*)(F.ws + WS_WPQ + 4 * MiB), scr, r, lane_id());
    }
    const size_t gt = (size_t)blockIdx.x * NTHR + (F.wave * 64 + lane_id()), ngt = (size_t)F.G * NTHR;
    cvt_bf16_span(F.in[10], (bf16*)(F.ws + WS_KEYS), 131072 / 8, gt, ngt);
    cvt_bf16_span(F.in[11], (bf16*)(F.ws + WS_KEYS + 256 * 1024), 131072 / 8, gt, ngt);
    cvt_bf16_span(F.in[10] + 131072, (bf16*)(F.ws + WS_KEYS + 512 * 1024), 131072 / 8, gt, ngt);
    cvt_bf16_span(F.in[11] + 131072, (bf16*)(F.ws + WS_KEYS + 768 * 1024), 131072 / 8, gt, ngt);
#if !QUANT_IN_RET
    for (int R = gw; R < 65536; R += NGW) { f32x4 qa[4]; const float* qs = qrow_src(F, R) + 4 * lane_id();
#pragma unroll
        for (int i = 0; i < 4; ++i) qa[i] = __builtin_nontemporal_load((const GAS f32x4*)(qs + 256 * i));
        quant_row_c(qa, qrow_dst(F, R), qrow_rs(F, R), lane_id()); }
#endif
    cvt_bf16_span(F.in[0], (bf16*)(F.ws + WS_XB), (size_t)TP * D / 8, gt, ngt);
    cvt_bf16_span(F.in[1], (bf16*)(F.ws + WS_XB) + (size_t)TP * D, (size_t)TS * D / 8, gt, ngt);
    float* cosT = (float*)(F.ws + WS_COS); float* sinT = (float*)(F.ws + WS_SIN);
    for (size_t i = gt; i < (size_t)8192 * 128; i += ngt) {
        const int pos = (int)(i >> 7), fi = (int)(i & 127);
        const float inv = ROPE_INV[fi];
        const float ang = (float)pos * inv;
        double s, c; sincos_d((double)ang, s, c);
        cosT[i] = (float)c; sinT[i] = (float)s;
    }
}

__device__ __forceinline__ void ret_phase(Frame& F) {
    constexpr int QS = 0, KS = 33792, SS = 67584, VS = 101376, AS = 110592;
    LAS unsigned char* lds = F.lds;
    const int lane = lane_id(), tid = F.wave * 64 + lane, w = F.wave, fr = lane & 15, q4 = lane >> 4;
    const bf16* QK = (const bf16*)(F.out + O_KRP);
    bf16* VG = (bf16*)(F.ws + WS_VG);
    const int RPW = (65536 + F.G - 1) / F.G, qr0 = (int)blockIdx.x * RPW, qr1 = (qr0 + RPW < 65536) ? qr0 + RPW : 65536;
    const int RPC = (RPW + 127) / 128 < NWAVES ? (RPW + 127) / 128 : NWAVES;
    int qnext = qr0;
    for (int item = blockIdx.x; item < 768; item += F.G) {
        int bh, es, nchunk; size_t row0; const float* S0; float* Sout;
        if (item < 256) { bh = item & 31; es = item >> 5; nchunk = 128; row0 = (size_t)(bh >> 2) * 8192; S0 = nullptr; Sout = F.out + O_RSP + (size_t)bh * 131072; }
        else { const int it = item - 256; bh = it & 63; es = it >> 6; nchunk = 1; row0 = 65536 + (size_t)(bh >> 2) * 64; S0 = F.in[2] + (size_t)bh * 131072; Sout = F.out + O_RSS + (size_t)bh * 131072; }
        const int h = bh & 3;
        const float l2g = __builtin_amdgcn_logf(1.0f - __builtin_amdgcn_exp2f(-5.0f - (float)h));
        const float gam = __builtin_amdgcn_exp2f(l2g), gam64 = __builtin_amdgcn_exp2f(64.0f * l2g), rgam = __builtin_amdgcn_exp2f(-l2g);
        f32x4 S[2][4];
#pragma unroll
        for (int dl = 0; dl < 2; ++dl)
#pragma unroll
            for (int et = 0; et < 4; ++et) {
                f32x4 v = (f32x4){0.f, 0.f, 0.f, 0.f};
                if (S0) {
#pragma unroll
                    for (int j = 0; j < 4; ++j) v[j] = gam * S0[(size_t)(32 * w + 16 * dl + 4 * q4 + j) * 512 + es * 64 + et * 16 + fr];
                }
                S[dl][et] = v;
                v2u pk; pk.x = pkbf(v[0], v[1]); pk.y = pkbf(v[2], v[3]);
                *(LAS v2u*)(lds + SS + (et * 16 + fr) * 528 + (32 * w + 16 * dl + 4 * q4) * 2) = pk;
            }
        v4u pqA[4], pkA[4], pvA;
        const bf16* qbase = QK + row0 * 2048 + h * 256;
        bf16* vbase = VG + row0 * 4096 + h * 512 + es * 64;
#define RET_LOAD(c) do { _Pragma("unroll") for (int i_ = 0; i_ < 4; ++i_) { const int p_ = tid + 512 * i_; const bf16* s_ = qbase + (size_t)((c) * 64 + (p_ >> 5)) * 2048 + (p_ & 31) * 8; \
            pq[i_] = *(const GAS v4u*)s_; pk4[i_] = *(const GAS v4u*)(s_ + 1024); } \
            pv = *(const GAS v4u*)(vbase + (size_t)((c) * 64 + (tid >> 3)) * 4096 + (tid & 7) * 8); } while (0)
        volatile LAS int* afl = (volatile LAS int*)(lds + 120064);
        if (lane == 0) afl[w] = 0;
        { v4u (&pq)[4] = pqA; v4u (&pk4)[4] = pkA; v4u& pv = pvA; RET_LOAD(0); }
        auto chunk = [&](const int c, v4u (&pq)[4], v4u (&pk4)[4], v4u& pv) __attribute__((always_inline)) {
            __syncthreads();
            if (c > 0) {
#pragma unroll
                for (int dl = 0; dl < 2; ++dl)
#pragma unroll
                    for (int et = 0; et < 4; ++et) { v2u pk; pk.x = pkbf(S[dl][et][0], S[dl][et][1]); pk.y = pkbf(S[dl][et][2], S[dl][et][3]);
                        *(LAS v2u*)(lds + SS + (et * 16 + fr) * 528 + (32 * w + 16 * dl + 4 * q4) * 2) = pk; } }
#pragma unroll
            for (int i = 0; i < 4; ++i) { const int p = tid + 512 * i; const int off = (p >> 5) * 528 + (p & 31) * 16;
                *(LAS v4u*)(lds + QS + off) = pq[i]; *(LAS v4u*)(lds + KS + off) = pk4[i]; }
            *(LAS v4u*)(lds + VS + (tid >> 3) * 144 + (tid & 7) * 16) = pv;
            if (c + 1 < nchunk) RET_LOAD(c + 1);
            f32x4 qa[4]; int qR = -1;
            if (QUANT_IN_RET && nchunk > 1) { const int jw = (w - RPC * c) & 7; if (jw < RPC && qnext + jw < qr1) qR = qnext + jw; qnext += RPC; }
            if (qR >= 0) { const float* qs = qrow_src(F, qR) + 16 * lane;
#pragma unroll
                for (int i = 0; i < 4; ++i) qa[i] = __builtin_nontemporal_load((const f32x4*)(qs + 4 * i)); }
            __syncthreads();
            const int nt4 = w >> 1;
            bf16x8 qf[8];
#pragma unroll
            for (int ks = 0; ks < 8; ++ks) qf[ks] = *(const LAS bf16x8*)(lds + QS + (nt4 * 16 + fr) * 528 + (32 * ks + 8 * q4) * 2);
#pragma unroll
            for (int tt = 0; tt < 2; ++tt) { const int mt = 2 * (w & 1) + tt;
                f32x4 at = (f32x4){0.f, 0.f, 0.f, 0.f};
                if (mt <= nt4) {
#pragma unroll
                    for (int ks = 0; ks < 8; ++ks) { const bf16x8 ka = *(const LAS bf16x8*)(lds + KS + (mt * 16 + fr) * 528 + (32 * ks + 8 * q4) * 2); at = mfma16(ka, qf[ks], at); }
                }
                const int n = nt4 * 16 + fr; float v[4];
#pragma unroll
                for (int j = 0; j < 4; ++j) { const int m = mt * 16 + 4 * q4 + j; v[j] = (n >= m) ? at[j] : 0.f; }
                v2u pk; pk.x = pkbf(v[0], v[1]); pk.y = pkbf(v[2], v[3]);
                *(LAS v2u*)(lds + AS + n * 144 + (mt * 16 + 4 * q4) * 2) = pk; }
            if (lane == 0) afl[w] = c + 1;
            f32x4 o[2] = {(f32x4){0.f, 0.f, 0.f, 0.f}, (f32x4){0.f, 0.f, 0.f, 0.f}};
#pragma unroll
            for (int ks = 0; ks < 8; ++ks) {
#pragma unroll
                for (int tt = 0; tt < 2; ++tt) { const int et = 2 * (w & 1) + tt;
                    const bf16x8 sb = *(const LAS bf16x8*)(lds + SS + (et * 16 + fr) * 528 + (32 * ks + 8 * q4) * 2);
                    o[tt] = mfma16(sb, qf[ks], o[tt]); }
            }
            for (int sp_ = 0; afl[w ^ 1] < c + 1 && sp_ < (1 << 22); ++sp_) { }
#pragma unroll
            for (int ks = 0; ks < 2; ++ks) {
                if (ks == 1 && nt4 < 2) continue;
                const bf16x8 aa = *(const LAS bf16x8*)(lds + AS + (nt4 * 16 + fr) * 144 + (32 * ks + 8 * q4) * 2);
                const int m0 = 32 * ks + 8 * q4 + (fr >> 2);
#pragma unroll
                for (int tt = 0; tt < 2; ++tt) { const int et = 2 * (w & 1) + tt;
                    const s16x4 lo = trrd(lds + VS + m0 * 144 + et * 32 + 8 * (fr & 3)), hi = trrd(lds + VS + (m0 + 4) * 144 + et * 32 + 8 * (fr & 3));
                    o[tt] = mfma16(cat8(lo, hi), aa, o[tt]); }
            }
#pragma unroll
            for (int tt = 0; tt < 2; ++tt) { const int e0 = (2 * (w & 1) + tt) * 16 + 4 * q4, n = nt4 * 16 + fr;
                v2u pk; pk.x = pkbf(o[tt][0], o[tt][1]); pk.y = pkbf(o[tt][2], o[tt][3]);
                *(GAS v2u*)(vbase + (size_t)(c * 64 + n) * 4096 + e0) = pk; }
#pragma unroll
            for (int ks = 0; ks < 2; ++ks) {
                const int m0 = 32 * ks + 8 * q4 + (fr >> 2);
                bf16x8 ka[2], vb[4];
#pragma unroll
                for (int dl = 0; dl < 2; ++dl) { const int dt = 2 * w + dl;
                    ka[dl] = cat8(trrd(lds + KS + m0 * 528 + dt * 32 + 8 * (fr & 3)), trrd(lds + KS + (m0 + 4) * 528 + dt * 32 + 8 * (fr & 3))); }
#pragma unroll
                for (int et = 0; et < 4; ++et) vb[et] = cat8(trrd(lds + VS + m0 * 144 + et * 32 + 8 * (fr & 3)), trrd(lds + VS + (m0 + 4) * 144 + et * 32 + 8 * (fr & 3)));
#pragma unroll
                for (int dl = 0; dl < 2; ++dl)
#pragma unroll
                    for (int et = 0; et < 4; ++et) S[dl][et] = mfma16(ka[dl], vb[et], S[dl][et]);
            }
#pragma unroll
            for (int dl = 0; dl < 2; ++dl)
#pragma unroll
                for (int et = 0; et < 4; ++et) S[dl][et] *= gam64;
            if (qR >= 0) quant_row(qa, qrow_dst(F, qR), qrow_rs(F, qR), lane);
        };
        for (int c = 0; c < nchunk; ++c) chunk(c, pqA, pkA, pvA);
#undef RET_LOAD
#pragma unroll
        for (int dl = 0; dl < 2; ++dl)
#pragma unroll
            for (int et = 0; et < 4; ++et)
#pragma unroll
                for (int j = 0; j < 4; ++j) Sout[(size_t)(32 * w + 16 * dl + 4 * q4 + j) * 512 + es * 64 + et * 16 + fr] = S[dl][et][j] * rgam;
        __syncthreads();
    }
    if (qnext < qr0) qnext = qr0;
    if (QUANT_IN_RET) for (int R = qnext + w; R < qr1; R += NWAVES) { f32x4 qa[4]; const float* qs = qrow_src(F, R) + 16 * lane;
#pragma unroll
        for (int i = 0; i < 4; ++i) qa[i] = *(const GAS f32x4*)(qs + 4 * i);
        quant_row(qa, qrow_dst(F, R), qrow_rs(F, R), lane); }
}

__device__ __forceinline__ void gn_gate_phase(Frame& F) {
    bf16* VG = (bf16*)(F.ws + WS_VG);
    const int gw = blockIdx.x * NWAVES + F.wave, NGW = F.G * NWAVES, lane = lane_id();
    for (int t0 = gw; t0 < T; t0 += 2 * NGW) {
        const bool two = t0 + NGW < T;
        v4u ov[2][4], gv[2][4];
#pragma unroll
        for (int u = 0; u < 2; ++u) if (u == 0 || two) { const bf16* orow = VG + (size_t)(t0 + u * NGW) * 4096 + lane * 8;
#pragma unroll
            for (int i = 0; i < 4; ++i) { ov[u][i] = __builtin_nontemporal_load((const v4u*)(orow + 512 * i)); gv[u][i] = __builtin_nontemporal_load((const v4u*)(orow + 2048 + 512 * i)); } }
#pragma unroll
        for (int u = 0; u < 2; ++u) if (u == 0 || two) {
            bf16* orow = VG + (size_t)(t0 + u * NGW) * 4096 + lane * 8;
#pragma unroll
            for (int i = 0; i < 4; ++i) {
                float o[8];
#pragma unroll
                for (int k = 0; k < 4; ++k) { o[2 * k] = bflo(ov[u][i][k]); o[2 * k + 1] = bfhi(ov[u][i][k]); }
                float s = ((o[0] + o[1]) + (o[2] + o[3])) + ((o[4] + o[5]) + (o[6] + o[7]));
                const float mu = wave_sum_dpp(s) * (1.0f / 512.0f);
                float q = 0.f;
#pragma unroll
                for (int k = 0; k < 8; ++k) { o[k] -= mu; q += o[k] * o[k]; }
                const float rstd = __builtin_amdgcn_rsqf(wave_sum_dpp(q) * (1.0f / 512.0f) + GN_EPS);
                v4u w;
#pragma unroll
                for (int k = 0; k < 4; ++k) {
                    const float g0 = bflo(gv[u][i][k]), g1 = bfhi(gv[u][i][k]);
                    const float s0 = g0 * __builtin_amdgcn_rcpf(1.0f + __builtin_amdgcn_exp2f(-g0 * LOG2E)), s1 = g1 * __builtin_amdgcn_rcpf(1.0f + __builtin_amdgcn_exp2f(-g1 * LOG2E));
                    w[k] = pkbf(s0 * o[2 * k] * rstd, s1 * o[2 * k + 1] * rstd);
                }
                *(GAS v4u*)(orow + 512 * i) = w;
            }
        }
    }
}

__device__ __forceinline__ void ln_rows2(Frame& F, int layer, const f32x4 (&gg)[4], const f32x4 (&bb)[4], int ta, int tb, bool two, int lane) {
    const bf16* M1 = (const bf16*)(F.ws + WS_M1); bf16* XB = (bf16*)(F.ws + WS_XB);
    f32x4 xv[2][4]; v2u mv[2][4];
#pragma unroll
    for (int u = 0; u < 2; ++u) if (u == 0 || two) { const int t = u ? tb : ta;
        if (layer == 0) { const float* xrow = (t < TP ? F.in[0] + (size_t)t * D : F.in[1] + (size_t)(t - TP) * D);
#pragma unroll
            for (int j = 0; j < 4; ++j) xv[u][j] = __builtin_nontemporal_load((const f32x4*)(xrow + 4 * lane + 256 * j)); }
        else {
#pragma unroll
            for (int j = 0; j < 4; ++j) { const v2u xb = *(const GAS v2u*)(XB + (size_t)t * D + 4 * lane + 256 * j); xv[u][j] = (f32x4){bflo(xb.x), bfhi(xb.x), bflo(xb.y), bfhi(xb.y)}; } }
#pragma unroll
        for (int j = 0; j < 4; ++j) mv[u][j] = __builtin_nontemporal_load((const v2u*)(M1 + (size_t)t * D + 4 * lane + 256 * j)); }
#pragma unroll
    for (int u = 0; u < 2; ++u) if (u == 0 || two) { const int t = u ? tb : ta;
        f32x4 v[4]; float s = 0.f;
#pragma unroll
        for (int j = 0; j < 4; ++j) { v[j] = xv[u][j] * ALPHA + (f32x4){bflo(mv[u][j].x), bfhi(mv[u][j].x), bflo(mv[u][j].y), bfhi(mv[u][j].y)}; s += (v[j][0] + v[j][1]) + (v[j][2] + v[j][3]); }
        const float mean = wave_sum_dpp(s) * (1.0f / D); float s2 = 0.f;
#pragma unroll
        for (int j = 0; j < 4; ++j) { v[j] = v[j] - mean; s2 += (v[j][0] * v[j][0] + v[j][1] * v[j][1]) + (v[j][2] * v[j][2] + v[j][3] * v[j][3]); }
        const float rstd = __builtin_amdgcn_rsqf(wave_sum_dpp(s2) * (1.0f / D) + LN_EPS);
#pragma unroll
        for (int j = 0; j < 4; ++j) { const f32x4 y = v[j] * rstd * gg[j] + bb[j];
            v2u o; o.x = pkbf(y[0], y[1]); o.y = pkbf(y[2], y[3]); *(GAS v2u*)(XB + (size_t)t * D + 4 * lane + 256 * j) = o; }
    }
}
__device__ __forceinline__ void ln_phase(Frame& F, int layer, int seam, int drows) {
    const float* gam = F.in[14] + (size_t)(layer * 2 + 0) * D; const float* bet = F.in[15] + (size_t)(layer * 2 + 0) * D;
    const int lane = lane_id(), c = (int)blockIdx.x;
    f32x4 gg[4], bb[4];
#pragma unroll
    for (int j = 0; j < 4; ++j) { gg[j] = *(const GAS f32x4*)(gam + 4 * lane + 256 * j); bb[j] = *(const GAS f32x4*)(bet + 4 * lane + 256 * j); }
    const int ntw = tail_wgs(F, 4);
    const int d = (F.G >= 64) ? drows : 0;
    const int qn = (TP + ntw * d + F.G - 1) / F.G, qt = qn - d;
    int r0 = (c < ntw) ? c * qt : ntw * qt + (c - ntw) * qn, r1 = r0 + ((c < ntw) ? qt : qn);
    r0 = r0 < TP ? r0 : TP; r1 = r1 < TP ? r1 : TP;
    for (int t = r0 + F.wave; t < r1; t += 2 * NWAVES) ln_rows2(F, layer, gg, bb, t, t + NWAVES, t + NWAVES < r1, lane);
    tail_wait(F, seam, ntw);
    for (int t = TP + F.wave * F.G + c; t < T; t += NWAVES * F.G) ln_rows2(F, layer, gg, bb, t, t, false, lane);
}

__device__ __forceinline__ int f2key(float s) { const int u = __float_as_int(s); return u ^ ((u >> 31) & 0x7fffffff); }
__device__ __forceinline__ float key2f(int k) { return __int_as_float(k ^ ((k >> 31) & 0x7fffffff)); }
__device__ __forceinline__ int med3i(int a, int b, int c) { int r; asm("v_med3_i32 %0, %1, %2, %3" : "=v"(r) : "v"(a), "v"(b), "v"(c)); return r; }
__device__ __forceinline__ int maxi(int a, int b) { return a > b ? a : b; }
#define KEY_NEG_INF ((int)0x80000000)
#define TOPK_INSERT(L, x) do { _Pragma("unroll") for (int i_ = 15; i_ >= 1; --i_) L[i_] = med3i(L[i_ - 1], L[i_], (x)); L[0] = maxi(L[0], (x)); } while (0)
#define TK_DMA(rsrc_, reg_, dv_, rowstride_, sbase_) do { _Pragma("unroll") for (int i_ = 0; i_ < 8; ++i_) \
        __builtin_amdgcn_raw_ptr_buffer_load_lds((rsrc_), (LAS void*)((reg_) + i_ * 1024), 16, (dv_)[i_ & 1], (sbase_) + 8 * (i_ & 3) * (rowstride_) + 128 * (i_ >> 2), 0, 0); } while (0)
#define TK_FRAGS(dst_, rega_) do { const unsigned a0_ = (rega_) + rd[0], a1_ = (rega_) + rd[1], a2_ = (rega_) + rd[2], a3_ = (rega_) + rd[3]; v4u f_[8]; \
        asm volatile("s_waitcnt vmcnt(0)\n\tds_read_b128 %0, %8\n\tds_read_b128 %1, %9\n\tds_read_b128 %2, %10\n\tds_read_b128 %3, %11\n\t" \
                     "ds_read_b128 %4, %8 offset:4096\n\tds_read_b128 %5, %9 offset:4096\n\tds_read_b128 %6, %10 offset:4096\n\tds_read_b128 %7, %11 offset:4096\n\ts_waitcnt lgkmcnt(0)" \
                     : "=&v"(f_[0]), "=&v"(f_[1]), "=&v"(f_[2]), "=&v"(f_[3]), "=&v"(f_[4]), "=&v"(f_[5]), "=&v"(f_[6]), "=&v"(f_[7]) : "v"(a0_), "v"(a1_), "v"(a2_), "v"(a3_) : "memory"); \
        _Pragma("unroll") for (int ks = 0; ks < 8; ++ks) dst_[ks] = __builtin_bit_cast(bf16x8, f_[ks]); } while (0)
__device__ __forceinline__ void topk_pass(const __amdgpu_buffer_rsrc_t rsrcQ, const __amdgpu_buffer_rsrc_t rsrcK, int t0, int h, int lane, LAS unsigned char* wl, int (&La)[16], int (&Lb)[16]) {
    const int r = lane & 31, h2 = lane >> 5;
    const int h2x4 = 4 * h2;
    const unsigned qreg_a = (unsigned)(size_t)wl, kreg_a = qreg_a + 8448u;
    unsigned rd[4];
#pragma unroll
    for (int q = 0; q < 4; ++q) rd[q] = (unsigned)(r * 128 + 16 * ((2 * q + h2) ^ ((r >> 1) & 7)));
    int dvK[2], dvQ[2];
#pragma unroll
    for (int b = 0; b < 2; ++b) { const int ch = 16 * ((lane & 7) ^ ((lane >> 4) + 4 * b)); dvK[b] = (lane >> 3) * 256 + ch; dvQ[b] = (lane >> 3) * 4096 + ch; }
#pragma unroll
    for (int half = 0; half < 2; ++half) {
        bf16x8 qf[8];
        int zs = 0; asm volatile("" : "+s"(zs));
        const int qs = t0 * 4096 + h * 512 + half * 256 + zs;
        const int kbs = half * 262144 + h * 32768 + zs;
        if (half == 0) { TK_DMA(rsrcQ, wl, dvQ, 4096, qs); TK_DMA(rsrcK, wl + 8448, dvK, 256, kbs); }
        bf16x8 kf[8];
        TK_FRAGS(qf, qreg_a);
        TK_FRAGS(kf, kreg_a);
        if (half == 0) TK_DMA(rsrcQ, wl, dvQ, 4096, qs + 256);
        int L[16];
#pragma unroll
        for (int tile = 0; tile < 4; ++tile) {
            if (tile < 3) TK_DMA(rsrcK, wl + 8448, dvK, 256, kbs + (tile + 1) * 8192);
            else if (half == 0) TK_DMA(rsrcK, wl + 8448, dvK, 256, kbs + 262144);
            f32x16 acc;
#pragma unroll
            for (int i = 0; i < 16; ++i) acc[i] = 0.f;
#pragma unroll
            for (int ks = 0; ks < 8; ++ks) acc = mfma32(kf[ks], qf[ks], acc);
            __builtin_amdgcn_sched_barrier(0);
            int Kt[16];
#pragma unroll
            for (int i = 0; i < 16; ++i) Kt[i] = ((f2key(acc[i]) & ~127) | (127 - (32 * tile + (i & 3) + 8 * (i >> 2)))) - h2x4;
            SORT16(Kt);
            if (tile == 0) {
#pragma unroll
                for (int i = 0; i < 16; ++i) L[i] = Kt[i];
            } else MERGE_PRUNE(L, Kt);
            __builtin_amdgcn_sched_barrier(0);
            if (tile < 3) TK_FRAGS(kf, kreg_a);
        }
        int A[16], B[16];
#pragma unroll
        for (int i = 0; i < 16; ++i) { auto rr = __builtin_amdgcn_permlane32_swap((unsigned)L[i], (unsigned)L[i], false, false); A[i] = (int)rr[0]; B[i] = (int)rr[1]; }
        MERGE_PRUNE(A, B);
#pragma unroll
        for (int i = 0; i < 16; ++i) { if (half == 0) La[i] = A[i]; else Lb[i] = A[i]; }
        __builtin_amdgcn_sched_barrier(0);
    }
}
__device__ __forceinline__ void topk_phase(Frame& F, int layer, int seam) {
    const bf16* QP = (const bf16*)(F.ws + WS_VG);
    const bf16* KEYS = (const bf16*)(F.ws + WS_KEYS + (size_t)layer * 512 * 1024);
    int* IDX = (int*)(F.ws + WS_IDX); float* GATE = (float*)(F.ws + WS_GATE);
    const int lane = lane_id(), h = F.wave;
    LAS unsigned char* wl = F.lds + h * 19456;
    LAS unsigned* tab = (LAS unsigned*)wl + lane * 33;
    const __amdgpu_buffer_rsrc_t rsrcQ = __builtin_amdgcn_make_buffer_rsrc((void*)QP, 0, T * 4096, 0x00020000);
    const __amdgpu_buffer_rsrc_t rsrcK = __builtin_amdgcn_make_buffer_rsrc((void*)KEYS, 0, 512 * 1024, 0x00020000);
    constexpr int NBP = TP / 32, NBS = TS / 32;
    const int cwg = (int)blockIdx.x, ntw = tail_wgs(F, 8);
    const int npair = cwg < NBP ? (NBP - cwg + 2 * F.G - 1) / (2 * F.G) : 0;
    const int j0 = (cwg - ntw + F.G) % F.G, nsamp = j0 < NBS ? (NBS - j0 + F.G - 1) / F.G : 0;
    for (int it = 0; it < npair + nsamp; ++it) {
        int bA, bB; bool two;
        if (it < npair) { bA = cwg + it * 2 * F.G; bB = bA + F.G; two = bB < NBP; }
        else { if (it == npair) tail_wait(F, seam, ntw); bA = NBP + j0 + (it - npair) * F.G; bB = bA; two = false; }
        int La[16], Lb[16];
        topk_pass(rsrcQ, rsrcK, 32 * bA, h, lane, wl, La, Lb);
        if (two) { int La2[16], Lb2[16];
            topk_pass(rsrcQ, rsrcK, 32 * bB, h, lane, wl, La2, Lb2);
#pragma unroll
            for (int i = 0; i < 16; ++i) { La[i] = (lane < 32) ? La[i] : La2[i]; Lb[i] = (lane < 32) ? Lb[i] : Lb2[i]; } }
        const int t = (lane < 32) ? 32 * bA + lane : 32 * bB + (lane - 32);
        float va[16], vb[16];
#pragma unroll
        for (int i = 0; i < 16; ++i) { va[i] = key2f(La[i] & ~127); vb[i] = key2f(Lb[i] & ~127); }
        int C[16];
#pragma unroll
        for (int j = 0; j < 16; ++j) C[j] = (f2key(va[0] + vb[j]) & ~255) | (255 - j);
#pragma unroll
        for (int i = 1; i < 16; ++i)
#pragma unroll
            for (int j = 0; j < 16; ++j)
                if ((i + 1) * (j + 1) <= 16) { const int x = (f2key(va[i] + vb[j]) & ~255) | (255 - (i * 16 + j)); TOPK_INSERT(C, x); }
#pragma unroll
        for (int i = 0; i < 16; ++i) { tab[i] = 127u - (unsigned)(La[i] & 127); tab[16 + i] = 127u - (unsigned)(Lb[i] & 127); }
        LDS_WAIT(); asm volatile("" ::: "memory");
        int ex[16]; float sc[16];
#pragma unroll
        for (int k = 0; k < 16; ++k) { const unsigned cidx = 255u - (unsigned)(C[k] & 255); ex[k] = (int)(tab[cidx >> 4] * 128u + tab[16 + (cidx & 15u)]); sc[k] = key2f(C[k] & ~255); }
        float ssum = 0.f;
        const float smax = sc[0];
#pragma unroll
        for (int k = 0; k < 16; ++k) { sc[k] = __builtin_amdgcn_exp2f((sc[k] - smax) * LOG2E); ssum += sc[k]; }
        const float rinv = 1.0f / ssum;
        if (lane < 32 || two) {
            int* ip = IDX + (size_t)t * 128 + h * 16; float* gp = GATE + (size_t)t * 128 + h * 16;
#pragma unroll
            for (int k = 0; k < 4; ++k) { *(GAS v4u*)(ip + 4 * k) = (v4u){(unsigned)ex[4 * k], (unsigned)ex[4 * k + 1], (unsigned)ex[4 * k + 2], (unsigned)ex[4 * k + 3]};
                *(GAS f32x4*)(gp + 4 * k) = (f32x4){sc[4 * k] * rinv, sc[4 * k + 1] * rinv, sc[4 * k + 2] * rinv, sc[4 * k + 3] * rinv}; }
        }
        LDS_WAIT(); asm volatile("" ::: "memory");
    }
}

typedef int v8i_t __attribute__((ext_vector_type(8)));
__device__ __forceinline__ float gelu1(float v) { const f32x2 g = pg8::gelu_pk((f32x2){v, v}); return g.x; }
#define FP4_ACC(W, D_, WK) do { f32x2 f_; \
        f_ = __builtin_amdgcn_cvt_scalef32_pk_f32_fp4((W), 1.0f, 0); acc[8 * (D_) + 0] += (WK) * f_.x; acc[8 * (D_) + 1] += (WK) * f_.y; \
        f_ = __builtin_amdgcn_cvt_scalef32_pk_f32_fp4((W), 1.0f, 1); acc[8 * (D_) + 2] += (WK) * f_.x; acc[8 * (D_) + 3] += (WK) * f_.y; \
        f_ = __builtin_amdgcn_cvt_scalef32_pk_f32_fp4((W), 1.0f, 2); acc[8 * (D_) + 4] += (WK) * f_.x; acc[8 * (D_) + 5] += (WK) * f_.y; \
        f_ = __builtin_amdgcn_cvt_scalef32_pk_f32_fp4((W), 1.0f, 3); acc[8 * (D_) + 6] += (WK) * f_.x; acc[8 * (D_) + 7] += (WK) * f_.y; } while (0)
#define GATHER_LOADU(kb_) do { const int el_ = __shfl(((kb_) < 4) ? idv0 : idv1, ((kb_) & 3) * 16 + fr); const int vo_ = el_ * 512 + q4 * 16; \
        _Pragma("unroll") for (int j = 0; j < 8; ++j) uA[j] = __builtin_amdgcn_raw_buffer_load_b128(rsrcU, vo_, 64 * j, 0); } while (0)
#define GATHER_LOADV(VH, kb_, hf_) do { const int idv_ = ((kb_) < 4) ? idv0 : idv1; const int kbase_ = ((kb_) & 3) * 16 + 8 * (hf_); \
        _Pragma("unroll") for (int kk = 0; kk < 8; ++kk) { const int e_ = __builtin_amdgcn_readlane(idv_, kbase_ + kk); VH[kk] = __builtin_amdgcn_raw_buffer_load_b64(rsrcV, lane8, e_ * 512, 0); } } while (0)
#define GATHER_LOADU2(UB, kb_) do { const int el_ = __shfl(((kb_) < 4) ? idv0 : idv1, ((kb_) & 3) * 16 + fr); const int vo_ = el_ * 512 + q4 * 16; \
        _Pragma("unroll") for (int j = 0; j < 8; ++j) UB[j] = __builtin_amdgcn_raw_buffer_load_b128(rsrcU, vo_, 64 * j, 0); } while (0)
__device__ __forceinline__ void stage_x_fp4(const unsigned (&xw)[8], LAS unsigned char* xs_, int lane, float& xinv, float& xinv2) {
    float m = 0.f;
#pragma unroll
    for (int k = 0; k < 8; ++k) m = __builtin_fmaxf(m, __builtin_fmaxf(__builtin_fabsf(bflo(xw[k])), __builtin_fabsf(bfhi(xw[k]))));
    m = wave_max_nonneg(m);
    const float xsc = (m > 1e-30f) ? 6.0f / m : 1.0f; xinv = (m > 1e-30f) ? m * (1.0f / 6.0f) : 1.0f;
    float xr[16]; v2u q; float m2 = 0.f;
#pragma unroll
    for (int d = 0; d < 2; ++d) { unsigned w_ = 0u;
        w_ = __builtin_amdgcn_cvt_scalef32_pk_fp4_f32(w_, bflo(xw[4 * d]) * xsc, bfhi(xw[4 * d]) * xsc, 1.0f, 0);
        w_ = __builtin_amdgcn_cvt_scalef32_pk_fp4_f32(w_, bflo(xw[4 * d + 1]) * xsc, bfhi(xw[4 * d + 1]) * xsc, 1.0f, 1);
        w_ = __builtin_amdgcn_cvt_scalef32_pk_fp4_f32(w_, bflo(xw[4 * d + 2]) * xsc, bfhi(xw[4 * d + 2]) * xsc, 1.0f, 2);
        w_ = __builtin_amdgcn_cvt_scalef32_pk_fp4_f32(w_, bflo(xw[4 * d + 3]) * xsc, bfhi(xw[4 * d + 3]) * xsc, 1.0f, 3);
        q[d] = w_;
        f32x2 f;
        f = __builtin_amdgcn_cvt_scalef32_pk_f32_fp4(w_, 1.0f, 0); xr[8 * d + 0] = bflo(xw[4 * d]) - f.x * xinv;     xr[8 * d + 1] = bfhi(xw[4 * d]) - f.y * xinv;
        f = __builtin_amdgcn_cvt_scalef32_pk_f32_fp4(w_, 1.0f, 1); xr[8 * d + 2] = bflo(xw[4 * d + 1]) - f.x * xinv; xr[8 * d + 3] = bfhi(xw[4 * d + 1]) - f.y * xinv;
        f = __builtin_amdgcn_cvt_scalef32_pk_f32_fp4(w_, 1.0f, 2); xr[8 * d + 4] = bflo(xw[4 * d + 2]) - f.x * xinv; xr[8 * d + 5] = bfhi(xw[4 * d + 2]) - f.y * xinv;
        f = __builtin_amdgcn_cvt_scalef32_pk_f32_fp4(w_, 1.0f, 3); xr[8 * d + 6] = bflo(xw[4 * d + 3]) - f.x * xinv; xr[8 * d + 7] = bfhi(xw[4 * d + 3]) - f.y * xinv; }
    *(LAS v2u*)(xs_ + 8 * lane) = q;
#pragma unroll
    for (int i = 0; i < 16; ++i) m2 = __builtin_fmaxf(m2, __builtin_fabsf(xr[i]));
    m2 = wave_max_nonneg(m2);
    const float xsc2 = (m2 > 1e-30f) ? 6.0f / m2 : 1.0f; xinv2 = (m2 > 1e-30f) ? m2 * (1.0f / 6.0f) : 0.0f;
#pragma unroll
    for (int d = 0; d < 2; ++d) { unsigned w_ = 0u;
        w_ = __builtin_amdgcn_cvt_scalef32_pk_fp4_f32(w_, xr[8 * d + 0] * xsc2, xr[8 * d + 1] * xsc2, 1.0f, 0);
        w_ = __builtin_amdgcn_cvt_scalef32_pk_fp4_f32(w_, xr[8 * d + 2] * xsc2, xr[8 * d + 3] * xsc2, 1.0f, 1);
        w_ = __builtin_amdgcn_cvt_scalef32_pk_fp4_f32(w_, xr[8 * d + 4] * xsc2, xr[8 * d + 5] * xsc2, 1.0f, 2);
        w_ = __builtin_amdgcn_cvt_scalef32_pk_fp4_f32(w_, xr[8 * d + 6] * xsc2, xr[8 * d + 7] * xsc2, 1.0f, 3);
        q[d] = w_; }
    *(LAS v2u*)(xs_ + 512 + 8 * lane) = q;
}
__device__ __forceinline__ void lds_w64(unsigned a, v2u v);
__device__ __forceinline__ void stage_x_fp4_asm(const unsigned (&xw)[8], unsigned xs_, int lane, float& xinv, float& xinv2) {
    float m = 0.f;
#pragma unroll
    for (int k = 0; k < 8; ++k) m = __builtin_fmaxf(m, __builtin_fmaxf(__builtin_fabsf(bflo(xw[k])), __builtin_fabsf(bfhi(xw[k]))));
    m = wave_max_nonneg(m);
    const float xsc = (m > 1e-30f) ? 6.0f / m : 1.0f; xinv = (m > 1e-30f) ? m * (1.0f / 6.0f) : 1.0f;
    float xr[16]; v2u q; float m2 = 0.f;
#pragma unroll
    for (int d = 0; d < 2; ++d) { unsigned w_ = 0u;
        w_ = __builtin_amdgcn_cvt_scalef32_pk_fp4_f32(w_, bflo(xw[4 * d]) * xsc, bfhi(xw[4 * d]) * xsc, 1.0f, 0);
        w_ = __builtin_amdgcn_cvt_scalef32_pk_fp4_f32(w_, bflo(xw[4 * d + 1]) * xsc, bfhi(xw[4 * d + 1]) * xsc, 1.0f, 1);
        w_ = __builtin_amdgcn_cvt_scalef32_pk_fp4_f32(w_, bflo(xw[4 * d + 2]) * xsc, bfhi(xw[4 * d + 2]) * xsc, 1.0f, 2);
        w_ = __builtin_amdgcn_cvt_scalef32_pk_fp4_f32(w_, bflo(xw[4 * d + 3]) * xsc, bfhi(xw[4 * d + 3]) * xsc, 1.0f, 3);
        q[d] = w_;
        f32x2 f;
        f = __builtin_amdgcn_cvt_scalef32_pk_f32_fp4(w_, 1.0f, 0); xr[8 * d + 0] = bflo(xw[4 * d]) - f.x * xinv;     xr[8 * d + 1] = bfhi(xw[4 * d]) - f.y * xinv;
        f = __builtin_amdgcn_cvt_scalef32_pk_f32_fp4(w_, 1.0f, 1); xr[8 * d + 2] = bflo(xw[4 * d + 1]) - f.x * xinv; xr[8 * d + 3] = bfhi(xw[4 * d + 1]) - f.y * xinv;
        f = __builtin_amdgcn_cvt_scalef32_pk_f32_fp4(w_, 1.0f, 2); xr[8 * d + 4] = bflo(xw[4 * d + 2]) - f.x * xinv; xr[8 * d + 5] = bfhi(xw[4 * d + 2]) - f.y * xinv;
        f = __builtin_amdgcn_cvt_scalef32_pk_f32_fp4(w_, 1.0f, 3); xr[8 * d + 6] = bflo(xw[4 * d + 3]) - f.x * xinv; xr[8 * d + 7] = bfhi(xw[4 * d + 3]) - f.y * xinv; }
    lds_w64(xs_ + 8u * (unsigned)lane, q);
#pragma unroll
    for (int i = 0; i < 16; ++i) m2 = __builtin_fmaxf(m2, __builtin_fabsf(xr[i]));
    m2 = wave_max_nonneg(m2);
    const float xsc2 = (m2 > 1e-30f) ? 6.0f / m2 : 1.0f; xinv2 = (m2 > 1e-30f) ? m2 * (1.0f / 6.0f) : 0.0f;
#pragma unroll
    for (int d = 0; d < 2; ++d) { unsigned w_ = 0u;
        w_ = __builtin_amdgcn_cvt_scalef32_pk_fp4_f32(w_, xr[8 * d + 0] * xsc2, xr[8 * d + 1] * xsc2, 1.0f, 0);
        w_ = __builtin_amdgcn_cvt_scalef32_pk_fp4_f32(w_, xr[8 * d + 2] * xsc2, xr[8 * d + 3] * xsc2, 1.0f, 1);
        w_ = __builtin_amdgcn_cvt_scalef32_pk_fp4_f32(w_, xr[8 * d + 4] * xsc2, xr[8 * d + 5] * xsc2, 1.0f, 2);
        w_ = __builtin_amdgcn_cvt_scalef32_pk_fp4_f32(w_, xr[8 * d + 6] * xsc2, xr[8 * d + 7] * xsc2, 1.0f, 3);
        q[d] = w_; }
    lds_w64(xs_ + 512u + 8u * (unsigned)lane, q);
}
__device__ __forceinline__ void lds_w64(unsigned a, v2u v) { asm volatile("ds_write_b64 %0, %1" :: "v"(a), "v"(v) : "memory"); }
__device__ __forceinline__ void lds_w128(unsigned a, f32x4 v) { asm volatile("ds_write_b128 %0, %1" :: "v"(a), "v"(v) : "memory"); }
__device__ __forceinline__ float lds_r32_wait(unsigned a) { float r; asm volatile("s_waitcnt lgkmcnt(0)\n\tds_read_b32 %0, %1\n\ts_waitcnt lgkmcnt(0)" : "=v"(r) : "v"(a) : "memory"); return r; }
__device__ __forceinline__ float dpp_ror8(float x) { return __int_as_float(__builtin_amdgcn_update_dpp(0, __float_as_int(x), 0x128, 0xf, 0xf, true)); }
__device__ __forceinline__ void gather_u_phase(Frame& F, int layer) {
    const unsigned char* PU = F.ws + WS_PU + (size_t)layer * 16384 * 512;
    const float* RSU = (const float*)(F.ws + WS_RS) + (size_t)layer * 32768;
    const int* IDX = (const int*)(F.ws + WS_IDX); float* GATE = (float*)(F.ws + WS_GATE);
    const bf16* XB = (const bf16*)(F.ws + WS_XB);
    const int lane = lane_id(), fr = lane & 15, q4 = lane >> 4;
    const int gw = blockIdx.x * NWAVES + F.wave, NGW = F.G * NWAVES;
    LAS unsigned char* wl = F.lds + F.wave * 19456;
    const unsigned wl_a = (unsigned)(size_t)wl;
    const unsigned xs_a = wl_a + 16384, hb_a = wl_a + 18432;
    const __amdgpu_buffer_rsrc_t rsrcU = __builtin_amdgcn_make_buffer_rsrc((void*)PU, 0, 16384 * 512, 0x00020000);
    const __amdgpu_buffer_rsrc_t rsrcS = __builtin_amdgcn_make_buffer_rsrc((void*)RSU, 0, 2 * 65536, 0x00020000);
    int t = gw;
    if (t >= T) return;
    const int dma_c = (((lane & 7) ^ (lane >> 3)) & 7) * 16;
    const int rr = fr & 7;
    const unsigned rdA0 = (unsigned)((fr >> 3) * 4096 + rr * 128 + ((q4 ^ rr) & 7) * 16), rdA1 = (unsigned)((fr >> 3) * 4096 + rr * 128 + (((4 + q4) ^ rr) & 7) * 16);
    const unsigned rdX = xs_a + 16 * q4;
#define GU_DMA(buf_, i0_, i1_, kb_) do { const int iv_ = ((kb_) < 4) ? (i0_) : (i1_); \
        _Pragma("unroll") for (int h_ = 0; h_ < 2; ++h_) { const int vo_ = __shfl(iv_, ((kb_) & 3) * 16 + 8 * h_ + (lane >> 3)) * 512 + dma_c; \
            _Pragma("unroll") for (int m_ = 0; m_ < 4; ++m_) __builtin_amdgcn_raw_ptr_buffer_load_lds(rsrcU, (LAS void*)(wl + (buf_) * 8192 + (h_ * 4 + m_) * 1024), 16, vo_, 128 * m_, 0, 0); } } while (0)
#define GU_READA(buf_) do { const unsigned a0_ = wl_a + (buf_) * 8192 + rdA0, a1_ = wl_a + (buf_) * 8192 + rdA1; \
        asm volatile("ds_read_b128 %0, %8\n\tds_read_b128 %1, %9\n\tds_read_b128 %2, %8 offset:1024\n\tds_read_b128 %3, %9 offset:1024\n\t" \
                     "ds_read_b128 %4, %8 offset:2048\n\tds_read_b128 %5, %9 offset:2048\n\tds_read_b128 %6, %8 offset:3072\n\tds_read_b128 %7, %9 offset:3072\n\ts_waitcnt lgkmcnt(0)" \
                     : "=&v"(ua[0]), "=&v"(ua[1]), "=&v"(ua[2]), "=&v"(ua[3]), "=&v"(ua[4]), "=&v"(ua[5]), "=&v"(ua[6]), "=&v"(ua[7]) : "v"(a0_), "v"(a1_) : "memory"); } while (0)
#define GU_LOADB(xa_) do { const unsigned b_ = (xa_) + 16 * q4 + ((fr & 8) ? 512u : 0u);     \
        asm volatile("ds_read_b128 %0, %8\n\tds_read_b128 %1, %8 offset:64\n\tds_read_b128 %2, %8 offset:128\n\tds_read_b128 %3, %8 offset:192\n\t" \
                     "ds_read_b128 %4, %8 offset:256\n\tds_read_b128 %5, %8 offset:320\n\tds_read_b128 %6, %8 offset:384\n\tds_read_b128 %7, %8 offset:448\n\ts_waitcnt lgkmcnt(0)" \
                     : "=&v"(xb0[0]), "=&v"(xb0[1]), "=&v"(xb0[2]), "=&v"(xb0[3]), "=&v"(xb0[4]), "=&v"(xb0[5]), "=&v"(xb0[6]), "=&v"(xb0[7]) : "v"(b_) : "memory"); } while (0)
#define GU_BATCH(buf_, kb_, NEXT_DMA) do { \
        asm volatile("s_waitcnt vmcnt(8)" ::: "memory"); \
        v4u ua[8]; GU_READA(buf_); \
        NEXT_DMA; \
        f32x4 dacc = (f32x4){0.f, 0.f, 0.f, 0.f}; \
        _Pragma("unroll") for (int j = 0; j < 8; ++j) { \
            const v8i_t A_ = (v8i_t){(int)ua[j].x, (int)ua[j].y, (int)ua[j].z, (int)ua[j].w, 0, 0, 0, 0}; \
            const v8i_t B_ = (v8i_t){(int)xb0[j].x, (int)xb0[j].y, (int)xb0[j].z, (int)xb0[j].w, 0, 0, 0, 0}; \
            dacc = __builtin_amdgcn_mfma_scale_f32_16x16x128_f8f6f4(A_, B_, dacc, 4, 4, 0, 127, 0, 127); } \
        { const float sc_ = (fr & 8) ? xinv2 : xinv;     \
          _Pragma("unroll") for (int i = 0; i < 4; ++i) { const float h_ = dacc[i] * sc_; dacc[i] = h_ + dpp_ror8(h_); } } \
        if (fr == 0) lds_w128(hb_a + (unsigned)((((kb_) & 3) * 16 + 4 * q4) * 4), dacc);     \
        } while (0)
#define GU_HALF(gt_, ru_, rv_, half_) do { const float h_ = lds_r32_wait(hb_a + 4u * (unsigned)lane); \
        wrow[64 * (half_) + lane] = (gt_) * gelu1(h_ * (ru_)) * (rv_); } while (0)
    int idv0, idv1; float gtv0, gtv1, rsu0, rsu1, rsv0, rsv1, xinv, xinv2;
    int cur = 0;
    v4u xb0[8];
    { const unsigned l32 = (unsigned)lane * 32u, l4 = (unsigned)lane * 4u;
      unsigned xw[8];
      { const v4u a = ldg16(XB + (size_t)t * D, l32), b = ldg16(XB + (size_t)t * D + 8, l32);
#pragma unroll
        for (int k = 0; k < 4; ++k) { xw[k] = a[k]; xw[4 + k] = b[k]; } }
      idv0 = *(const GAS int*)((const GAS char*)(IDX + (size_t)t * 128) + l4); idv1 = *(const GAS int*)((const GAS char*)(IDX + (size_t)t * 128 + 64) + l4);
      gtv0 = *(const GAS float*)((const GAS char*)(GATE + (size_t)t * 128) + l4); gtv1 = *(const GAS float*)((const GAS char*)(GATE + (size_t)t * 128 + 64) + l4);
      { const v2u s0_ = __builtin_amdgcn_raw_buffer_load_b64(rsrcS, idv0 * 8, 0, 0), s1_ = __builtin_amdgcn_raw_buffer_load_b64(rsrcS, idv1 * 8, 0, 0);
        rsu0 = __uint_as_float(s0_.x); rsv0 = __uint_as_float(s0_.y); rsu1 = __uint_as_float(s1_.x); rsv1 = __uint_as_float(s1_.y); }
      stage_x_fp4_asm(xw, xs_a, lane, xinv, xinv2);
      asm volatile("s_waitcnt vmcnt(0)" ::: "memory");
      GU_DMA(0, idv0, idv1, 0); GU_DMA(1, idv0, idv1, 1);
      GU_LOADB(xs_a); }
    for (; t < T; t += NGW) {
        unsigned l32 = (unsigned)lane * 32u, l4 = (unsigned)lane * 4u;
        asm volatile("" : "+v"(l32), "+v"(l4));
        const int tn = (t + NGW < T) ? t + NGW : t;
        float* wrow = GATE + (size_t)t * 128;
        unsigned xwn[8]; int idn0, idn1; float gtn0, gtn1, rsun0, rsun1, rsvn0, rsvn1;
#define GU_PRE_NEXT do { const v4u a = ldg16(XB + (size_t)tn * D, l32), b = ldg16(XB + (size_t)tn * D + 8, l32); \
            _Pragma("unroll") for (int k = 0; k < 4; ++k) { xwn[k] = a[k]; xwn[4 + k] = b[k]; } \
            idn0 = *(const GAS int*)((const GAS char*)(IDX + (size_t)tn * 128) + l4); idn1 = *(const GAS int*)((const GAS char*)(IDX + (size_t)tn * 128 + 64) + l4); \
            gtn0 = *(const GAS float*)((const GAS char*)(GATE + (size_t)tn * 128) + l4); gtn1 = *(const GAS float*)((const GAS char*)(GATE + (size_t)tn * 128 + 64) + l4); } while (0)
#define GU_PRE_RS do { const v2u s0_ = __builtin_amdgcn_raw_buffer_load_b64(rsrcS, idn0 * 8, 0, 0), s1_ = __builtin_amdgcn_raw_buffer_load_b64(rsrcS, idn1 * 8, 0, 0); \
            rsun0 = __uint_as_float(s0_.x); rsvn0 = __uint_as_float(s0_.y); rsun1 = __uint_as_float(s1_.x); rsvn1 = __uint_as_float(s1_.y); } while (0)
        GU_BATCH(0, 0, GU_PRE_NEXT; GU_DMA(0, idv0, idv1, 2));
        GU_BATCH(1, 1, GU_DMA(1, idv0, idv1, 3));
        GU_BATCH(0, 2, GU_DMA(0, idv0, idv1, 4));
        GU_BATCH(1, 3, GU_DMA(1, idv0, idv1, 5));
        GU_BATCH(0, 4, GU_HALF(gtv0, rsu0, rsv0, 0); GU_DMA(0, idv0, idv1, 6));
        GU_BATCH(1, 5, GU_PRE_RS; GU_DMA(1, idv0, idv1, 7));
        float xinvn, xinv2n;
        stage_x_fp4_asm(xwn, xs_a + (unsigned)((cur ^ 1) * 1024), lane, xinvn, xinv2n);
        GU_BATCH(0, 6, GU_DMA(0, idn0, idn1, 0));
        GU_BATCH(1, 7, GU_DMA(1, idn0, idn1, 1));
        GU_HALF(gtv1, rsu1, rsv1, 1);
#undef GU_PRE_NEXT
#undef GU_PRE_RS
        cur ^= 1;
        GU_LOADB(xs_a + (unsigned)(cur * 1024));
        idv0 = idn0; idv1 = idn1; gtv0 = gtn0; gtv1 = gtn1; rsu0 = rsun0; rsu1 = rsun1; rsv0 = rsvn0; rsv1 = rsvn1; xinv = xinvn; xinv2 = xinv2n;
    }
    asm volatile("s_waitcnt vmcnt(0)" ::: "memory");
#undef GU_DMA
#undef GU_READA
#undef GU_LOADB
#undef GU_BATCH
#undef GU_HALF
}
__device__ __forceinline__ float swz16(float x) { return __int_as_float(__builtin_amdgcn_ds_swizzle(__float_as_int(x), 0x401F)); }
__device__ __forceinline__ void gather_v_phase(Frame& F, int layer) {
    const unsigned char* PV = F.ws + WS_PV + (size_t)layer * 16384 * 512;
    const int* IDX = (const int*)(F.ws + WS_IDX); const float* GATE = (const float*)(F.ws + WS_GATE);
    bf16* XB = (bf16*)(F.ws + WS_XB); float* Y = F.out + O_Y;
    const float* gam = F.in[14] + (size_t)(layer * 2 + 1) * D; const float* bet = F.in[15] + (size_t)(layer * 2 + 1) * D;
    const int lane = lane_id(), np = lane & 31, hh = lane >> 5, np15 = np & 15, rowsel = np >> 4;
    const int gw = blockIdx.x * NWAVES + F.wave, NGW = F.G * NWAVES;
    const __amdgpu_buffer_rsrc_t rsrcV = __builtin_amdgcn_make_buffer_rsrc((void*)PV, 0, 16384 * 512, 0x00020000);
    int t = gw;
    if (t >= T) return;
    const int lane_off = 32 * np15 + 16 * hh;
    const int bp = 4 * rowsel;
    const int col0 = 64 * np15 + 4 * hh;
    int A[2][4];
    { const int m = np, par = m & 1, byt = (m & 7) >> 1, d0 = m >> 3;
      const float fa = par ? 0.f : 1.f, fb = par ? 1.f : 0.f;
      const unsigned v0 = __builtin_amdgcn_cvt_scalef32_pk_fp4_f32(0u, fa, fb, 1.0f, 0), v1 = __builtin_amdgcn_cvt_scalef32_pk_fp4_f32(0u, fa, fb, 1.0f, 1);
      const unsigned v2 = __builtin_amdgcn_cvt_scalef32_pk_fp4_f32(0u, fa, fb, 1.0f, 2), v3 = __builtin_amdgcn_cvt_scalef32_pk_fp4_f32(0u, fa, fb, 1.0f, 3);
      const unsigned val = (byt == 0) ? v0 : (byt == 1) ? v1 : (byt == 2) ? v2 : v3;
#pragma unroll
      for (int s_ = 0; s_ < 2; ++s_)
#pragma unroll
          for (int d = 0; d < 4; ++d) A[s_][d] = (hh == s_ && d == d0) ? (int)val : 0; }
    LAS f32x4* gbl = (LAS f32x4*)(F.lds + F.wave * 16384) + lane;
#pragma unroll
    for (int s_ = 0; s_ < 8; ++s_) { gbl[64 * s_] = *(const GAS f32x4*)(gam + col0 + 8 * s_); gbl[64 * (8 + s_)] = *(const GAS f32x4*)(bet + col0 + 8 * s_); }
    int idv0, idv1; float wv0, wv1;
    { const unsigned l4 = (unsigned)lane * 4u;
      idv0 = *(const GAS int*)((const GAS char*)(IDX + (size_t)t * 128) + l4); idv1 = *(const GAS int*)((const GAS char*)(IDX + (size_t)t * 128 + 64) + l4);
      wv0 = *(const GAS float*)((const GAS char*)(GATE + (size_t)t * 128) + l4); wv1 = *(const GAS float*)((const GAS char*)(GATE + (size_t)t * 128 + 64) + l4); }
    v4u vb[8]; float wl[8];
#define V2_ISSUE(u_, iv_, wv_, jj_) do { const int ba_ = bp + 8 * (jj_); const int e_ = __builtin_amdgcn_ds_bpermute(ba_, (iv_)); \
        wl[u_] = __int_as_float(__builtin_amdgcn_ds_bpermute(ba_, __float_as_int(wv_))); \
        vb[u_] = __builtin_amdgcn_raw_buffer_load_b128(rsrcV, e_ * 512 + lane_off, 0, 0); } while (0)
#define V2_STEP(DC, DP, u_, HAS_PREV) do { const v8i_t B_ = (v8i_t){(int)vb[u_].x, (int)vb[u_].y, (int)vb[u_].z, (int)vb[u_].w, 0, 0, 0, 0}; const float wc_ = wl[u_]; \
        _Pragma("unroll") for (int s_ = 0; s_ < 2; ++s_) { const v8i_t A_ = (v8i_t){A[s_][0], A[s_][1], A[s_][2], A[s_][3], 0, 0, 0, 0}; \
            DC[s_] = __builtin_amdgcn_mfma_scale_f32_32x32x64_f8f6f4(A_, B_, zero16, 4, 4, 0, 127, 0, 127); \
            if (HAS_PREV) { _Pragma("unroll") for (int j_ = 0; j_ < 4; ++j_) acc[4 * s_ + j_] += (f32x4){DP[s_][4 * j_], DP[s_][4 * j_ + 1], DP[s_][4 * j_ + 2], DP[s_][4 * j_ + 3]} * wp; } } \
        wp = wc_; } while (0)
    f32x16 zero16;
#pragma unroll
    for (int i = 0; i < 16; ++i) zero16[i] = 0.f;
#pragma unroll
    for (int u = 0; u < 8; ++u) V2_ISSUE(u, idv0, wv0, u);
    for (; t < T; t += NGW) {
        unsigned l4 = (unsigned)lane * 4u;
        asm volatile("" : "+v"(l4));
        const int tn = (t + NGW < T) ? t + NGW : t;
        const int idn0 = *(const GAS int*)((const GAS char*)(IDX + (size_t)tn * 128) + l4), idn1 = *(const GAS int*)((const GAS char*)(IDX + (size_t)tn * 128 + 64) + l4);
        const float wn0 = *(const GAS float*)((const GAS char*)(GATE + (size_t)tn * 128) + l4), wn1 = *(const GAS float*)((const GAS char*)(GATE + (size_t)tn * 128 + 64) + l4);
        f32x4 acc[8]; f32x16 dA[2], dB[2]; float wp = 0.f;
#pragma unroll
        for (int s_ = 0; s_ < 8; ++s_) acc[s_] = (f32x4){0.f, 0.f, 0.f, 0.f};
#define V2_GROUP(g_, NIV, NWV, NJB) do { \
        V2_STEP(dA, dB, 0, (g_) > 0); V2_ISSUE(0, NIV, NWV, (NJB) + 0); V2_STEP(dB, dA, 1, true); V2_ISSUE(1, NIV, NWV, (NJB) + 1); \
        V2_STEP(dA, dB, 2, true); V2_ISSUE(2, NIV, NWV, (NJB) + 2); V2_STEP(dB, dA, 3, true); V2_ISSUE(3, NIV, NWV, (NJB) + 3); \
        V2_STEP(dA, dB, 4, true); V2_ISSUE(4, NIV, NWV, (NJB) + 4); V2_STEP(dB, dA, 5, true); V2_ISSUE(5, NIV, NWV, (NJB) + 5); \
        V2_STEP(dA, dB, 6, true); V2_ISSUE(6, NIV, NWV, (NJB) + 6); V2_STEP(dB, dA, 7, true); V2_ISSUE(7, NIV, NWV, (NJB) + 7); } while (0)
        V2_GROUP(0, idv0, wv0, 8);  V2_GROUP(1, idv0, wv0, 16); V2_GROUP(2, idv0, wv0, 24); V2_GROUP(3, idv1, wv1, 0);
        V2_GROUP(4, idv1, wv1, 8);  V2_GROUP(5, idv1, wv1, 16); V2_GROUP(6, idv1, wv1, 24); V2_GROUP(7, idn0, wn0, 0);
#undef V2_GROUP
#pragma unroll
        for (int s_ = 0; s_ < 2; ++s_)
#pragma unroll
            for (int j_ = 0; j_ < 4; ++j_) acc[4 * s_ + j_] += (f32x4){dB[s_][4 * j_], dB[s_][4 * j_ + 1], dB[s_][4 * j_ + 2], dB[s_][4 * j_ + 3]} * wp;
        const bf16* xrow = XB + (size_t)t * D + col0;
        float ssum = 0.f;
#pragma unroll
        for (int s_ = 0; s_ < 8; ++s_) { const v2u xb = *(const GAS v2u*)(xrow + 8 * s_);
            const f32x4 xr = (f32x4){bflo(xb.x), bfhi(xb.x), bflo(xb.y), bfhi(xb.y)};
#pragma unroll
            for (int i = 0; i < 4; ++i) { acc[s_][i] = acc[s_][i] + swz16(acc[s_][i]) + ALPHA * xr[i]; ssum += acc[s_][i]; } }
        const float mean = wave_sum(ssum) * (0.5f / D); float s2 = 0.f;
#pragma unroll
        for (int s_ = 0; s_ < 8; ++s_)
#pragma unroll
            for (int i = 0; i < 4; ++i) { acc[s_][i] -= mean; s2 += acc[s_][i] * acc[s_][i]; }
        const float rstd = __builtin_amdgcn_rsqf(wave_sum(s2) * (0.5f / D) + LN_EPS);
        if (rowsel == 0) {
#pragma unroll
            for (int s_ = 0; s_ < 8; ++s_) { const f32x4 g4 = gbl[64 * s_], b4 = gbl[64 * (8 + s_)];
                const f32x4 y = acc[s_] * rstd * g4 + b4;
                if (layer == 1) __builtin_nontemporal_store(y, (f32x4*)(Y + (size_t)t * D + col0 + 8 * s_));
                else { v2u o; o.x = pkbf(y[0], y[1]); o.y = pkbf(y[2], y[3]); *(GAS v2u*)(XB + (size_t)t * D + col0 + 8 * s_) = o; } }
        }
        idv0 = idn0; idv1 = idn1; wv0 = wn0; wv1 = wn1;
    }
#undef V2_ISSUE
#undef V2_STEP
}
template <bool MASKED> __device__ __forceinline__ void sb_tile(f32x16& p, float& c, f32x16 (&o)[2], LAS const unsigned char* vs, int kv0, int ql, int lane) {
    const int h2 = lane >> 5, fr = lane & 15;
    float rm[16];
#pragma unroll
    for (int i = 0; i < 16; ++i) { const float z = p[i];
        const float t = __builtin_amdgcn_exp2f(-z * LOG2E);
        float be = __builtin_amdgcn_rcpf(1.0f + t);
        float r1 = 1.0f - be;
        if (MASKED) { const bool v = (kv0 + crow(i, h2) < ql); be = v ? be : 0.f; r1 = v ? r1 : 1.0f; }
        p[i] = be; rm[i] = r1; }
    float pp[4], hiv[4];
#pragma unroll
    for (int g = 0; g < 4; ++g) { const float gs = (rm[4 * g] * rm[4 * g + 1]) * (rm[4 * g + 2] * rm[4 * g + 3]);
        auto rr = __builtin_amdgcn_permlane32_swap(__float_as_uint(gs), __float_as_uint(gs), false, false);
        const float lo = __uint_as_float(rr[0]), hi = __uint_as_float(rr[1]); pp[g] = lo * hi; hiv[g] = hi; }
    float sp4[4]; sp4[3] = 1.0f;
#pragma unroll
    for (int g = 2; g >= 0; --g) sp4[g] = sp4[g + 1] * pp[g + 1];
    const float total = sp4[0] * pp[0];
    const float E = __builtin_amdgcn_exp2f(c * LOG2E);
#pragma unroll
    for (int g = 0; g < 4; ++g) { float run = E * sp4[g] * (h2 ? 1.0f : hiv[g]);
#pragma unroll
        for (int e = 3; e >= 0; --e) { const int ix = 4 * g + e; const float wgt = p[ix] * run; run *= rm[ix]; p[ix] = wgt; } }
    if (__builtin_expect(__any(total < 7.9e-31f), 0)) {
        float sl = 0.f;
#pragma unroll
        for (int i = 0; i < 16; ++i) sl += __builtin_amdgcn_logf(rm[i]);
        auto rr = __builtin_amdgcn_permlane32_swap(__float_as_uint(sl), __float_as_uint(sl), false, false);
        c += LN2 * (__uint_as_float(rr[0]) + __uint_as_float(rr[1]));
    } else c += LN2 * __builtin_amdgcn_logf(total);
    v2u tv[8];
    { const unsigned va = (unsigned)(size_t)vs + (unsigned)((4 * h2 + (fr >> 2)) * 128 + 32 * ((lane >> 4) & 1) + 8 * (fr & 3));
      asm volatile("ds_read_b64_tr_b16 %0, %8\n\tds_read_b64_tr_b16 %1, %8 offset:1024\n\tds_read_b64_tr_b16 %2, %8 offset:64\n\tds_read_b64_tr_b16 %3, %8 offset:1088\n\t"
                   "ds_read_b64_tr_b16 %4, %8 offset:2048\n\tds_read_b64_tr_b16 %5, %8 offset:3072\n\tds_read_b64_tr_b16 %6, %8 offset:2112\n\tds_read_b64_tr_b16 %7, %8 offset:3136\n\ts_waitcnt lgkmcnt(0)"
                   : "=&v"(tv[0]), "=&v"(tv[1]), "=&v"(tv[2]), "=&v"(tv[3]), "=&v"(tv[4]), "=&v"(tv[5]), "=&v"(tv[6]), "=&v"(tv[7]) : "v"(va) : "memory"); }
#pragma unroll
    for (int ss = 0; ss < 2; ++ss) {
        v4u pa; pa.x = pkbf(p[8 * ss], p[8 * ss + 1]); pa.y = pkbf(p[8 * ss + 2], p[8 * ss + 3]); pa.z = pkbf(p[8 * ss + 4], p[8 * ss + 5]); pa.w = pkbf(p[8 * ss + 6], p[8 * ss + 7]);
#pragma unroll
        for (int db = 0; db < 2; ++db) { const v2u lo = tv[4 * ss + 2 * db], hi = tv[4 * ss + 2 * db + 1];
            const v4u vv = (v4u){lo.x, lo.y, hi.x, hi.y};
            o[db] = mfma32(__builtin_bit_cast(bf16x8, pa), __builtin_bit_cast(bf16x8, vv), o[db]); } }
}
__device__ __forceinline__ void attn_phase(Frame& F) {
    bf16* Q1 = (bf16*)(F.ws + WS_VG); const bf16* K1 = Q1 + (size_t)T * D; const bf16* V1 = Q1 + (size_t)2 * T * D;
    const float* CK = F.in[3]; const float* CV = F.in[4];
    const int lane = lane_id(), r = lane & 31, h2 = lane >> 5;
    LAS unsigned char* vs0 = F.lds + F.wave * 8192;
    const int gw = blockIdx.x * NWAVES + F.wave, NGW = F.G * NWAVES;
    const unsigned offq = (unsigned)(r * 2048 + h2 * 16);
    const unsigned offv = (unsigned)((lane >> 3) * 2048 + (lane & 7) * 16);
    const unsigned offo = (unsigned)(h2 * 4 * 2048 + r * 2);
    const unsigned offck = (unsigned)(r * 256 + h2 * 32);
    const unsigned offcv = (unsigned)((lane >> 4) * 256 + (lane & 15) * 16);
    const int ntw = tail_wgs(F, 12);
    const int nP = gw < 32768 ? (32768 - gw + NGW - 1) / NGW : 0;
    const int v0 = (gw - ntw * NWAVES + NGW) % NGW, nS = v0 < 512 ? (512 - v0 + NGW - 1) / NGW : 0;
    for (int it = 0; it < nP + nS; ++it) {
        if (it == nP) tail_wait_wave(F, 4, ntw);
        const int u = it < nP ? gw + it * NGW : 32768 + v0 + (it - nP) * NGW;
        int hd, qblk; size_t seq0; const float* ck = nullptr; const float* cv = nullptr;
        if (u < 32768) { const int bh = u >> 8; qblk = u & 255; hd = bh & 15; seq0 = (size_t)(bh >> 4) * 8192; }
        else { const int v = u - 32768; const int bh = v >> 1; qblk = v & 1; hd = bh & 15; seq0 = 65536 + (size_t)(bh >> 4) * 64; ck = CK + (size_t)bh * 4096 * 64; cv = CV + (size_t)bh * 4096 * 64; }
        const bf16* qp = Q1 + (seq0 + 32 * qblk) * D + hd * 64;
        bf16x8 qf[4];
#pragma unroll
        for (int ks = 0; ks < 4; ++ks) qf[ks] = __builtin_bit_cast(bf16x8, ldg16(qp + 16 * ks, offq));
        f32x16 o[2];
#pragma unroll
        for (int i = 0; i < 16; ++i) { o[0][i] = 0.f; o[1][i] = 0.f; }
        float c = 0.f; const int ql = 32 * qblk + r;
        bool live = true;
        bf16x8 kf[4]; int vb = 0;
#define SB_FETCH(tk_, buf_) do { const bf16* kt_ = K1 + (seq0 + 32 * (tk_)) * D + hd * 64; const bf16* vt_ = V1 + (seq0 + 32 * (tk_)) * D + hd * 64; \
            _Pragma("unroll") for (int ks = 0; ks < 4; ++ks) kf[ks] = __builtin_bit_cast(bf16x8, ldg16(kt_ + 16 * ks, offq)); \
            _Pragma("unroll") for (int i = 0; i < 4; ++i) __builtin_amdgcn_global_load_lds((const unsigned*)((const char*)(vt_ + (size_t)(8 * i) * D) + offv), (LAS unsigned*)(vs0 + (buf_) * 4096 + i * 1024), 16, 0, 0); } while (0)
        SB_FETCH(qblk, 0);
#pragma unroll 1
        for (int tk = qblk; tk >= 0; --tk) {
            f32x16 p;
#pragma unroll
            for (int i = 0; i < 16; ++i) p[i] = 0.f;
            asm volatile("s_waitcnt vmcnt(0)" ::: "memory");
#pragma unroll
            for (int ks = 0; ks < 4; ++ks) p = mfma32(kf[ks], qf[ks], p);
            asm volatile("" ::: "memory");
            if (tk > 0) SB_FETCH(tk - 1, vb ^ 1);
            asm volatile("" ::: "memory");
            if (tk == qblk) sb_tile<true>(p, c, o, vs0 + vb * 4096, 32 * tk, ql, lane); else sb_tile<false>(p, c, o, vs0 + vb * 4096, 32 * tk, ql, lane);
            LDS_WAIT(); asm volatile("" ::: "memory");
            vb ^= 1;
            if (__all(c < SB_EXIT)) { live = false; break; }
        }
#undef SB_FETCH
        asm volatile("s_waitcnt vmcnt(0)" ::: "memory");
        if (ck && live) {
#pragma unroll 1
            for (int tc = 127; tc >= 0; --tc) {
                const float* kt = ck + (size_t)tc * 32 * 64; const float* vt = cv + (size_t)tc * 32 * 64;
#pragma unroll
                for (int ch = 0; ch < 2; ++ch) {
                    v4u a[4];
#pragma unroll
                    for (int i = 0; i < 4; ++i) a[i] = ldg16(vt + (size_t)(4 * (4 * ch + i)) * 64, offcv);
#pragma unroll
                    for (int i = 0; i < 4; ++i) { const int pz = lane + 64 * (4 * ch + i); v2u w2; w2.x = pkbf(__uint_as_float(a[i].x), __uint_as_float(a[i].y)); w2.y = pkbf(__uint_as_float(a[i].z), __uint_as_float(a[i].w));
                        *(LAS v2u*)(vs0 + (pz >> 4) * 128 + (pz & 15) * 8) = w2; }
                    asm volatile("" ::: "memory");
                }
                f32x16 p;
#pragma unroll
                for (int i = 0; i < 16; ++i) p[i] = 0.f;
#pragma unroll
                for (int kh = 0; kh < 2; ++kh) {
                    v4u a[2][2];
#pragma unroll
                    for (int k2 = 0; k2 < 2; ++k2) { const float* kr = kt + 16 * (2 * kh + k2); a[k2][0] = ldg16(kr, offck); a[k2][1] = ldg16(kr + 4, offck); }
#pragma unroll
                    for (int k2 = 0; k2 < 2; ++k2) { v4u kk; kk.x = pkbf(__uint_as_float(a[k2][0].x), __uint_as_float(a[k2][0].y)); kk.y = pkbf(__uint_as_float(a[k2][0].z), __uint_as_float(a[k2][0].w));
                        kk.z = pkbf(__uint_as_float(a[k2][1].x), __uint_as_float(a[k2][1].y)); kk.w = pkbf(__uint_as_float(a[k2][1].z), __uint_as_float(a[k2][1].w));
                        p = mfma32(__builtin_bit_cast(bf16x8, kk), qf[2 * kh + k2], p); }
                    asm volatile("" ::: "memory");
                }
                LDS_WAIT(); asm volatile("" ::: "memory");
                sb_tile<false>(p, c, o, vs0, 0, 0, lane);
                LDS_WAIT(); asm volatile("" ::: "memory");
                if (__all(c < SB_EXIT)) break;
            }
        }
        {
            const size_t rloc = (u < 32768) ? ((size_t)((u >> 8) >> 4) * 16 + hd) * 8192 + 32 * qblk : ((size_t)(((u - 32768) >> 1) >> 4) * 16 + hd) * 64 + 32 * qblk;
            float* kdst = F.out + (u < 32768 ? O_KRP : O_KRS) + rloc * 64 + lane * 4;
            float* vdst = kdst + (u < 32768 ? (O_VRP - O_KRP) : (O_VRS - O_KRS));
            const unsigned offkv = (unsigned)((lane >> 4) * 2048 + (lane & 15) * 8);
            const bf16* ksrc = K1 + (seq0 + 32 * qblk) * D + hd * 64; const bf16* vsrc = ksrc + (size_t)T * D;
            v2u kr[8], vr8[8];
#pragma unroll
            for (int i = 0; i < 8; ++i) { kr[i] = *(const GAS v2u*)((const GAS char*)(ksrc + (size_t)(4 * i) * D) + offkv); vr8[i] = *(const GAS v2u*)((const GAS char*)(vsrc + (size_t)(4 * i) * D) + offkv); }
#pragma unroll
            for (int i = 0; i < 8; ++i) {
                __builtin_nontemporal_store((f32x4){bflo(kr[i].x), bfhi(kr[i].x), bflo(kr[i].y), bfhi(kr[i].y)}, (f32x4*)(kdst + 256 * i));
                __builtin_nontemporal_store((f32x4){bflo(vr8[i].x), bfhi(vr8[i].x), bflo(vr8[i].y), bfhi(vr8[i].y)}, (f32x4*)(vdst + 256 * i)); }
        }
        bf16* op = Q1 + (seq0 + 32 * qblk) * D + hd * 64;
#pragma unroll
        for (int db = 0; db < 2; ++db)
#pragma unroll
            for (int i = 0; i < 16; ++i) *(GAS bf16*)((GAS char*)(op + (size_t)((i & 3) + 8 * (i >> 2)) * D + 32 * db) + offo) = (bf16)(pkbf(o[db][i], 0.f) & 0xffffu);
    }
}

struct Args { const float* in[16]; float* out; unsigned char* ws; int ph_lo, ph_hi; };
#ifndef DUP_LO
#define DUP_LO 16
#endif
#ifndef DUP_HI
#define DUP_HI 16
#endif
template <int PLO, int PHI> __device__ __forceinline__ void run_phases(Frame& F, const XcdBarrier& bar, int lo, int hi) {
#ifndef ONLY_PHASE
#define ONLY_PHASE -1
#endif
#define IN(k) ((ONLY_PHASE < 0 || ONLY_PHASE == (k)) && PLO <= (k) && (k) < PHI && lo <= (k) && (k) < hi)
#define SEAM(k) do { if ((k) + 1 < hi) xcd_barrier(bar, F.wave == 0 && lane_id() == 0); } while (0)
    bf16* XB = (bf16*)(F.ws + WS_XB); bf16* M1 = (bf16*)(F.ws + WS_M1); bf16* VG = (bf16*)(F.ws + WS_VG);
    if (IN(0)) { p0_prologue(F); SEAM(0); }
    if (IN(1)) {
        pg8::Gemm g{XB, (const bf16*)(F.ws + WS_WIN), T, 6144, 1024, 1024, 1024}; pg8::StaticOrder S; S.init(T, 6144, F.G, (int)blockIdx.x);
        pg8::EpiRot E{(bf16*)(F.out + O_KRP), VG, (const float*)(F.ws + WS_COS), (const float*)(F.ws + WS_SIN)};
        pg8::gemm_phase<pg8::EpiRot, pg8::StaticOrder, PG8_ALIGN, PG8_SP2>(F.lds, g, S, E, F.wave); SEAM(1);
    }
    if (IN(2)) { ret_phase(F); SEAM(2); }
    if (IN(3)) { gn_gate_phase(F); SEAM(3); }
    if (IN(4)) {
        pg8::Gemm g{VG, (const bf16*)(F.ws + WS_WRO), TP, 1024, 2048, 4096, 2048}; pg8::StaticOrder S; S.init(TP, 1024, F.G, (int)blockIdx.x);
        pg8::EpiBf16<0> E{M1, 1024, nullptr, 0, 0, 1.f};
        pg8::gemm_phase<pg8::EpiBf16<0>, pg8::StaticOrder, PG8_ALIGN, PG8_SP2>(F.lds, g, S, E, F.wave); SEAM(4);
    }
    if (IN(5)) {
        if ((int)blockIdx.x < tail_wgs(F, 4)) {
            pg8::Gemm g{VG, (const bf16*)(F.ws + WS_WRO), T, 1024, 2048, 4096, 2048}; pg8::TailOrder S{4, F.G, (int)blockIdx.x};
            pg8::EpiBf16<0> E{M1, 1024, nullptr, 0, 0, 1.f};
            pg8::gemm_phase<pg8::EpiBf16<0>, pg8::TailOrder, PG8_ALIGN, PG8_SP2>(F.lds, g, S, E, F.wave); tail_publish(F, 0);
        }
        ln_phase(F, 0, 0, LN_TAIL_ROWS0); SEAM(5);
    }
#define PEER_PHASES(layer, pb) do { \
        if (IN(pb)) { \
            pg8::Gemm g{XB, (const bf16*)(F.ws + WS_WPQ + (size_t)(layer) * 4 * MiB), TP, 2048, 1024, 1024, 1024}; pg8::StaticOrder S; S.init(TP, 2048, F.G, (int)blockIdx.x); \
            pg8::EpiBf16<0> E{VG, 2048, nullptr, 0, 0, 1.f}; \
            pg8::gemm_phase<pg8::EpiBf16<0>, pg8::StaticOrder, PG8_ALIGN, PG8_SP2>(F.lds, g, S, E, F.wave); SEAM(pb); \
        } \
        if (IN((pb) + 1)) { \
            if ((int)blockIdx.x < tail_wgs(F, 8)) {                       \
                pg8::Gemm g{XB, (const bf16*)(F.ws + WS_WPQ + (size_t)(layer) * 4 * MiB), T, 2048, 1024, 1024, 1024}; pg8::TailOrder S{8, F.G, (int)blockIdx.x}; \
                pg8::EpiBf16<0> E{VG, 2048, nullptr, 0, 0, 1.f}; \
                pg8::gemm_phase<pg8::EpiBf16<0>, pg8::TailOrder, PG8_ALIGN, PG8_SP2>(F.lds, g, S, E, F.wave); tail_publish(F, 2 + (layer)); \
            } \
            topk_phase(F, (layer), 2 + (layer)); SEAM((pb) + 1); } \
        if (IN((pb) + 2)) { gather_u_phase(F, (layer)); SEAM((pb) + 2); } \
        if (IN((pb) + 3)) { gather_v_phase(F, (layer)); SEAM((pb) + 3); } } while (0)
    PEER_PHASES(0, 6);
    if (IN(10)) {
        pg8::Gemm g{XB, (const bf16*)(F.ws + WS_WQKV), TP, 3072, 1024, 1024, 1024}; pg8::StaticOrder S; S.init(TP, 3072, F.G, (int)blockIdx.x);
        pg8::EpiQKV1 E{VG, (size_t)T * D, F.out + O_KRP, F.out + O_VRP, F.out + O_KRS, F.out + O_VRS};
        pg8::gemm_phase<pg8::EpiQKV1, pg8::StaticOrder, PG8_ALIGN, PG8_SP2>(F.lds, g, S, E, F.wave); SEAM(10);
    }
    if (IN(11)) {
        if ((int)blockIdx.x < tail_wgs(F, 12)) {
            pg8::Gemm g{XB, (const bf16*)(F.ws + WS_WQKV), T, 3072, 1024, 1024, 1024}; pg8::TailOrder S{12, F.G, (int)blockIdx.x};
            pg8::EpiQKV1 E{VG, (size_t)T * D, F.out + O_KRP, F.out + O_VRP, F.out + O_KRS, F.out + O_VRS};
            pg8::gemm_phase<pg8::EpiQKV1, pg8::TailOrder, PG8_ALIGN, PG8_SP2>(F.lds, g, S, E, F.wave); tail_publish(F, 4);
        }
        attn_phase(F); SEAM(11);
    }
    if (IN(12)) {
        pg8::Gemm g{VG, (const bf16*)(F.ws + WS_WSO), TP, 1024, 1024, 1024, 1024}; pg8::StaticOrder S; S.init(TP, 1024, F.G, (int)blockIdx.x);
        pg8::EpiBf16<0> E{M1, 1024, nullptr, 0, 0, 1.f};
        pg8::gemm_phase<pg8::EpiBf16<0>, pg8::StaticOrder, PG8_ALIGN, PG8_SP2>(F.lds, g, S, E, F.wave); SEAM(12);
    }
    if (IN(13)) {
        if ((int)blockIdx.x < tail_wgs(F, 4)) {
            pg8::Gemm g{VG, (const bf16*)(F.ws + WS_WSO), T, 1024, 1024, 1024, 1024}; pg8::TailOrder S{4, F.G, (int)blockIdx.x};
            pg8::EpiBf16<0> E{M1, 1024, nullptr, 0, 0, 1.f};
            pg8::gemm_phase<pg8::EpiBf16<0>, pg8::TailOrder, PG8_ALIGN, PG8_SP2>(F.lds, g, S, E, F.wave); tail_publish(F, 1);
        }
        ln_phase(F, 1, 1, LN_TAIL_ROWS1); SEAM(13);
    }
    PEER_PHASES(1, 14);
#undef PEER_PHASES
#undef IN
#undef SEAM
}
__global__ void __launch_bounds__(NTHR, 2) fwd(Args args) {
    extern __shared__ __attribute__((aligned(16))) unsigned char lds[];
    Frame F;
    F.lds = (LAS unsigned char*)lds; F.MISC = (volatile LAS unsigned*)(F.lds + MISC_OFF);
    F.wave = __builtin_amdgcn_readfirstlane((int)threadIdx.x >> 6); F.G = gridDim.x;
#pragma unroll
    for (int i = 0; i < 16; ++i) F.in[i] = args.in[i];
    F.out = args.out; F.ws = args.ws; F.ctl = (gu32*)(args.ws + WS_CTL);
    for (int u = F.wave * 64 + lane_id(); u < (LDS_BYTES - LDSCTL_OFF) / 4; u += NTHR) ((LAS unsigned*)(F.lds + LDSCTL_OFF))[u] = 0u;
    __syncthreads();
    const int lo = args.ph_lo, hi = args.ph_hi;
    XcdBarrier bar; bar.bar = (unsigned*)(F.ctl + CW_BAR); bar.x = 0; bar.st = nullptr;
    if (hi - lo > 1) bar = xcd_barrier_post((unsigned*)(F.ctl + CW_BAR), F.MISC + 8, F.wave == 0 && lane_id() == 0);
#if DUP_LO < DUP_HI
    run_phases<0, DUP_HI>(F, bar, lo, hi);
    run_phases<DUP_LO, DUP_HI>(F, bar, lo, hi);
    run_phases<DUP_HI, NPH>(F, bar, lo, hi);
#else
    run_phases<0, NPH>(F, bar, lo, hi);
#endif
}

extern "C" void kernel_launch(void* const* d_in, const int* in_sizes, int n_in, void* d_out, int out_size, void* d_ws, size_t ws_size, hipStream_t stream) {
    static int grid = 0;
    if (grid == 0) {
        if (n_in != 16 || in_sizes[0] != TP * D || (size_t)out_size != O_END || ws_size < WS_END) {
            fprintf(stderr, "kernel_launch: unexpected shapes: n_in %d in0 %d out %d ws %zu (need %zu)\n", n_in, n_in > 0 ? in_sizes[0] : -1, out_size, ws_size, (size_t)WS_END); grid = -1; return; }
        int dev = 0, cus = 0, per_cu = 0;
        if (hipGetDevice(&dev) != hipSuccess || hipDeviceGetAttribute(&cus, hipDeviceAttributeMultiprocessorCount, dev) != hipSuccess) { grid = -1; return; }
        if (hipFuncSetAttribute((const void*)fwd, hipFuncAttributeMaxDynamicSharedMemorySize, LDS_BYTES) != hipSuccess) { fprintf(stderr, "kernel_launch: hipFuncSetAttribute failed\n"); grid = -1; return; }
        if (hipOccupancyMaxActiveBlocksPerMultiprocessor(&per_cu, (const void*)fwd, NTHR, LDS_BYTES) != hipSuccess || per_cu < 1) fprintf(stderr, "kernel_launch: occupancy query says %d\n", per_cu);
        (void)hipGetLastError();
        grid = cus;
    }
    if (grid < 0) return;
    if (hipMemsetAsync((char*)d_ws + WS_CTL, 0, CTL_ZERO_BYTES, stream) != hipSuccess) { fprintf(stderr, "kernel_launch: memset failed\n"); return; }
    Args a{};
    for (int i = 0; i < 16; ++i) a.in[i] = (const float*)d_in[i];
    a.out = (float*)d_out; a.ws = (unsigned char*)d_ws;
#if MK_ONE_LAUNCH
    a.ph_lo = 0; a.ph_hi = NPH;
    hipLaunchKernelGGL(fwd, dim3(grid), dim3(NTHR), LDS_BYTES, stream, a);
#else
    for (int p = 0; p < NPH; ++p) { a.ph_lo = p; a.ph_hi = p + 1; hipLaunchKernelGGL(fwd, dim3(grid), dim3(NTHR), LDS_BYTES, stream, a); }
#endif
    const hipError_t le = hipPeekAtLastError();
    if (le != hipSuccess) fprintf(stderr, "kernel_launch: launch failed: %s\n", hipGetErrorName(le));
}
```
